# Optimizing an MI355X kernel written in HIP

```python
import jax, jax.numpy as jnp
from jax import lax
import numpy as np

D_MODEL = 1024
BATCH = 16
SEQ = 2048
DEPTH = 1

GRID_W = 64
CTX_LEN = 256
HEAD_DIM = 128
N_Q_HEADS = 8
N_KV_HEADS = 2
Q_PER_KV = N_Q_HEADS // N_KV_HEADS
ROPE_AXIS_DIM = HEAD_DIM // 2
ROPE_THETA = 10000.0
Q_BLOCK = 128
GLA_HEADS = 4
GLA_DK = (D_MODEL // 2) // GLA_HEADS
GLA_DV = D_MODEL // GLA_HEADS
GLA_LOWRANK = 16
GLA_GATE_NORM = 16.0
GLA_CHUNK = 64
N_BRANCH = 2
D_FF = ((8 * D_MODEL + 3 * 256 - 1) // (3 * 256)) * 256
EPS = 1e-6

ATTN_Q_W = N_Q_HEADS * HEAD_DIM
ATTN_KV_W = N_KV_HEADS * HEAD_DIM
GLA_QK_W = GLA_HEADS * GLA_DK
GLA_V_W = GLA_HEADS * GLA_DV
IN_WIDTHS = (ATTN_Q_W, ATTN_KV_W, ATTN_KV_W, GLA_QK_W, GLA_QK_W, GLA_V_W, GLA_V_W, 2 * GLA_LOWRANK, N_BRANCH * D_MODEL)
D_IN = sum(IN_WIDTHS)

kernel_name = "hybrid_gqa_gla_adaln_prefix_block"


def rms_norm(x, g):
    x32 = x.astype(jnp.float32)
    y = x32 * lax.rsqrt(jnp.mean(x32 * x32, axis=-1, keepdims=True) + EPS)
    return y.astype(x.dtype) * g


def modulate(h, shift, scale):
    return h * (1 + scale) + shift


def adaln(cvec, w_ada, b_ada):
    mod = jax.nn.silu(cvec) @ w_ada + b_ada
    return jnp.split(mod, 6, axis=-1)


def split_in(p):
    idx = [int(i) for i in np.cumsum(IN_WIDTHS)[:-1]]
    return jnp.split(p, idx, axis=-1)


def rope_2d_tables(rows, dtype):
    row = jnp.repeat(jnp.arange(rows, dtype=jnp.float32), GRID_W)
    col = jnp.tile(jnp.arange(GRID_W, dtype=jnp.float32), rows)
    inv_freq = 1.0 / (ROPE_THETA ** (jnp.arange(0, ROPE_AXIS_DIM, 2, dtype=jnp.float32) / ROPE_AXIS_DIM))
    ang = jnp.concatenate([row[:, None] * inv_freq[None], col[:, None] * inv_freq[None]], axis=-1)
    return jnp.cos(ang).astype(dtype), jnp.sin(ang).astype(dtype)


def apply_rope(x, cos, sin):
    xr = x.reshape(x.shape[:-1] + (HEAD_DIM // 2, 2))
    x0, x1 = xr[..., 0], xr[..., 1]
    c, s = cos[None, :, None, :], sin[None, :, None, :]
    out = jnp.stack([x0 * c - x1 * s, x0 * s + x1 * c], axis=-1)
    return out.reshape(x.shape)


def grouped_attention(qg, k, v):
    s = jnp.einsum('bqhgd,bkhd->bhgqk', qg, k).astype(jnp.float32) * (HEAD_DIM ** -0.5)
    p = jax.nn.softmax(s, axis=-1).astype(v.dtype)
    return jnp.einsum('bhgqk,bkhd->bqhgd', p, v)


def latent_attention(q, k_all, v_all):
    B, T = q.shape[0], q.shape[1]
    nb = T // Q_BLOCK
    qb = jnp.moveaxis(q.reshape(B, nb, Q_BLOCK, N_KV_HEADS, Q_PER_KV, HEAD_DIM), 1, 0)
    o = lax.map(lambda qi: grouped_attention(qi, k_all, v_all), qb)
    return jnp.moveaxis(o, 0, 1).reshape(B, T, ATTN_Q_W)


def gla_chunked(q, k, v, log_a, s0):
    B, T, H, dk = q.shape
    dv = v.shape[-1]
    C = GLA_CHUNK
    N = T // C
    f32 = jnp.float32
    qc = q.astype(f32).reshape(B, N, C, H, dk) * (dk ** -0.5)
    kc = k.astype(f32).reshape(B, N, C, H, dk)
    vc = v.astype(f32).reshape(B, N, C, H, dv)
    b = jnp.cumsum(log_a.astype(f32).reshape(B, N, C, H, dk), axis=2)
    b_last = b[:, :, -1]
    qe = qc * jnp.exp(b)
    ke = kc * jnp.exp(-b)
    kd = kc * jnp.exp(b_last[:, :, None] - b)
    mask = jnp.tril(jnp.ones((C, C), dtype=bool))
    a_intra = jnp.where(mask, jnp.einsum('bnthk,bnshk->bnhts', qe, ke), 0.0)
    o_intra = jnp.einsum('bnhts,bnshv->bnthv', a_intra, vc)

    def step(state, inp):
        qe_c, kd_c, v_c, dl_c = inp
        o = jnp.einsum('bchk,bhkv->bchv', qe_c, state)
        state = state * dl_c[..., None] + jnp.einsum('bchk,bchv->bhkv', kd_c, v_c)
        return state, o

    xs = (jnp.moveaxis(qe, 1, 0), jnp.moveaxis(kd, 1, 0), jnp.moveaxis(vc, 1, 0), jnp.moveaxis(jnp.exp(b_last), 1, 0))
    s_fin, o_inter = lax.scan(step, s0.astype(f32), xs)
    o = o_intra + jnp.moveaxis(o_inter, 0, 1)
    return o.reshape(B, T, H, dv).astype(q.dtype), s_fin


def gla_bidir(q, k, v, la_f, la_b, s0_f, s0_b):
    o_f, s_f = gla_chunked(q, k, v, la_f, s0_f)
    flip = lambda t: jnp.flip(t, axis=1)
    o_b, s_b = gla_chunked(flip(q), flip(k), flip(v), flip(la_b), s0_b)
    return o_f + flip(o_b), s_f, s_b


def gla_decays(lowrank, up_f, up_f_b, up_b, up_b_b):
    B, T = lowrank.shape[0], lowrank.shape[1]
    lr_f, lr_b = jnp.split(lowrank, 2, axis=-1)
    la_f = jax.nn.log_sigmoid((lr_f @ up_f + up_f_b).astype(jnp.float32)) / GLA_GATE_NORM
    la_b = jax.nn.log_sigmoid((lr_b @ up_b + up_b_b).astype(jnp.float32)) / GLA_GATE_NORM
    return la_f.reshape(B, T, GLA_HEADS, GLA_DK), la_b.reshape(B, T, GLA_HEADS, GLA_DK)


def gla_heads(gq, gk, gv):
    B, T = gq.shape[0], gq.shape[1]
    return (gq.reshape(B, T, GLA_HEADS, GLA_DK), gk.reshape(B, T, GLA_HEADS, GLA_DK),
            gv.reshape(B, T, GLA_HEADS, GLA_DV))


def branch_merge(attn_o, gla_o, gla_g, merge_g, gla_norm_g, w_attn_proj, w_gla_proj, w_out):
    B, T = attn_o.shape[0], attn_o.shape[1]
    go = rms_norm(gla_o, gla_norm_g).reshape(B, T, GLA_V_W) * jax.nn.silu(gla_g)
    ya = attn_o @ w_attn_proj
    yg = go @ w_gla_proj
    ga, gb = jnp.split(merge_g, 2, axis=-1)
    return (jax.nn.sigmoid(ga) * ya + jax.nn.sigmoid(gb) * yg) @ w_out


def swiglu(h, w_ffn_in, w_ffn_out):
    a, b = jnp.split(h @ w_ffn_in, 2, axis=-1)
    return (jax.nn.silu(a) * b) @ w_ffn_out


def setup_inputs(seed: int = 0) -> dict:
    key = jax.random.key(seed)
    ks = jax.random.split(key, 21)
    nrm = jax.random.normal
    f32 = jnp.float32

    def dense(k, shape, fan_in, gain=1.0):
        return nrm(k, shape, f32) * (gain * fan_in ** -0.5)

    return {
        "x": nrm(ks[0], (BATCH, SEQ, D_MODEL), f32),
        "c": nrm(ks[1], (BATCH, D_MODEL), f32),
        "ctx": nrm(ks[2], (BATCH, CTX_LEN, D_MODEL), f32),
        "c_ctx": nrm(ks[3], (D_MODEL,), f32),
        "w_ada": dense(ks[4], (DEPTH, D_MODEL, 6 * D_MODEL), D_MODEL, 0.5),
        "b_ada": 0.02 * nrm(ks[5], (DEPTH, 6 * D_MODEL), f32),
        "norm1_g": 1.0 + 0.05 * nrm(ks[6], (DEPTH, D_MODEL), f32),
        "w_in": dense(ks[7], (DEPTH, D_MODEL, D_IN), D_MODEL),
        "q_norm_g": 1.0 + 0.05 * nrm(ks[8], (DEPTH, HEAD_DIM), f32),
        "k_norm_g": 1.0 + 0.05 * nrm(ks[9], (DEPTH, HEAD_DIM), f32),
        "gk_up_f": dense(ks[10], (DEPTH, GLA_LOWRANK, GLA_QK_W), GLA_LOWRANK),
        "gk_up_f_b": 0.1 * nrm(ks[11], (DEPTH, GLA_QK_W), f32),
        "gk_up_b": dense(ks[12], (DEPTH, GLA_LOWRANK, GLA_QK_W), GLA_LOWRANK),
        "gk_up_b_b": 0.1 * nrm(ks[13], (DEPTH, GLA_QK_W), f32),
        "gla_norm_g": 1.0 + 0.05 * nrm(ks[14], (DEPTH, GLA_DV), f32),
        "w_attn_proj": dense(ks[15], (DEPTH, ATTN_Q_W, D_MODEL), ATTN_Q_W),
        "w_gla_proj": dense(ks[16], (DEPTH, GLA_V_W, D_MODEL), GLA_V_W),
        "w_out": dense(ks[17], (DEPTH, D_MODEL, D_MODEL), D_MODEL),
        "norm2_g": 1.0 + 0.05 * nrm(ks[18], (DEPTH, D_MODEL), f32),
        "w_ffn_in": dense(ks[19], (DEPTH, D_MODEL, 2 * D_FF), D_MODEL),
        "w_ffn_out": dense(ks[20], (DEPTH, D_FF, D_MODEL), D_FF),
    }


def reference(x, c, ctx, c_ctx, w_ada, b_ada, norm1_g, w_in, q_norm_g, k_norm_g, gk_up_f, gk_up_f_b,
              gk_up_b, gk_up_b_b, gla_norm_g, w_attn_proj, w_gla_proj, w_out, norm2_g, w_ffn_in, w_ffn_out):
    B, T, _ = x.shape
    Tc = ctx.shape[1]
    ROWS = T // GRID_W
    cos, sin = rope_2d_tables(ROWS, x.dtype)

    for l in range(DEPTH):
        sh1, sc1, g1, sh2, sc2, g2 = [m[:, None, :] for m in adaln(c, w_ada[l], b_ada[l])]
        sh1c, sc1c, g1c, sh2c, sc2c, g2c = adaln(c_ctx, w_ada[l], b_ada[l])

        hc = modulate(rms_norm(ctx, norm1_g[l]), sh1c, sc1c)
        aq_c, ak_c, av_c, gq_c, gk_c, gv_c, gg_c, glr_c, mg_c = split_in(hc @ w_in[l])
        k_c = rms_norm(ak_c.reshape(B, Tc, N_KV_HEADS, HEAD_DIM), k_norm_g[l])
        v_c = av_c.reshape(B, Tc, N_KV_HEADS, HEAD_DIM)
        la_f_c, la_b_c = gla_decays(glr_c, gk_up_f[l], gk_up_f_b[l], gk_up_b[l], gk_up_b_b[l])
        s_zero = jnp.zeros((B, GLA_HEADS, GLA_DK, GLA_DV), jnp.float32)
        gla_c, s_f, s_b = gla_bidir(*gla_heads(gq_c, gk_c, gv_c), la_f_c, la_b_c, s_zero, s_zero)

        hx = modulate(rms_norm(x, norm1_g[l]), sh1, sc1)
        aq, ak, av, gq, gk, gv, gg, glr, mg = split_in(hx @ w_in[l])
        q_x = apply_rope(rms_norm(aq.reshape(B, T, N_Q_HEADS, HEAD_DIM), q_norm_g[l]), cos, sin)
        k_x = apply_rope(rms_norm(ak.reshape(B, T, N_KV_HEADS, HEAD_DIM), k_norm_g[l]), cos, sin)
        v_x = av.reshape(B, T, N_KV_HEADS, HEAD_DIM)
        attn_x = latent_attention(q_x, jnp.concatenate([k_c, k_x], axis=1), jnp.concatenate([v_c, v_x], axis=1))
        la_f, la_b = gla_decays(glr, gk_up_f[l], gk_up_f_b[l], gk_up_b[l], gk_up_b_b[l])
        gla_x, _, _ = gla_bidir(*gla_heads(gq, gk, gv), la_f, la_b, s_f, s_b)
        x = x + g1 * branch_merge(attn_x, gla_x, gg, mg, gla_norm_g[l], w_attn_proj[l], w_gla_proj[l], w_out[l])
        x = x + g2 * swiglu(modulate(rms_norm(x, norm2_g[l]), sh2, sc2), w_ffn_in[l], w_ffn_out[l])

        if l < DEPTH - 1:
            q_c = rms_norm(aq_c.reshape(B, Tc, N_Q_HEADS, HEAD_DIM), q_norm_g[l])
            attn_c = grouped_attention(q_c.reshape(B, Tc, N_KV_HEADS, Q_PER_KV, HEAD_DIM), k_c, v_c).reshape(B, Tc, ATTN_Q_W)
            ctx = ctx + g1c * branch_merge(attn_c, gla_c, gg_c, mg_c, gla_norm_g[l], w_attn_proj[l], w_gla_proj[l], w_out[l])
            ctx = ctx + g2c * swiglu(modulate(rms_norm(ctx, norm2_g[l]), sh2c, sc2c), w_ffn_in[l], w_ffn_out[l])

    return x
```

```cpp
#include <hip/hip_runtime.h>
#include <hip/hip_bf16.h>
#include <hip/hip_cooperative_groups.h>
#include <cstdio>
#include <cstdint>
namespace cg = cooperative_groups;
__device__ __forceinline__ int mk_lane_() { int l; asm volatile("v_mbcnt_lo_u32_b32 %0, -1, 0\n\tv_mbcnt_hi_u32_b32 %0, -1, %0" : "=v"(l)); return l; }
#define MK_LANE() mk_lane_()
#define MK_TID (mk_wid * 64 + MK_LANE())
namespace pg8 {
#define PG8_LAS __attribute__((address_space(3)))
typedef unsigned short bf16_t;
typedef short bf16x8 __attribute__((ext_vector_type(8)));
typedef float f32x4 __attribute__((ext_vector_type(4)));
typedef unsigned u32x4 __attribute__((ext_vector_type(4)));
constexpr int BM = 256, BK = 64, HALF = 128, HTB = HALF * BK * 2  , STAGE_BYTES = 8 * HTB, NXCD = 8, WGM = 4  ;

__host__ __device__ __forceinline__ int lds_byte(int r, int c) { const int st = (r >> 4) * 2 + (c >> 5), rr = r & 15, cc = c & 31, ob = rr * 64 + cc * 2; return st * 1024 + (ob ^ (((ob >> 9) & 1) << 5)); }
__host__ __device__ __forceinline__ void stage_rc(int b, int& R, int& C) { const int st = b / 1024, sb = b % 1024, swz = sb ^ (((sb >> 9) & 1) << 5); R = (st >> 1) * 16 + swz / 64; C = (st & 1) * 32 + (swz % 64) / 2; }
__host__ __device__ __forceinline__ int perm32(int rho) { const int n = rho >> 4, i = rho & 15; return 8 * (i >> 2) + 4 * n + (i & 3); }

struct Unit { int pm, pn; };
struct Gemm { const bf16_t* A; const bf16_t* Bt; int M, N, K; };

struct StaticOrder {
    int nM, nN, nwg, G, c, wgm;
    __host__ __device__ void init(int M, int N, int G_, int c_, int wgm_ = WGM) { nM = M / BM; nN = N / BM; nwg = nM * nN; G = G_; c = c_; wgm = wgm_; }
    __host__ __device__ bool next(int i, Unit& u) const {
        const long L = (long)i * G + c; if (L >= nwg) return false;
        int wgid = (int)L; { const int q = nwg / NXCD, r = nwg % NXCD, xcd = wgid % NXCD, off = wgid / NXCD; wgid = (xcd < r ? xcd * (q + 1) : r * (q + 1) + (xcd - r) * q) + off; }
        const int nig = wgm * nN, gid = wgid / nig, fm = gid * wgm, gsz = (nM - fm) < wgm ? (nM - fm) : wgm;
        u.pm = fm + ((wgid % nig) % gsz); u.pn = (wgid % nig) / gsz; return true;
    }
    __device__ __forceinline__ void a_ready(const Unit&) const {}
    __device__ __forceinline__ void done(const Unit&) const {}
};

__device__ __forceinline__ unsigned cvt_pk_bf16(float lo, float hi) { unsigned r; asm volatile("v_cvt_pk_bf16_f32 %0, %1, %2" : "=v"(r) : "v"(lo), "v"(hi)); return r; }
typedef float f32x2 __attribute__((ext_vector_type(2)));
template <class Epi, class Sched, bool ALIGN_EPI = false, bool SP2 = false>
__device__ __forceinline__ void gemm_phase(PG8_LAS unsigned char* lds, const Gemm g, const Sched& S, const Epi& E, const int mk_wid) {
    const int tid = MK_TID, wid = mk_wid, lane = tid & 63, wr = wid >> 2, wc = wid & 3, fr = lane & 15, fq = lane >> 4;
    const int K = g.K, nt = K / BK;
    unsigned voffA[2], voffB[2];
#pragma unroll
    for (int i = 0; i < 2; ++i) { int R, C; stage_rc(tid * 16 + i * 8192, R, C); const int Rb = Epi::PERM ? ((R & ~31) + perm32(R & 31)) : R;
        voffA[i] = (unsigned)(R * K + C) * 2u; voffB[i] = (unsigned)(Rb * K + C) * 2u; }
    const size_t kstep = (size_t)(BK * 2);
    const size_t hstep = (size_t)HALF * K * 2;
    const size_t tstep = 2 * hstep;
    const unsigned ldsw = (unsigned)wid * 1024u;
    const int aoff = lds_byte(wr * 64 + fr, fq * 8), boff = lds_byte(wc * 32 + fr, fq * 8);
#define PG8_SA(b, h) (((b) * 2 + (h)) * HTB)
#define PG8_SB(b, h) ((4 + (b) * 2 + (h)) * HTB)
#define PG8_STAGE(bufoff, gbase, voff) do { _Pragma("unroll") for (int _i = 0; _i < 2; ++_i) \
        __builtin_amdgcn_global_load_lds((const unsigned*)((const char*)(gbase) + (voff)[_i]), (PG8_LAS unsigned*)(lds + (bufoff) + ldsw + _i * 8192), 16, 0, 0); } while (0)
#define PG8_LDA(dst, b, h) do { _Pragma("unroll") for (int m = 0; m < 4; ++m) _Pragma("unroll") for (int k = 0; k < 2; ++k) dst[m][k] = *(const PG8_LAS bf16x8*)(lds + PG8_SA(b, h) + aoff + m * 2048 + k * 1024); } while (0)
#define PG8_LDB(dst, b, h) do { _Pragma("unroll") for (int n = 0; n < 2; ++n) _Pragma("unroll") for (int k = 0; k < 2; ++k) dst[n][k] = *(const PG8_LAS bf16x8*)(lds + PG8_SB(b, h) + boff + n * 2048 + k * 1024); } while (0)
#define PG8_MMA(ai, bj, At, Bt) do { __builtin_amdgcn_s_setprio(1); _Pragma("unroll") for (int m = 0; m < 4; ++m) _Pragma("unroll") for (int n = 0; n < 2; ++n) _Pragma("unroll") for (int k = 0; k < 2; ++k) \
        acc[ai][bj][m][n] = __builtin_amdgcn_mfma_f32_16x16x32_bf16(Bt[n][k], At[m][k], acc[ai][bj][m][n], 0, 0, 0); __builtin_amdgcn_s_setprio(0); } while (0)
#define PG8_WAIT_V(n) asm volatile("s_waitcnt vmcnt(" #n ")" ::: "memory")
#define PG8_WAIT_L(n) asm volatile("s_waitcnt lgkmcnt(" #n ")" ::: "memory")
#define PG8_BAR __builtin_amdgcn_s_barrier()
#define PG8_SCHED __builtin_amdgcn_sched_barrier(0)
    Unit cur, nxt; int ui = 0;
    if (!S.next(0, cur)) return;
    f32x4 acc[2][2][4][2];
#pragma unroll
    for (int a = 0; a < 2; ++a)
#pragma unroll
        for (int b = 0; b < 2; ++b)
#pragma unroll
            for (int m = 0; m < 4; ++m)
#pragma unroll
                for (int n = 0; n < 2; ++n) acc[a][b][m][n] = (f32x4){0.f, 0.f, 0.f, 0.f};
    bf16x8 At[4][2], B0[2][2], B1[2][2];
    const char* cA = (const char*)g.A + (size_t)cur.pm * tstep; const char* cB = (const char*)g.Bt + (size_t)cur.pn * tstep;
    S.a_ready(cur);
    if constexpr (SP2) {
        PG8_STAGE(PG8_SB(0, 0), cB, voffB); PG8_STAGE(PG8_SB(0, 1), cB + hstep, voffB); PG8_STAGE(PG8_SA(0, 0), cA, voffA); PG8_STAGE(PG8_SA(0, 1), cA + hstep, voffA);
        if (wr == 1) PG8_BAR;
        PG8_WAIT_V(2); PG8_BAR;
        PG8_STAGE(PG8_SB(1, 0), cB + kstep, voffB); PG8_STAGE(PG8_SA(1, 0), cA + kstep, voffA); PG8_STAGE(PG8_SB(1, 1), cB + hstep + kstep, voffB);
        PG8_WAIT_V(6); PG8_BAR;
    } else {
        PG8_STAGE(PG8_SB(0, 0), cB, voffB); PG8_STAGE(PG8_SA(0, 0), cA, voffA); PG8_STAGE(PG8_SB(0, 1), cB + hstep, voffB); PG8_STAGE(PG8_SA(0, 1), cA + hstep, voffA);
        if (wr == 1) PG8_BAR;
        PG8_WAIT_V(4); PG8_BAR;
        PG8_STAGE(PG8_SB(1, 0), cB + kstep, voffB); PG8_STAGE(PG8_SA(1, 0), cA + kstep, voffA); PG8_STAGE(PG8_SB(1, 1), cB + hstep + kstep, voffB);
        PG8_WAIT_V(6); PG8_BAR;
    }
    for (;;) {
        const bool has_next = S.next(ui + 1, nxt);
        const char* nA = has_next ? (const char*)g.A + (size_t)nxt.pm * tstep : cA; const char* nB = has_next ? (const char*)g.Bt + (size_t)nxt.pn * tstep : cB;
        for (int t = 0; t < nt; t += 2) {
            const bool last = (t == nt - 2);
            const char* a1 = cA + (size_t)(t + 1) * kstep;
            const char* a2 = last ? nA : cA + (size_t)(t + 2) * kstep; const char* b2 = last ? nB : cB + (size_t)(t + 2) * kstep;
            const char* a3 = a2 + kstep; const char* b3 = b2 + kstep;
            if (last && has_next) S.a_ready(nxt);
            if constexpr (SP2) {
            PG8_LDB(B0, 0, 0); PG8_LDB(B1, 0, 1); PG8_SCHED; PG8_LDA(At, 0, 0); PG8_STAGE(PG8_SA(1, 1), a1 + hstep, voffA);
            PG8_WAIT_V(8); PG8_WAIT_L(0); PG8_BAR; PG8_MMA(0, 0, At, B0); PG8_MMA(0, 1, At, B1); PG8_BAR; PG8_SCHED;
            PG8_LDA(At, 0, 1); PG8_STAGE(PG8_SB(0, 0), b2, voffB); PG8_STAGE(PG8_SB(0, 1), b2 + hstep, voffB); PG8_STAGE(PG8_SA(0, 0), a2, voffA);
            PG8_WAIT_V(8); PG8_WAIT_L(0); PG8_BAR; PG8_MMA(1, 0, At, B0); PG8_MMA(1, 1, At, B1); PG8_BAR; PG8_SCHED;
            PG8_LDB(B0, 1, 0); PG8_LDB(B1, 1, 1); PG8_SCHED; PG8_LDA(At, 1, 0); PG8_STAGE(PG8_SA(0, 1), a2 + hstep, voffA);
            PG8_WAIT_V(8); PG8_WAIT_L(0); PG8_BAR; PG8_MMA(0, 0, At, B0); PG8_MMA(0, 1, At, B1); PG8_BAR; PG8_SCHED;
            PG8_LDA(At, 1, 1); PG8_STAGE(PG8_SB(1, 0), b3, voffB); PG8_STAGE(PG8_SB(1, 1), b3 + hstep, voffB); PG8_STAGE(PG8_SA(1, 0), a3, voffA);
            PG8_WAIT_V(8); PG8_WAIT_L(0); PG8_BAR; PG8_MMA(1, 0, At, B0); PG8_MMA(1, 1, At, B1); PG8_BAR; PG8_SCHED;
            } else {
            PG8_LDB(B0, 0, 0); PG8_SCHED; PG8_LDA(At, 0, 0); PG8_STAGE(PG8_SA(1, 1), a1 + hstep, voffA);
            PG8_WAIT_L(8); PG8_BAR; PG8_WAIT_L(0); PG8_MMA(0, 0, At, B0); PG8_BAR; PG8_SCHED;
            PG8_LDB(B1, 0, 1); PG8_STAGE(PG8_SB(0, 0), b2, voffB);
            PG8_BAR; PG8_WAIT_L(0); PG8_MMA(0, 1, At, B1); PG8_BAR;
            PG8_LDA(At, 0, 1); PG8_STAGE(PG8_SA(0, 0), a2, voffA);
            PG8_BAR; PG8_WAIT_L(0); PG8_MMA(1, 0, At, B0); PG8_BAR; PG8_SCHED;
            PG8_STAGE(PG8_SB(0, 1), b2 + hstep, voffB);
            PG8_WAIT_V(6); PG8_BAR; PG8_MMA(1, 1, At, B1); PG8_BAR;
            PG8_LDB(B0, 1, 0); PG8_SCHED; PG8_LDA(At, 1, 0); PG8_STAGE(PG8_SA(0, 1), a2 + hstep, voffA);
            PG8_WAIT_L(8); PG8_BAR; PG8_WAIT_L(0); PG8_MMA(0, 0, At, B0); PG8_BAR; PG8_SCHED;
            PG8_LDB(B1, 1, 1); PG8_STAGE(PG8_SB(1, 0), b3, voffB);
            PG8_BAR; PG8_WAIT_L(0); PG8_MMA(0, 1, At, B1); PG8_BAR;
            PG8_LDA(At, 1, 1); PG8_STAGE(PG8_SA(1, 0), a3, voffA);
            PG8_BAR; PG8_WAIT_L(0); PG8_MMA(1, 0, At, B0); PG8_BAR; PG8_SCHED;
            PG8_STAGE(PG8_SB(1, 1), b3 + hstep, voffB);
            PG8_WAIT_V(6); PG8_BAR; PG8_MMA(1, 1, At, B1); PG8_BAR;
            }
        }
        if constexpr (ALIGN_EPI) { if (wr == 0) PG8_BAR; }
        if constexpr (!Epi::AFTER_DRAIN) { E(acc, cur, wr, wc, fr, fq); S.done(cur); }
        if (!has_next) break;
#pragma unroll
        for (int a = 0; a < 2; ++a)
#pragma unroll
            for (int b = 0; b < 2; ++b)
#pragma unroll
                for (int m = 0; m < 4; ++m)
#pragma unroll
                    for (int n = 0; n < 2; ++n) acc[a][b][m][n] = (f32x4){0.f, 0.f, 0.f, 0.f};
        cur = nxt; cA = nA; cB = nB; ++ui;
        if constexpr (ALIGN_EPI) { if (wr == 1) PG8_BAR; }
    }
    PG8_WAIT_V(0);
    if constexpr (!ALIGN_EPI) { if (wr == 0) PG8_BAR; }
    PG8_BAR;
    if constexpr (Epi::AFTER_DRAIN) { E.fused(acc, cur, wr, wc, fr, fq, lds, wid, lane); S.done(cur); }
#undef PG8_SA
#undef PG8_SB
#undef PG8_STAGE
#undef PG8_LDA
#undef PG8_LDB
#undef PG8_MMA
#undef PG8_WAIT_V
#undef PG8_WAIT_L
#undef PG8_BAR
#undef PG8_SCHED
}
}
namespace att {
using bf16 = __hip_bfloat16;
constexpr int   D = 128, NW = 8, QBLK = 32, KVBLK = 64;
constexpr float SCALE = 0.088388347648318440f;
constexpr float THR = 8.f;
constexpr int LDQ = 1024, LDK = 256, LDO = 1024;
constexpr size_t SHM_V = KVBLK * D * 2, SHM_K = KVBLK * D * 2, SHM_ATTN = 2 * SHM_V + 2 * SHM_K + NW * 64 * 4;
using bf16x8 = __attribute__((ext_vector_type(8))) short;
using s16x4  = __attribute__((ext_vector_type(4))) short;
using f32x16 = __attribute__((ext_vector_type(16))) float;
using f32x8  = __attribute__((ext_vector_type(8))) float;
using u32x4  = __attribute__((ext_vector_type(4))) unsigned;
#define KSWZ(row, colB) ((row) * 256 + ((colB) ^ (((row) & 7) << 4)))
#define SBAR() __builtin_amdgcn_sched_barrier(0)
__device__ __forceinline__ int crow(int r, int hi) { return (r & 3) + 8 * (r >> 2) + 4 * hi; }
__device__ __forceinline__ unsigned cvtpk(float lo, float hi) {
  unsigned r; asm volatile("v_cvt_pk_bf16_f32 %0, %1, %2" : "=v"(r) : "v"(lo), "v"(hi)); return r;
}
template <typename TIn> struct Stage;
template <> struct Stage<bf16>  { using T = bf16x8;
  __device__ static __forceinline__ T ld8(const bf16* p) { return *reinterpret_cast<const bf16x8*>(p); }
  __device__ static __forceinline__ bf16x8 tobf(T x) { return x; } };
template <> struct Stage<float> { using T = f32x8;
  __device__ static __forceinline__ T ld8(const float* p) { return *reinterpret_cast<const f32x8*>(p); }
  __device__ static __forceinline__ bf16x8 tobf(T x) {
    u32x4 w = {cvtpk(x[0], x[1]), cvtpk(x[2], x[3]), cvtpk(x[4], x[5]), cvtpk(x[6], x[7])}; return *reinterpret_cast<bf16x8*>(&w); } };

__device__ __forceinline__ void partialSM(f32x16& p0, f32x16& p1, float& m_reg, float& mn, float& alpha) {
  constexpr float C = SCALE * 1.4426950408889634f;
  float pmax = p0[0]; for (int r = 1; r < 16; ++r) pmax = fmaxf(pmax, p0[r]); for (int r = 0; r < 16; ++r) pmax = fmaxf(pmax, p1[r]);
  { auto rr = __builtin_amdgcn_permlane32_swap(__float_as_uint(pmax), __float_as_uint(pmax), false, false);
    pmax = fmaxf(__uint_as_float(rr[0]), __uint_as_float(rr[1])); }
  if (__builtin_expect(__all(pmax - m_reg <= THR / SCALE), 1)) { mn = m_reg; alpha = 1.f; }
  else { mn = fmaxf(m_reg, pmax); alpha = __builtin_amdgcn_exp2f((m_reg - mn) * C); m_reg = mn; }
  float mnC = -mn * C;
  for (int r = 0; r < 16; ++r) p0[r] = fmaf(p0[r], C, mnC); for (int r = 0; r < 16; ++r) p1[r] = fmaf(p1[r], C, mnC);
  for (int r = 0; r < 16; ++r) p0[r] = __builtin_amdgcn_exp2f(p0[r]);
}
__device__ __forceinline__ void finishSM(f32x16& p0, f32x16& p1, float alpha, float& l_reg, bf16x8& pa0, bf16x8& pa1, bf16x8& pa2, bf16x8& pa3) {
  for (int r = 0; r < 16; ++r) p1[r] = __builtin_amdgcn_exp2f(p1[r]);
  float ps = 0; for (int r = 0; r < 16; ++r) ps += p0[r]; for (int r = 0; r < 16; ++r) ps += p1[r];
  { auto rr = __builtin_amdgcn_permlane32_swap(__float_as_uint(ps), __float_as_uint(ps), false, false);
    ps = __uint_as_float(rr[0]) + __uint_as_float(rr[1]); }
  l_reg = l_reg * alpha + ps;
#define PK4(P, BASE, OUT) do { unsigned a0 = cvtpk(P[BASE + 0], P[BASE + 1]), a1 = cvtpk(P[BASE + 2], P[BASE + 3]);   \
    unsigned b0 = cvtpk(P[BASE + 4], P[BASE + 5]), b1 = cvtpk(P[BASE + 6], P[BASE + 7]);                              \
    auto r0 = __builtin_amdgcn_permlane32_swap(a0, b0, false, false); auto r1 = __builtin_amdgcn_permlane32_swap(a1, b1, false, false); \
    u32x4 w = {r0[0], r1[0], r0[1], r1[1]}; OUT = *reinterpret_cast<bf16x8*>(&w); } while (0)
  PK4(p0, 0, pa0); PK4(p0, 8, pa1); PK4(p1, 0, pa2); PK4(p1, 8, pa3);
#undef PK4
}
__device__ __forceinline__ void qkt(f32x16& p0, f32x16& p1, const bf16* Ks, const bf16x8* qr, int r32, int hi) {
  p0 = f32x16{}; p1 = f32x16{};
  for (int d0 = 0; d0 < 8; ++d0) { int cb = (d0 * 16 + hi * 8) * 2;
    bf16x8 b0 = *reinterpret_cast<const bf16x8*>((const char*)Ks + KSWZ(r32, cb));
    bf16x8 b1 = *reinterpret_cast<const bf16x8*>((const char*)Ks + KSWZ(32 + r32, cb));
    p0 = __builtin_amdgcn_mfma_f32_32x32x16_bf16(b0, qr[d0], p0, 0, 0, 0);
    p1 = __builtin_amdgcn_mfma_f32_32x32x16_bf16(b1, qr[d0], p1, 0, 0, 0); }
}
__device__ __forceinline__ int v_st(int k, int c) { const int kk = (k & ~0xC) | ((k & 4) << 1) | ((k & 8) >> 1); return ((kk >> 3) * 4 + (c >> 5)) * 512 + ((kk & 7) * 32 + (c & 31)) * 2; }
__device__ __forceinline__ int v_rd_base(int lane) { return ((lane & 3) << 3) | (((lane >> 2) & 3) << 6) | (((lane >> 4) & 1) << 5) | (((lane >> 5) & 1) << 8); }
constexpr int v_rd_off(int d0, int ks, int half) { return d0 * 512 + ks * 4096 + half * 2048; }
template <int OFF> __device__ __forceinline__ s16x4 tr_read(int vb) {
  s16x4 r; asm volatile("ds_read_b64_tr_b16 %0, %1 offset:%2" : "=&v"(r) : "v"(vb), "i"(OFF) : "memory"); return r;
}
template <int D0> __device__ __forceinline__ void pv_one(f32x16& od, int vb, bf16x8 pa0, bf16x8 pa1, bf16x8 pa2, bf16x8 pa3) {
  const s16x4 l0 = tr_read<v_rd_off(D0, 0, 0)>(vb), h0 = tr_read<v_rd_off(D0, 0, 1)>(vb), l1 = tr_read<v_rd_off(D0, 1, 0)>(vb), h1 = tr_read<v_rd_off(D0, 1, 1)>(vb);
  const s16x4 l2 = tr_read<v_rd_off(D0, 2, 0)>(vb), h2 = tr_read<v_rd_off(D0, 2, 1)>(vb), l3 = tr_read<v_rd_off(D0, 3, 0)>(vb), h3 = tr_read<v_rd_off(D0, 3, 1)>(vb);
  asm volatile("s_waitcnt lgkmcnt(0)" ::: "memory"); SBAR();
#define PK(L, H) (bf16x8){L[0], L[1], L[2], L[3], H[0], H[1], H[2], H[3]}
  od = __builtin_amdgcn_mfma_f32_32x32x16_bf16(pa0, PK(l0, h0), od, 0, 0, 0);
  od = __builtin_amdgcn_mfma_f32_32x32x16_bf16(pa1, PK(l1, h1), od, 0, 0, 0);
  od = __builtin_amdgcn_mfma_f32_32x32x16_bf16(pa2, PK(l2, h2), od, 0, 0, 0);
  od = __builtin_amdgcn_mfma_f32_32x32x16_bf16(pa3, PK(l3, h3), od, 0, 0, 0);
#undef PK
}
__device__ __forceinline__ void pv_d0(f32x16* o, int vb, bf16x8 pa0, bf16x8 pa1, bf16x8 pa2, bf16x8 pa3) {
  pv_one<0>(o[0], vb, pa0, pa1, pa2, pa3); pv_one<1>(o[1], vb, pa0, pa1, pa2, pa3); pv_one<2>(o[2], vb, pa0, pa1, pa2, pa3); pv_one<3>(o[3], vb, pa0, pa1, pa2, pa3);
}
__device__ __forceinline__ float bf2f(short s) { return __uint_as_float(((unsigned)(unsigned short)s) << 16); }
__device__ __forceinline__ void attn_unit(const bf16* Qb, const bf16* __restrict__ Kh, const bf16* __restrict__ Vh, bf16* Ob, int seq, char* lds,
                                          const float* __restrict__ rope, const float* __restrict__ qg, const int mk_wid) {
  using St = Stage<bf16>;
  int tid = MK_TID; asm volatile("" : "+v"(tid));
  const int wid = mk_wid, lane = tid & 63, r32 = lane & 31, hi = lane >> 5;
  bf16* V_lds = (bf16*)lds; bf16* K_lds = (bf16*)(lds + 2 * SHM_V);
  float* ws = (float*)(lds + 2 * SHM_V + 2 * SHM_K) + wid * 64; float* li_l = ws; float* al_l = ws + 32;
  float m_reg = -1e30f, l_reg = 0; f32x16 o[4] = {}; bf16x8 qr[8];
  const int sr = tid >> 4, sc = (tid & 15) * 8, vst0 = v_st(sr, sc), vst1 = v_st(32 + sr, sc);
  const int vb0 = (int)(uintptr_t)V_lds + v_rd_base(lane);
  struct { typename St::T vs0, vs1, ks0, ks1; } sr_[2];
#define SLOAD(i, k0) do { sr_[i].vs0 = St::ld8(&Vh[(long)((k0) + sr) * LDK + sc]); sr_[i].vs1 = St::ld8(&Vh[(long)((k0) + 32 + sr) * LDK + sc]); \
    sr_[i].ks0 = St::ld8(&Kh[(long)((k0) + sr) * LDK + sc]); sr_[i].ks1 = St::ld8(&Kh[(long)((k0) + 32 + sr) * LDK + sc]); } while (0)
#define SWRITE(b, i) do { *(bf16x8*)((char*)V_lds + (b) * SHM_V + vst0) = St::tobf(sr_[i].vs0);          \
    *(bf16x8*)((char*)V_lds + (b) * SHM_V + vst1) = St::tobf(sr_[i].vs1); int kc = sc * 2;               \
    *(bf16x8*)((char*)K_lds + (b) * SHM_K + KSWZ(sr, kc)) = St::tobf(sr_[i].ks0);                       \
    *(bf16x8*)((char*)K_lds + (b) * SHM_K + KSWZ(32 + sr, kc)) = St::tobf(sr_[i].ks1); } while (0)
#define SWAIT() do { asm volatile("s_waitcnt vmcnt(4)" ::: "memory"); } while (0)
#define RESC(a) do { if (__any((a) < 1.f)) { if (hi == 0) al_l[r32] = (a); asm volatile("s_waitcnt lgkmcnt(0)" ::: "memory"); \
    for (int d = 0; d < 4; ++d) for (int r = 0; r < 16; ++r) o[d][r] *= al_l[crow(r, hi)]; } } while (0)
  constexpr int SE = 0, SO = 1;
  {
    int tp = MK_TID; asm volatile("" : "+v"(tp)); const int r32 = tp & 31, hi = (tp >> 5) & 1;
    const bf16* Qw = Qb + (long)(wid * QBLK + r32) * LDQ + hi * 8;
    const float* rp = rope + ((long)(wid * QBLK + r32) * 64 + hi * 4) * 2;
    bf16x8 rw[8]; float4 gA[8], gB[8], cA[8], cB[8];
#pragma unroll
    for (int d0 = 0; d0 < 8; ++d0) { rw[d0] = *reinterpret_cast<const bf16x8*>(Qw + d0 * 16);
      gA[d0] = *reinterpret_cast<const float4*>(qg + d0 * 16 + hi * 8); gB[d0] = *reinterpret_cast<const float4*>(qg + d0 * 16 + hi * 8 + 4);
      cA[d0] = *reinterpret_cast<const float4*>(rp + d0 * 16); cB[d0] = *reinterpret_cast<const float4*>(rp + d0 * 16 + 4); }
    float ss = 0.f;
#pragma unroll
    for (int d0 = 0; d0 < 8; ++d0)
#pragma unroll
      for (int e = 0; e < 8; ++e) { const float f = bf2f(rw[d0][e]); ss += f * f; }
    { auto rr = __builtin_amdgcn_permlane32_swap(__float_as_uint(ss), __float_as_uint(ss), false, false); ss = __uint_as_float(rr[0]) + __uint_as_float(rr[1]); }
    const float rinv = rsqrtf(ss * (1.f / 128.f) + 1e-6f);
#pragma unroll
    for (int d0 = 0; d0 < 8; ++d0) {
      const float4 g0 = gA[d0], g1 = gB[d0], cs0 = cA[d0], cs1 = cB[d0];
      const float x0 = bf2f(rw[d0][0]) * rinv * g0.x, x1 = bf2f(rw[d0][1]) * rinv * g0.y, x2 = bf2f(rw[d0][2]) * rinv * g0.z, x3 = bf2f(rw[d0][3]) * rinv * g0.w;
      const float x4 = bf2f(rw[d0][4]) * rinv * g1.x, x5 = bf2f(rw[d0][5]) * rinv * g1.y, x6 = bf2f(rw[d0][6]) * rinv * g1.z, x7 = bf2f(rw[d0][7]) * rinv * g1.w;
      u32x4 w = {cvtpk(x0 * cs0.x - x1 * cs0.y, x0 * cs0.y + x1 * cs0.x), cvtpk(x2 * cs0.z - x3 * cs0.w, x2 * cs0.w + x3 * cs0.z),
                 cvtpk(x4 * cs1.x - x5 * cs1.y, x4 * cs1.y + x5 * cs1.x), cvtpk(x6 * cs1.z - x7 * cs1.w, x6 * cs1.w + x7 * cs1.z)};
      qr[d0] = *reinterpret_cast<bf16x8*>(&w);
    }
  }
  f32x16 pA0, pA1, pB0, pB1; float mnA, mnB, alA, alB; bf16x8 pa0, pa1, pa2, pa3; const int NT = seq / KVBLK;
  SLOAD(SE, 0); asm volatile("s_waitcnt vmcnt(0)" ::: "memory"); SWRITE(0, SE); __syncthreads();
  qkt(pA0, pA1, K_lds, qr, r32, hi); partialSM(pA0, pA1, m_reg, mnA, alA);
  SLOAD(SO, KVBLK); if (2 < NT) SLOAD(SE, 2 * KVBLK);
  SWAIT(); SWRITE(1, SO); __syncthreads();
  for (int j = 1; j + 1 < NT; j += 2) {
    SBAR(); qkt(pB0, pB1, (bf16*)((char*)K_lds + SHM_K), qr, r32, hi);
    finishSM(pA0, pA1, alA, l_reg, pa0, pa1, pa2, pa3); SBAR();
    SLOAD(SO, (j + 2) * KVBLK); SBAR();
    pv_d0(o, vb0, pa0, pa1, pa2, pa3); partialSM(pB0, pB1, m_reg, mnB, alB);
    __syncthreads(); SWAIT(); SWRITE(0, SE);
    RESC(alB); __syncthreads();
    SBAR(); qkt(pA0, pA1, K_lds, qr, r32, hi);
    finishSM(pB0, pB1, alB, l_reg, pa0, pa1, pa2, pa3); SBAR();
    if (j + 3 < NT) SLOAD(SE, (j + 3) * KVBLK); SBAR();
    pv_d0(o, vb0 + (int)SHM_V, pa0, pa1, pa2, pa3); partialSM(pA0, pA1, m_reg, mnA, alA);
    __syncthreads(); SWAIT(); SWRITE(1, SO);
    RESC(alA); __syncthreads();
  }
  SBAR(); qkt(pB0, pB1, (bf16*)((char*)K_lds + SHM_K), qr, r32, hi);
  finishSM(pA0, pA1, alA, l_reg, pa0, pa1, pa2, pa3); SBAR();
  pv_d0(o, vb0, pa0, pa1, pa2, pa3); partialSM(pB0, pB1, m_reg, mnB, alB);
  __syncthreads(); RESC(alB);
  finishSM(pB0, pB1, alB, l_reg, pa0, pa1, pa2, pa3); SBAR();
  pv_d0(o, vb0 + (int)SHM_V, pa0, pa1, pa2, pa3);
  if (hi == 0) li_l[r32] = l_reg; asm volatile("s_waitcnt lgkmcnt(0)" ::: "memory");
  float rli[16];
#pragma unroll
  for (int r = 0; r < 16; ++r) rli[r] = __builtin_amdgcn_rcpf(li_l[crow(r, hi)]);
  __syncthreads();
  { int te = MK_TID; asm volatile("" : "+v"(te)); const int lane = te & 63, r32 = lane & 31, hi = lane >> 5;
    unsigned short* stg = (unsigned short*)(lds + wid * 8192);
#pragma unroll
    for (int r = 0; r < 16; ++r) { const int orow = crow(r, hi);
#pragma unroll
      for (int d0 = 0; d0 < 4; ++d0) stg[orow * 128 + d0 * 32 + r32] = (unsigned short)(cvtpk(o[d0][r] * rli[r], 0.f) & 0xffffu); }
    asm volatile("s_waitcnt lgkmcnt(0)" ::: "memory");
    bf16* Ow = Ob + (long)(wid * QBLK) * LDO;
#pragma unroll
    for (int i = 0; i < 8; ++i) { const int row = i * 4 + (lane >> 4), ch = lane & 15; const u32x4 v = *(const u32x4*)(stg + row * 128 + ch * 8); *(u32x4*)(Ow + (long)row * LDO + ch * 8) = v; } }
  __syncthreads();
#undef SLOAD
#undef SWRITE
#undef SWAIT
#undef RESC
}
}
constexpr int NB = 16, T = 2048, TC = 256, TA = T + TC, DM = 1024;
constexpr int MLAT = NB * T, MALL = NB * TA;
constexpr int NIN = 6912;
constexpr int DFF = 2816;
constexpr float EPS = 1e-6f;
constexpr size_t MiB = 1u << 20;
constexpr size_t WS_MOD = 1 * MiB, WS_ROPE = 2 * MiB, WS_WIN = 4 * MiB, WS_WAP = 18 * MiB, WS_WGP = 20 * MiB, WS_WOUT = 22 * MiB, WS_WFI = 24 * MiB, WS_WFO = 36 * MiB,
                 WS_H1 = 42 * MiB, WS_Q = 114 * MiB, WS_K = 178 * MiB, WS_V = 196 * MiB, WS_GQ = 214 * MiB, WS_GK = 250 * MiB, WS_GV = 286 * MiB, WS_GG = 358 * MiB,
                 WS_LR = 422 * MiB, WS_OB = 426 * MiB, WS_END = 490 * MiB;
constexpr size_t WS_OF = WS_H1, WS_T1 = WS_GQ  , WS_H2 = WS_H1, WS_MRG = WS_GV, WS_ACT = WS_Q, WS_X1 = WS_OB  ;
constexpr int LDS_BYTES = 147456;
constexpr int NPH = 11;
constexpr int WI_IN = 16 * 216, WI_PROJ = WI_IN + 3 * 16 * 32, WI_ALL = WI_PROJ + 16 * 176 + 44 * 32;

typedef unsigned short u16;
typedef unsigned v4u __attribute__((ext_vector_type(4)));
typedef unsigned v2u __attribute__((ext_vector_type(2)));
typedef float f32x4 __attribute__((ext_vector_type(4)));
#define LAS __attribute__((address_space(3)))

struct Args { const float* in[21]; float* out; unsigned char* ws; int ph_lo, ph_hi; };

__device__ __forceinline__ float bf2f(u16 u) { return __uint_as_float((unsigned)u << 16); }
typedef float f32x2_t __attribute__((ext_vector_type(2))); typedef __bf16 bf16x2_t __attribute__((ext_vector_type(2)));
__device__ __forceinline__ unsigned pk2(float lo, float hi) { f32x2_t v = {lo, hi}; bf16x2_t b = __builtin_convertvector(v, bf16x2_t); return __builtin_bit_cast(unsigned, b); }
__device__ __forceinline__ u16 f2bf(float f) { return (u16)(pk2(f, 0.f) & 0xffffu); }
__device__ __forceinline__ float wave_sum(float v) {
#pragma unroll
    for (int o = 1; o < 64; o <<= 1) v += __shfl_xor(v, o);
    return v;
}
__device__ __forceinline__ float sigmoidf_(float x) { return 1.f / (1.f + __expf(-x)); }

struct EpiInProj {
    static constexpr bool PERM = true, AFTER_DRAIN = false;
    unsigned char* ws; u16* MG;
    __device__ __forceinline__ void operator()(const pg8::f32x4 (&acc)[2][2][4][2], const pg8::Unit& u, int wr, int wc, int fr, int fq) const {
        const int b = u.pm / 9, j = u.pm % 9, pn = u.pn; const bool isctx = (j == 0);
        const long rall = (long)u.pm * 256, rlat = (long)b * T + (j - 1) * 256;
        u16* base; int ld, colt; long row0;
        if (pn < 4)       { if (isctx) return; base = (u16*)(ws + WS_Q);  ld = 1024; colt = pn * 256;        row0 = rlat; }
        else if (pn == 4) {                    base = (u16*)(ws + WS_K);  ld = 256;  colt = 0;               row0 = rall; }
        else if (pn == 5) {                    base = (u16*)(ws + WS_V);  ld = 256;  colt = 0;               row0 = rall; }
        else if (pn < 8)  { if (isctx) return; base = (u16*)(ws + WS_GQ); ld = 512;  colt = (pn - 6) * 256;  row0 = rall; }
        else if (pn < 10) {                    base = (u16*)(ws + WS_GK); ld = 512;  colt = (pn - 8) * 256;  row0 = rall; }
        else if (pn < 14) {                    base = (u16*)(ws + WS_GV); ld = 1024; colt = (pn - 10) * 256; row0 = rall; }
        else if (pn < 18) { if (isctx) return; base = (u16*)(ws + WS_GG); ld = 1024; colt = (pn - 14) * 256; row0 = rlat; }
        else if (pn < 26) { if (isctx) return; base = MG;                 ld = 2048; colt = (pn - 18) * 256; row0 = rlat; }
        else              {                    base = (u16*)(ws + WS_LR); ld = 32;   colt = 0;               row0 = rall; }
        const bool lr = (pn == 26);
        if (lr && wc != 0) return;
        const int col0 = colt + wc * 32 + 8 * fq;
#pragma unroll
        for (int ai = 0; ai < 2; ++ai)
#pragma unroll
            for (int m = 0; m < 4; ++m) { u16* rowp = base + (size_t)(row0 + ai * 128 + wr * 64 + m * 16 + fr) * ld + col0;
#pragma unroll
                for (int bj = 0; bj < 2; ++bj) { if (lr && bj) continue;
                    const pg8::f32x4 v0 = acc[ai][bj][m][0], v1 = acc[ai][bj][m][1];
                    v4u w; w.x = pk2(v0[0], v0[1]); w.y = pk2(v0[2], v0[3]); w.z = pk2(v1[0], v1[1]); w.w = pk2(v1[2], v1[3]);
                    *(v4u*)(rowp + bj * 128) = w; } }
    }
};
struct InProjOrder {
    pg8::StaticOrder so; int G, c;
    __device__ void init(int G_, int c_) { so.init(128 * 256, 26 * 256, G_, c_); G = G_; c = c_; }
    __device__ bool next(int i, pg8::Unit& u) const {
        if (so.next(i, u)) { u.pm = (u.pm >> 3) * 9 + 1 + (u.pm & 7); return true; }
        const long q = (long)i * G + c - 3328; if (q < 0 || q >= 128) return false;
        const int b = (int)(q >> 3), t = (int)(q & 7);
        u.pm = b * 9; u.pn = t == 0 ? 4 : (t == 1 ? 5 : (t < 4 ? 6 + t : 6 + t)); return true;
    }
    __device__ __forceinline__ void a_ready(const pg8::Unit&) const {}
    __device__ __forceinline__ void done(const pg8::Unit&) const {}
};
template <int MODE> struct EpiMerge {
    static constexpr bool PERM = true, AFTER_DRAIN = false;
    const u16* MG; u16* T1; u16* MRG;
    __device__ __forceinline__ void operator()(const pg8::f32x4 (&acc)[2][2][4][2], const pg8::Unit& u, int wr, int wc, int fr, int fq) const {
        const int col0 = u.pn * 256 + wc * 32 + 8 * fq;
#pragma unroll
        for (int ai = 0; ai < 2; ++ai) {
            v4u gwv[4][2], twv[4][2];
#pragma unroll
            for (int m = 0; m < 4; ++m) { const size_t row = (size_t)u.pm * 256 + ai * 128 + wr * 64 + m * 16 + fr;
#pragma unroll
                for (int bj = 0; bj < 2; ++bj) { const int col = col0 + bj * 128;
                    gwv[m][bj] = __builtin_nontemporal_load((const v4u*)(MG + row * 2048 + MODE * 1024 + col));
                    twv[m][bj] = (MODE == 1) ? __builtin_nontemporal_load((const v4u*)(T1 + row * 1024 + col)) : (v4u){0u, 0u, 0u, 0u}; } }
#pragma unroll
            for (int m = 0; m < 4; ++m) { const size_t row = (size_t)u.pm * 256 + ai * 128 + wr * 64 + m * 16 + fr;
#pragma unroll
                for (int bj = 0; bj < 2; ++bj) { const int col = col0 + bj * 128;
                    const pg8::f32x4 v0 = acc[ai][bj][m][0], v1 = acc[ai][bj][m][1];
                    const float r[8] = {v0[0], v0[1], v0[2], v0[3], v1[0], v1[1], v1[2], v1[3]};
                    const unsigned gws[4] = {gwv[m][bj].x, gwv[m][bj].y, gwv[m][bj].z, gwv[m][bj].w};
                    const unsigned tws[4] = {twv[m][bj].x, twv[m][bj].y, twv[m][bj].z, twv[m][bj].w};
                    unsigned ow[4];
#pragma unroll
                    for (int e = 0; e < 4; ++e) {
                        float a0 = sigmoidf_(bf2f((u16)(gws[e] & 0xffffu))) * r[2 * e], a1 = sigmoidf_(bf2f((u16)(gws[e] >> 16))) * r[2 * e + 1];
                        if (MODE == 1) { a0 += bf2f((u16)(tws[e] & 0xffffu)); a1 += bf2f((u16)(tws[e] >> 16)); }
                        ow[e] = pk2(a0, a1); }
                    v4u w = {ow[0], ow[1], ow[2], ow[3]};
                    *(v4u*)((MODE == 0 ? T1 : MRG) + row * 1024 + col) = w; } }
        }
    }
};
struct EpiGateRes {
    static constexpr bool PERM = true, AFTER_DRAIN = false;
    const float* base; float* out; const float* gate;
    __device__ __forceinline__ void operator()(const pg8::f32x4 (&acc)[2][2][4][2], const pg8::Unit& u, int wr, int wc, int fr, int fq) const {
        const int col0 = u.pn * 256 + wc * 32 + 8 * fq; const int b = (u.pm * 256) / T;
        pg8::f32x4 gv[2][2];
#pragma unroll
        for (int bj = 0; bj < 2; ++bj)
#pragma unroll
            for (int n = 0; n < 2; ++n) gv[bj][n] = *(const pg8::f32x4*)(gate + (size_t)b * 6144 + col0 + bj * 128 + n * 4);
#pragma unroll
        for (int ai = 0; ai < 2; ++ai)
#pragma unroll
            for (int m = 0; m < 4; ++m) { const size_t off = ((size_t)u.pm * 256 + ai * 128 + wr * 64 + m * 16 + fr) * DM + col0;
#pragma unroll
                for (int bj = 0; bj < 2; ++bj)
#pragma unroll
                    for (int n = 0; n < 2; ++n) { const pg8::f32x4 bs = *(const pg8::f32x4*)(base + off + bj * 128 + n * 4);
                        *(pg8::f32x4*)(out + off + bj * 128 + n * 4) = bs + gv[bj][n] * acc[ai][bj][m][n]; } }
    }
};
template <bool IN_BF16> struct EpiGateResB {
    static constexpr bool PERM = true, AFTER_DRAIN = false;
    const void* base; void* out; const float* gate;
    __device__ __forceinline__ void operator()(const pg8::f32x4 (&acc)[2][2][4][2], const pg8::Unit& u, int wr, int wc, int fr, int fq) const {
        const int col0 = u.pn * 256 + wc * 32 + 8 * fq; const int b = (u.pm * 256) / T;
        pg8::f32x4 gv[2][2];
#pragma unroll
        for (int bj = 0; bj < 2; ++bj)
#pragma unroll
            for (int n = 0; n < 2; ++n) gv[bj][n] = *(const pg8::f32x4*)(gate + (size_t)b * 6144 + col0 + bj * 128 + n * 4);
#pragma unroll
        for (int ai = 0; ai < 2; ++ai) {
            pg8::f32x4 bs[4][2][2]; v4u bw[4][2];
#pragma unroll
            for (int m = 0; m < 4; ++m) { const size_t off = ((size_t)u.pm * 256 + ai * 128 + wr * 64 + m * 16 + fr) * DM + col0;
#pragma unroll
                for (int bj = 0; bj < 2; ++bj) {
                    if (IN_BF16) bw[m][bj] = __builtin_nontemporal_load((const v4u*)((const u16*)base + off + bj * 128));
                    else { bs[m][bj][0] = __builtin_nontemporal_load((const pg8::f32x4*)((const float*)base + off + bj * 128)); bs[m][bj][1] = __builtin_nontemporal_load((const pg8::f32x4*)((const float*)base + off + bj * 128 + 4)); } } }
#pragma unroll
            for (int m = 0; m < 4; ++m) { const size_t off = ((size_t)u.pm * 256 + ai * 128 + wr * 64 + m * 16 + fr) * DM + col0;
#pragma unroll
                for (int bj = 0; bj < 2; ++bj) {
                    pg8::f32x4 b0, b1;
                    if (IN_BF16) { const v4u w = bw[m][bj];
                        b0 = (pg8::f32x4){bf2f((u16)(w.x & 0xffffu)), bf2f((u16)(w.x >> 16)), bf2f((u16)(w.y & 0xffffu)), bf2f((u16)(w.y >> 16))};
                        b1 = (pg8::f32x4){bf2f((u16)(w.z & 0xffffu)), bf2f((u16)(w.z >> 16)), bf2f((u16)(w.w & 0xffffu)), bf2f((u16)(w.w >> 16))}; }
                    else { b0 = bs[m][bj][0]; b1 = bs[m][bj][1]; }
                    const pg8::f32x4 o0 = b0 + gv[bj][0] * acc[ai][bj][m][0], o1 = b1 + gv[bj][1] * acc[ai][bj][m][1];
                    if (IN_BF16) { *(pg8::f32x4*)((float*)out + off + bj * 128) = o0; *(pg8::f32x4*)((float*)out + off + bj * 128 + 4) = o1; }
                    else { v4u w; w.x = pk2(o0[0], o0[1]); w.y = pk2(o0[2], o0[3]); w.z = pk2(o1[0], o1[1]); w.w = pk2(o1[2], o1[3]); *(v4u*)((u16*)out + off + bj * 128) = w; } } }
        }
    }
};
struct EpiSwiglu {
    static constexpr bool PERM = true, AFTER_DRAIN = false;
    u16* ACT;
    __device__ __forceinline__ void operator()(const pg8::f32x4 (&acc)[2][2][4][2], const pg8::Unit& u, int wr, int wc, int fr, int fq) const {
        const int col0 = u.pn * 128 + wc * 32 + 8 * fq;
#pragma unroll
        for (int ai = 0; ai < 2; ++ai)
#pragma unroll
            for (int m = 0; m < 4; ++m) { const size_t row = (size_t)u.pm * 256 + ai * 128 + wr * 64 + m * 16 + fr;
                unsigned ow[4];
#pragma unroll
                for (int n = 0; n < 2; ++n) { const pg8::f32x4 av = acc[ai][0][m][n], bv = acc[ai][1][m][n];
                    float s[4];
#pragma unroll
                    for (int e = 0; e < 4; ++e) s[e] = av[e] * sigmoidf_(av[e]) * bv[e];
                    ow[2 * n] = pk2(s[0], s[1]); ow[2 * n + 1] = pk2(s[2], s[3]); }
                v4u w = {ow[0], ow[1], ow[2], ow[3]};
                *(v4u*)(ACT + row * DFF + col0) = w; }
    }
};
__device__ __forceinline__ void p_adaln(const Args& a, unsigned char* lds, const int mk_wid) {
    float* sl = (float*)lds;
    float* part = (float*)(lds + 17 * 1024 * 4);
    const int tid = MK_TID;
    const float* c = a.in[1]; const float* cctx = a.in[3]; const float* W = a.in[4]; const float* bada = a.in[5];
    float* MOD = (float*)(a.ws + WS_MOD);
    for (int i = tid; i < 17 * 1024; i += 512) { const float v = (i < 16 * 1024) ? c[i] : cctx[i - 16 * 1024]; sl[i] = v / (1.f + expf(-v)); }
    __syncthreads();
    for (int w = blockIdx.x; w < 192; w += gridDim.x) {
        const int col = w * 32 + (tid & 31), kg = tid >> 5;
        float acc[17];
#pragma unroll
        for (int v = 0; v < 17; ++v) acc[v] = 0.f;
        for (int kk = 0; kk < 64; kk += 8) { const int k = kg * 64 + kk; float wv[8];
#pragma unroll
            for (int j = 0; j < 8; ++j) wv[j] = __builtin_nontemporal_load(W + (size_t)(k + j) * 6144 + col);
#pragma unroll
            for (int v = 0; v < 17; ++v)
#pragma unroll
                for (int j4 = 0; j4 < 2; ++j4) { const f32x4 s4 = *(const f32x4*)(sl + v * 1024 + k + 4 * j4);
                    acc[v] += (s4.x * wv[4 * j4] + s4.y * wv[4 * j4 + 1]) + (s4.z * wv[4 * j4 + 2] + s4.w * wv[4 * j4 + 3]); } }
#pragma unroll
        for (int v = 0; v < 17; ++v) part[(kg * 17 + v) * 32 + (tid & 31)] = acc[v];
        __syncthreads();
        for (int i = tid; i < 17 * 32; i += 512) { const int v = i >> 5, cl = i & 31; float s = bada[w * 32 + cl];
            for (int g = 0; g < 16; ++g) s += part[(g * 17 + v) * 32 + cl];
            MOD[v * 6144 + w * 32 + cl] = s; }
        __syncthreads();
    }
}

__device__ __forceinline__ void transpose_item(const float* W, int ldw, int src_n0, int k0, u16* WT, int K, int dst_n0, bool zero, float* scr, int lane) {
    { const int kr = lane >> 3, n4 = (lane & 7) * 4; f32x4 v[8];
#pragma unroll
      for (int i = 0; i < 8; ++i) v[i] = zero ? (f32x4){0.f, 0.f, 0.f, 0.f} : __builtin_nontemporal_load((const f32x4*)(W + (size_t)(k0 + 8 * i + kr) * ldw + src_n0 + n4));
#pragma unroll
      for (int i = 0; i < 8; ++i) { float* d = scr + (8 * i + kr) * 33 + n4; d[0] = v[i].x; d[1] = v[i].y; d[2] = v[i].z; d[3] = v[i].w; } }
    asm volatile("s_waitcnt lgkmcnt(0)" ::: "memory");
    const int c = lane & 7;
#pragma unroll
    for (int j = 0; j < 4; ++j) { const int n = (lane >> 3) + 8 * j; const float* s = scr + (8 * c) * 33 + n;
        v4u o; o.x = pk2(s[0 * 33], s[1 * 33]); o.y = pk2(s[2 * 33], s[3 * 33]); o.z = pk2(s[4 * 33], s[5 * 33]); o.w = pk2(s[6 * 33], s[7 * 33]);
        *(v4u*)(WT + (size_t)(dst_n0 + n) * K + k0 + 8 * c) = o; }
    asm volatile("s_waitcnt lgkmcnt(0)" ::: "memory");
}
__device__ __forceinline__ void norm_mod_row2(const float* xrow0, const float* xrow1, const float* g, const float* shift0, const float* scale0, const float* shift1, const float* scale1, u16* orow0, u16* orow1, int lane) {
    const f32x4* xr0 = (const f32x4*)xrow0 + lane; const f32x4* xr1 = (const f32x4*)xrow1 + lane;
    f32x4 v0[4], v1[4]; float s0 = 0.f, s1 = 0.f;
#pragma unroll
    for (int j = 0; j < 4; ++j) { v0[j] = __builtin_nontemporal_load(xr0 + 64 * j); v1[j] = __builtin_nontemporal_load(xr1 + 64 * j); }
#pragma unroll
    for (int j = 0; j < 4; ++j) { s0 += (v0[j].x * v0[j].x + v0[j].y * v0[j].y) + (v0[j].z * v0[j].z + v0[j].w * v0[j].w); s1 += (v1[j].x * v1[j].x + v1[j].y * v1[j].y) + (v1[j].z * v1[j].z + v1[j].w * v1[j].w); }
#pragma unroll
    for (int o = 1; o < 64; o <<= 1) { s0 += __shfl_xor(s0, o); s1 += __shfl_xor(s1, o); }
    const float r0 = rsqrtf(s0 * (1.f / DM) + EPS), r1 = rsqrtf(s1 * (1.f / DM) + EPS);
    unsigned long long* o80 = (unsigned long long*)orow0 + lane; unsigned long long* o81 = (unsigned long long*)orow1 + lane;
#pragma unroll
    for (int j = 0; j < 4; ++j) { const f32x4 gg = ((const f32x4*)g)[lane + 64 * j];
        const f32x4 sh0 = ((const f32x4*)shift0)[lane + 64 * j], sc0 = ((const f32x4*)scale0)[lane + 64 * j], sh1 = ((const f32x4*)shift1)[lane + 64 * j], sc1 = ((const f32x4*)scale1)[lane + 64 * j];
        const f32x4 y0 = (v0[j] * r0 * gg) * (sc0 + 1.f) + sh0, y1 = (v1[j] * r1 * gg) * (sc1 + 1.f) + sh1;
        o80[64 * j] = (unsigned long long)pk2(y0.x, y0.y) | ((unsigned long long)pk2(y0.z, y0.w) << 32);
        o81[64 * j] = (unsigned long long)pk2(y1.x, y1.y) | ((unsigned long long)pk2(y1.z, y1.w) << 32); }
}
__device__ __forceinline__ void norm_mod_row2_bf(const u16* xrow0, const u16* xrow1, const float* g, const float* shift, const float* scale, u16* orow0, u16* orow1, int lane) {
    v4u w0[2], w1[2]; float x0[2][8], x1[2][8]; float s0 = 0.f, s1 = 0.f;
#pragma unroll
    for (int j = 0; j < 2; ++j) { w0[j] = *(const v4u*)(xrow0 + 512 * j + 8 * lane); w1[j] = *(const v4u*)(xrow1 + 512 * j + 8 * lane); }
#pragma unroll
    for (int j = 0; j < 2; ++j) { const unsigned a_[4] = {w0[j].x, w0[j].y, w0[j].z, w0[j].w}, b_[4] = {w1[j].x, w1[j].y, w1[j].z, w1[j].w};
#pragma unroll
        for (int e = 0; e < 4; ++e) { x0[j][2 * e] = bf2f((u16)(a_[e] & 0xffffu)); x0[j][2 * e + 1] = bf2f((u16)(a_[e] >> 16)); x1[j][2 * e] = bf2f((u16)(b_[e] & 0xffffu)); x1[j][2 * e + 1] = bf2f((u16)(b_[e] >> 16)); }
#pragma unroll
        for (int e = 0; e < 8; ++e) { s0 += x0[j][e] * x0[j][e]; s1 += x1[j][e] * x1[j][e]; } }
#pragma unroll
    for (int o = 1; o < 64; o <<= 1) { s0 += __shfl_xor(s0, o); s1 += __shfl_xor(s1, o); }
    const float r0 = rsqrtf(s0 * (1.f / DM) + EPS), r1 = rsqrtf(s1 * (1.f / DM) + EPS);
#pragma unroll
    for (int j = 0; j < 2; ++j) { const int c0 = 512 * j + 8 * lane; float y0[8], y1[8];
#pragma unroll
        for (int h4 = 0; h4 < 2; ++h4) { const f32x4 gg = *(const f32x4*)(g + c0 + 4 * h4), sh = *(const f32x4*)(shift + c0 + 4 * h4), sc = *(const f32x4*)(scale + c0 + 4 * h4);
#pragma unroll
            for (int e = 0; e < 4; ++e) { y0[4 * h4 + e] = (x0[j][4 * h4 + e] * r0 * gg[e]) * (sc[e] + 1.f) + sh[e]; y1[4 * h4 + e] = (x1[j][4 * h4 + e] * r1 * gg[e]) * (sc[e] + 1.f) + sh[e]; } }
        v4u o0 = {pk2(y0[0], y0[1]), pk2(y0[2], y0[3]), pk2(y0[4], y0[5]), pk2(y0[6], y0[7])}, o1 = {pk2(y1[0], y1[1]), pk2(y1[2], y1[3]), pk2(y1[4], y1[5]), pk2(y1[6], y1[7])};
        *(v4u*)(orow0 + c0) = o0; *(v4u*)(orow1 + c0) = o1; }
}
__device__ __forceinline__ void p_weights(const Args& a, unsigned char* lds, const int mk_wid, const int item_lo, const int item_hi, const int blk_lo, const bool do_rope) {
    const int tid = MK_TID, lane = tid & 63, wave = mk_wid;
    float* scr = (float*)(lds + wave * 16384);
    if ((int)blockIdx.x < blk_lo) return;
    const int gw = ((int)blockIdx.x - blk_lo) * 8 + wave, NGW = ((int)gridDim.x - blk_lo) * 8;
    unsigned char* ws = a.ws;
    constexpr int I_IN = 16 * 216, I_SQ = 16 * 32, I_FI = 16 * 176, I_FO = 44 * 32;
    constexpr int NITEMS = I_IN + 3 * I_SQ + I_FI + I_FO;
    for (int it = item_lo + gw; it < (item_hi < NITEMS ? item_hi : NITEMS); it += NGW) {
        int r = it;
        if (r < I_IN) { const int kb = r / 216, nb = r % 216, n0 = 32 * nb; const bool zero = n0 >= 6688;
            const int src = n0 < 4608 ? n0 : (n0 < 6656 ? n0 + 32 : n0 - 2048);
            transpose_item(a.in[7], 6688, zero ? 0 : src, 64 * kb, (u16*)(ws + WS_WIN), 1024, n0, zero, scr, lane); continue; }
        r -= I_IN;
        if (r < 3 * I_SQ) { const int which = r / I_SQ, q = r % I_SQ, kb = q / 32, nb = q % 32;
            const float* W = which == 0 ? a.in[15] : (which == 1 ? a.in[16] : a.in[17]);
            u16* WT = (u16*)(ws + (which == 0 ? WS_WAP : (which == 1 ? WS_WGP : WS_WOUT)));
            transpose_item(W, 1024, 32 * nb, 64 * kb, WT, 1024, 32 * nb, false, scr, lane); continue; }
        r -= 3 * I_SQ;
        if (r < I_FI) { const int kb = r / 176, nb = r % 176, n0 = 32 * nb, pn = n0 >> 8, j = n0 & 255;
            const int src = j < 128 ? pn * 128 + j : DFF + pn * 128 + (j - 128);
            transpose_item(a.in[19], 2 * DFF, src, 64 * kb, (u16*)(ws + WS_WFI), 1024, n0, false, scr, lane); continue; }
        r -= I_FI;
        { const int kb = r / 32, nb = r % 32; transpose_item(a.in[20], 1024, 32 * nb, 64 * kb, (u16*)(ws + WS_WFO), DFF, 32 * nb, false, scr, lane); }
    }
    float* rope = (float*)(ws + WS_ROPE);
    if (do_rope) for (int idx = blockIdx.x * 512 + tid; idx < T * 64; idx += gridDim.x * 512) { const int t = idx >> 6, i = idx & 63, j = i & 31;
        const float pos = (float)(i < 32 ? (t >> 6) : (t & 63));
        const float inv = 1.0f / powf(10000.f, (float)(2 * j) / 64.f);
        const float ang = pos * inv;
        rope[2 * idx] = cosf(ang); rope[2 * idx + 1] = sinf(ang); }
}

__device__ __forceinline__ void p_h1rows(const Args& a, const int mk_wid) {
    const int tid = MK_TID, lane = tid & 63, wave = mk_wid;
    const int gw = blockIdx.x * 8 + wave, NGW = gridDim.x * 8;
    unsigned char* ws = a.ws;
    const float* MOD = (const float*)(ws + WS_MOD);
    for (int m0 = gw * 2; m0 < MALL; m0 += NGW * 2) {
        const float* src[2]; const float* mod[2];
#pragma unroll
        for (int e = 0; e < 2; ++e) { const int m = m0 + e, b = m / TA, r = m % TA; const bool isc = r < TC;
            src[e] = isc ? a.in[2] + ((size_t)b * TC + r) * DM : a.in[0] + ((size_t)b * T + (r - TC)) * DM; mod[e] = MOD + (size_t)(isc ? 16 : b) * 6144; }
        norm_mod_row2(src[0], src[1], a.in[6], mod[0], mod[0] + 1024, mod[1], mod[1] + 1024, (u16*)(ws + WS_H1) + (size_t)m0 * DM, (u16*)(ws + WS_H1) + (size_t)(m0 + 1) * DM, lane); }
}

__device__ __forceinline__ void p_lowrank(const Args& a, unsigned char* lds, const int mk_wid) {
    const int tid = MK_TID, lane = tid & 63, r32 = lane & 31, hi = lane >> 5;
    constexpr int WP = 1032, APT = 136;
    u16* wl = (u16*)lds; u16* al = (u16*)(lds + 32 * WP * 2);
    const u16* H1 = (const u16*)(a.ws + WS_H1); const u16* WL = (const u16*)(a.ws + WS_WIN) + (size_t)6656 * 1024; u16* LR = (u16*)(a.ws + WS_LR);
    const int rb0 = (int)gridDim.x >= 256 ? (int)blockIdx.x - ((int)gridDim.x - MALL / 256) : (int)blockIdx.x;
    if (rb0 < 0 || rb0 >= MALL / 256) return;
#pragma unroll
    for (int p = 0; p < 8; ++p) { const int piece = p * 512 + tid, row = piece >> 7, c8 = piece & 127; *(v4u*)(wl + row * WP + c8 * 8) = *(const v4u*)(WL + (size_t)row * 1024 + c8 * 8); }
    for (int rb = rb0; rb < MALL / 256; rb += gridDim.x) {
        const u16* Ab = H1 + (size_t)rb * 256 * 1024;
        v4u st[8];
#pragma unroll
        for (int p = 0; p < 8; ++p) { const int piece = p * 512 + tid, row = piece >> 4, c8 = piece & 15; st[p] = *(const v4u*)(Ab + (size_t)row * 1024 + c8 * 8); }
        att::f32x16 acc = att::f32x16{};
        for (int kc = 0; kc < 8; ++kc) {
            __syncthreads();
#pragma unroll
            for (int p = 0; p < 8; ++p) { const int piece = p * 512 + tid, row = piece >> 4, c8 = piece & 15; *(v4u*)(al + row * APT + c8 * 8) = st[p]; }
            if (kc + 1 < 8) {
#pragma unroll
                for (int p = 0; p < 8; ++p) { const int piece = p * 512 + tid, row = piece >> 4, c8 = piece & 15; st[p] = *(const v4u*)(Ab + (size_t)row * 1024 + (kc + 1) * 128 + c8 * 8); } }
            __syncthreads();
            const u16* ap = al + (mk_wid * 32 + r32) * APT + 8 * hi; const u16* bp = wl + r32 * WP + kc * 128 + 8 * hi;
#pragma unroll
            for (int kb = 0; kb < 8; ++kb) acc = __builtin_amdgcn_mfma_f32_32x32x16_bf16(*(const att::bf16x8*)(ap + kb * 16), *(const att::bf16x8*)(bp + kb * 16), acc, 0, 0, 0);
        }
#pragma unroll
        for (int r = 0; r < 16; ++r) LR[(size_t)(rb * 256 + mk_wid * 32 + att::crow(r, hi)) * 32 + r32] = f2bf(acc[r]);
    }
    __syncthreads();
}
__device__ __forceinline__ void p_kprep(const Args& a, const int mk_wid) {
    const int tid = MK_TID, lane = tid & 63, wave = mk_wid;
    const int gw = blockIdx.x * 8 + wave, NGW = gridDim.x * 8;
    u16* Kb = (u16*)(a.ws + WS_K); const float* rope = (const float*)(a.ws + WS_ROPE); const float* kg = a.in[9];
    const int head = lane >> 5, l = lane & 31;
    const f32x4 g = *(const f32x4*)(kg + 4 * l);
    for (int m0 = gw * 6; m0 < MALL; m0 += NGW * 6) {
        v2u w[6]; f32x4 cs[6]; float f[6][4], s[6];
#pragma unroll
        for (int e = 0; e < 6; ++e) { const int m = m0 + e, r = m % TA; w[e] = *(const v2u*)(Kb + (size_t)m * 256 + head * 128 + 4 * l);
            cs[e] = (r >= TC) ? *(const f32x4*)(rope + ((size_t)(r - TC) * 64 + 2 * l) * 2) : (f32x4){1.f, 0.f, 1.f, 0.f}; }
#pragma unroll
        for (int e = 0; e < 6; ++e) { f[e][0] = bf2f((u16)(w[e].x & 0xffffu)); f[e][1] = bf2f((u16)(w[e].x >> 16)); f[e][2] = bf2f((u16)(w[e].y & 0xffffu)); f[e][3] = bf2f((u16)(w[e].y >> 16));
            s[e] = (f[e][0] * f[e][0] + f[e][1] * f[e][1]) + (f[e][2] * f[e][2] + f[e][3] * f[e][3]); }
#pragma unroll
        for (int o = 1; o < 32; o <<= 1) {
#pragma unroll
            for (int e = 0; e < 6; ++e) s[e] += __shfl_xor(s[e], o); }
#pragma unroll
        for (int e = 0; e < 6; ++e) { const float rinv = rsqrtf(s[e] * (1.f / 128.f) + EPS);
            const float f0 = f[e][0] * rinv * g.x, f1 = f[e][1] * rinv * g.y, f2 = f[e][2] * rinv * g.z, f3 = f[e][3] * rinv * g.w;
            v2u o; o.x = pk2(f0 * cs[e].x - f1 * cs[e].y, f0 * cs[e].y + f1 * cs[e].x); o.y = pk2(f2 * cs[e].z - f3 * cs[e].w, f2 * cs[e].w + f3 * cs[e].z);
            *(v2u*)(Kb + (size_t)(m0 + e) * 256 + head * 128 + 4 * l) = o; } }
}
__device__ __forceinline__ void p_glapost(const Args& a, const int mk_wid) {
    const int tid = MK_TID, lane = tid & 63, wave = mk_wid;
    const int gw = blockIdx.x * 8 + wave, NGW = gridDim.x * 8;
    const u16* OF = (const u16*)(a.ws + WS_OF); const u16* OB = (const u16*)(a.ws + WS_OB); u16* GG = (u16*)(a.ws + WS_GG);
    const f32x4 g = *(const f32x4*)(a.in[14] + 4 * lane);
    for (int it0 = gw * 4; it0 < MLAT * 4; it0 += NGW * 4) {
        v2u wf[4], wb[4], wg[4]; float o_[4][4], ss[4];
#pragma unroll
        for (int e = 0; e < 4; ++e) { const size_t off = (size_t)(it0 + e) * 256 + 4 * lane; wf[e] = __builtin_nontemporal_load((const v2u*)(OF + off)); wb[e] = __builtin_nontemporal_load((const v2u*)(OB + off)); wg[e] = __builtin_nontemporal_load((const v2u*)(GG + off)); }
#pragma unroll
        for (int e = 0; e < 4; ++e) {
            o_[e][0] = bf2f((u16)(wf[e].x & 0xffffu)) + bf2f((u16)(wb[e].x & 0xffffu)); o_[e][1] = bf2f((u16)(wf[e].x >> 16)) + bf2f((u16)(wb[e].x >> 16));
            o_[e][2] = bf2f((u16)(wf[e].y & 0xffffu)) + bf2f((u16)(wb[e].y & 0xffffu)); o_[e][3] = bf2f((u16)(wf[e].y >> 16)) + bf2f((u16)(wb[e].y >> 16));
            ss[e] = (o_[e][0] * o_[e][0] + o_[e][1] * o_[e][1]) + (o_[e][2] * o_[e][2] + o_[e][3] * o_[e][3]); }
#pragma unroll
        for (int o = 1; o < 64; o <<= 1) {
#pragma unroll
            for (int e = 0; e < 4; ++e) ss[e] += __shfl_xor(ss[e], o); }
#pragma unroll
        for (int e = 0; e < 4; ++e) { const float rinv = rsqrtf(ss[e] * (1.f / 256.f) + EPS);
            const float g0 = bf2f((u16)(wg[e].x & 0xffffu)), g1 = bf2f((u16)(wg[e].x >> 16)), g2 = bf2f((u16)(wg[e].y & 0xffffu)), g3 = bf2f((u16)(wg[e].y >> 16));
            v2u o; o.x = pk2(o_[e][0] * rinv * g.x * (g0 * sigmoidf_(g0)), o_[e][1] * rinv * g.y * (g1 * sigmoidf_(g1)));
            o.y = pk2(o_[e][2] * rinv * g.z * (g2 * sigmoidf_(g2)), o_[e][3] * rinv * g.w * (g3 * sigmoidf_(g3)));
            *(v2u*)(GG + (size_t)(it0 + e) * 256 + 4 * lane) = o; } }
}
__device__ __forceinline__ void p_h2(const Args& a, const int mk_wid) {
    const int tid = MK_TID, lane = tid & 63, wave = mk_wid;
    const int gw = blockIdx.x * 8 + wave, NGW = gridDim.x * 8;
    const float* MOD = (const float*)(a.ws + WS_MOD);
    const u16* X1 = (const u16*)(a.ws + WS_X1);
    for (int m0 = gw * 2; m0 < MLAT; m0 += NGW * 2) { const float* mod = MOD + (size_t)(m0 / T) * 6144;
        norm_mod_row2_bf(X1 + (size_t)m0 * DM, X1 + (size_t)(m0 + 1) * DM, a.in[18], mod + 3 * 1024, mod + 4 * 1024,
                         (u16*)(a.ws + WS_H2) + (size_t)m0 * DM, (u16*)(a.ws + WS_H2) + (size_t)(m0 + 1) * DM, lane); }
}
namespace gla {
using att::bf16x8; using att::s16x4; using att::f32x16; using att::crow; using att::v_st; using att::v_rd_base; using att::v_rd_off; using att::tr_read;
constexpr int QP = 136, AP = 72;
constexpr int L_QE = 0, L_KE = 17408, L_KD = 34816, L_V = 51200, L_AM = 83968, L_LAS = 93184, L_LR = 125952, L_GS = 128000, L_DL = 130048, L_END = 130560;
static_assert(L_END <= LDS_BYTES - 64, "GLA LDS map");
#define GLA_PK(L, H) (bf16x8){L[0], L[1], L[2], L[3], H[0], H[1], H[2], H[3]}
#define GLA_SBAR() __builtin_amdgcn_sched_barrier(0)
#define OPAQUE_TID(name) int name = MK_TID; asm volatile("" : "+v"(name))

__device__ __forceinline__ void scan_unit(const int unit, const Args& a, unsigned char* lds, const int mk_wid) {
    const int wid = mk_wid;
    const int dir = unit & 1, h = (unit >> 1) & 3, b = unit >> 3;
    const int vt = wid;
    const u16* GQ = (const u16*)(a.ws + WS_GQ); const u16* GK = (const u16*)(a.ws + WS_GK); const u16* GV = (const u16*)(a.ws + WS_GV); const u16* LR = (const u16*)(a.ws + WS_LR);
    u16* OUT = (u16*)(a.ws + (dir ? WS_OB : WS_OF));
    bf16x8 upf; float biasc;
    { const int l_ = MK_TID & 63, r32 = l_ & 31, hi = l_ >> 5; const float* up = a.in[dir ? 12 : 10] + (size_t)(8 * hi) * 512 + h * 128 + (wid & 3) * 32 + r32;
      v4u w; w.x = pk2(up[0], up[512]); w.y = pk2(up[2 * 512], up[3 * 512]); w.z = pk2(up[4 * 512], up[5 * 512]); w.w = pk2(up[6 * 512], up[7 * 512]);
      upf = __builtin_bit_cast(bf16x8, w); biasc = a.in[dir ? 13 : 11][h * 128 + (wid & 3) * 32 + r32]; }
    u16* qe = (u16*)(lds + L_QE); u16* ke = (u16*)(lds + L_KE); u16* am = (u16*)(lds + L_AM);
    float* las = (float*)(lds + L_LAS); float* gs = (float*)(lds + L_GS); float* dl = (float*)(lds + L_DL);
    const int ldsb = (int)(uintptr_t)lds;
    u16* ot = (u16*)(lds + L_LAS);
    int pend_cc = -1;
#define GLA_FLUSH() do { if (pend_cc >= 0) { OPAQUE_TID(tf_); const size_t rl0_ = (size_t)b * T + (size_t)(pend_cc - 4) * 64; \
      _Pragma("unroll") for (int p = 0; p < 4; ++p) { const int idx_ = p * 512 + tf_, i_ = idx_ >> 5, c16_ = idx_ & 31; \
          *(v4u*)(OUT + (rl0_ + (dir ? 63 - i_ : i_)) * 1024 + h * 256 + c16_ * 8) = *(const v4u*)(ot + i_ * 256 + c16_ * 8); } } } while (0)
    f32x16 S[4]; S[0] = f32x16{}; S[1] = f32x16{}; S[2] = f32x16{}; S[3] = f32x16{};
    bf16x8 qraw[2], kraw[2], vraw[4]; bf16x8 lraw = bf16x8{};
#define GLA_CHUNK(s) (dir ? ((s) < 4 ? 3 - (s) : 39 - (s)) : (s))
#define GLA_LOAD(s) do { OPAQUE_TID(t_); const int cc_ = GLA_CHUNK(s); const size_t rowb_ = (size_t)b * TA + (size_t)cc_ * 64; \
      _Pragma("unroll") for (int p = 0; p < 2; ++p) { const int i_ = p * 32 + (t_ >> 4); const size_t row_ = rowb_ + (dir ? 63 - i_ : i_); \
          kraw[p] = *(const bf16x8*)(GK + row_ * 512 + h * 128 + (t_ & 15) * 8); \
          qraw[p] = (cc_ >= 4) ? *(const bf16x8*)(GQ + row_ * 512 + h * 128 + (t_ & 15) * 8) : bf16x8{}; } \
      _Pragma("unroll") for (int p = 0; p < 4; ++p) { const int i_ = p * 16 + (t_ >> 5); const size_t row_ = rowb_ + (dir ? 63 - i_ : i_); \
          vraw[p] = *(const bf16x8*)(GV + row_ * 1024 + h * 256 + (t_ & 31) * 8); } \
      if (t_ < 128) { const int i_ = t_ >> 1; const size_t row_ = rowb_ + (dir ? 63 - i_ : i_); lraw = *(const bf16x8*)(LR + row_ * 32 + dir * 16 + (t_ & 1) * 8); } } while (0)
    GLA_LOAD(0);
    for (int step = 0; step < 36; ++step) {
        const int cc = GLA_CHUNK(step); const bool lat = cc >= 4;
        GLA_FLUSH();
        { OPAQUE_TID(t_);
#pragma unroll
          for (int p = 0; p < 2; ++p) { const int i_ = p * 32 + (t_ >> 4), c_ = (t_ & 15) * 8; *(bf16x8*)(qe + i_ * QP + c_) = qraw[p]; *(bf16x8*)(ke + i_ * QP + c_) = kraw[p]; }
#pragma unroll
          for (int p = 0; p < 4; ++p) { const int i_ = p * 16 + (t_ >> 5), c8 = t_ & 31; *(bf16x8*)(lds + L_V + (c8 >> 4) * 16384 + v_st(i_, (c8 & 15) * 8)) = vraw[p]; }
          if (t_ < 128) *(bf16x8*)(lds + L_LR + (t_ >> 1) * 32 + (t_ & 1) * 16) = lraw; }
        __syncthreads();
        { OPAQUE_TID(t_); const int lane = t_ & 63, r32 = lane & 31, hi = lane >> 5; const int tt = wid >> 2, ct = wid & 3;
          const bf16x8 af = *(const bf16x8*)(lds + L_LR + (tt * 32 + r32) * 32 + hi * 16);
          const f32x16 z = __builtin_amdgcn_mfma_f32_32x32x16_bf16(af, upf, f32x16{}, 0, 0, 0);
          float* lw = las + (tt * 32 + 4 * hi) * 128 + ct * 32 + r32;
#pragma unroll
          for (int r = 0; r < 16; ++r) { const float zz = z[r] + biasc;
              lw[crow(r, 0) * 128] = (fminf(zz, 0.f) - __builtin_amdgcn_logf(1.f + __builtin_amdgcn_exp2f(-1.4426950408889634f * fabsf(zz))) * 0.6931471805599453f) * (1.f / 16.f); } }
        __syncthreads();
        { OPAQUE_TID(t_); const int c = t_ & 127, g = t_ >> 7;
          float bl[16]; float run = 0.f;
          { const float* lp = las + (g * 16) * 128 + c;
#pragma unroll
            for (int ii = 0; ii < 16; ++ii) { run += lp[ii * 128]; bl[ii] = run; } }
          gs[g * 128 + c] = run;
          __syncthreads();
          const float g0 = gs[c], g1 = gs[128 + c], g2 = gs[256 + c], g3 = gs[384 + c];
          const float off = (g > 0 ? g0 : 0.f) + (g > 1 ? g1 : 0.f) + (g > 2 ? g2 : 0.f);
          const float btot = (g0 + g1) + (g2 + g3);
          const float dlc = __builtin_amdgcn_exp2f(btot * 1.4426950408889634f);
          if (g == 0) dl[c] = dlc;
          u16* qcol = qe + (g * 16) * QP + c; u16* kcol = ke + (g * 16) * QP + c; unsigned char* kdb = lds + L_KD + v_st(g * 16, c);
#pragma unroll
          for (int ii = 0; ii < 16; ++ii) { const float bb = bl[ii] + off;
              const float qf = bf2f(qcol[ii * QP]), kf = bf2f(kcol[ii * QP]);
              const float e = __builtin_amdgcn_exp2f(bb * 1.4426950408889634f), ker = kf * __builtin_amdgcn_rcpf(e);
              qcol[ii * QP] = f2bf(qf * (0.088388347648318440f * e));
              kcol[ii * QP] = f2bf(ker);
              *(u16*)(kdb + v_st(ii, 0)) = f2bf(ker * dlc); } }
        if (step + 1 < 36) GLA_LOAD(step + 1);
        __syncthreads();
        if (lat) {
            if (wid < 4) { OPAQUE_TID(t_); const int r32 = t_ & 31, hi = (t_ >> 5) & 1;
                const int jt = wid >> 1, it = wid & 1; f32x16 ct = f32x16{};
                const u16* kp = ke + (jt * 32 + r32) * QP + hi * 8; const u16* qp = qe + (it * 32 + r32) * QP + hi * 8;
#pragma unroll
                for (int kb = 0; kb < 8; ++kb) ct = __builtin_amdgcn_mfma_f32_32x32x16_bf16(*(const bf16x8*)(kp + kb * 16), *(const bf16x8*)(qp + kb * 16), ct, 0, 0, 0);
                const int i = it * 32 + r32;
#pragma unroll
                for (int rg = 0; rg < 4; ++rg) { const int j0 = jt * 32 + 8 * rg + 4 * hi;
                    const float x0 = (j0 + 0 <= i) ? ct[4 * rg + 0] : 0.f, x1 = (j0 + 1 <= i) ? ct[4 * rg + 1] : 0.f, x2 = (j0 + 2 <= i) ? ct[4 * rg + 2] : 0.f, x3 = (j0 + 3 <= i) ? ct[4 * rg + 3] : 0.f;
                    v2u w; w.x = pk2(x0, x1); w.y = pk2(x2, x3); *(v2u*)(am + i * AP + j0) = w; } }
            __syncthreads();
        }
        { OPAQUE_TID(t_); const int lane = t_ & 63, r32 = lane & 31, hi = lane >> 5;
          const int vb = ldsb + L_V + (vt >> 2) * 16384 + v_rd_base(lane) + (vt & 3) * 512;
          s16x4 vl0, vh0, vl1, vh1, vl2, vh2, vl3, vh3;
#define GLA_LOADV() do { vl0 = tr_read<v_rd_off(0, 0, 0)>(vb); vh0 = tr_read<v_rd_off(0, 0, 1)>(vb); vl1 = tr_read<v_rd_off(0, 1, 0)>(vb); vh1 = tr_read<v_rd_off(0, 1, 1)>(vb); \
              vl2 = tr_read<v_rd_off(0, 2, 0)>(vb); vh2 = tr_read<v_rd_off(0, 2, 1)>(vb); vl3 = tr_read<v_rd_off(0, 3, 0)>(vb); vh3 = tr_read<v_rd_off(0, 3, 1)>(vb); } while (0)
          if (!lat) GLA_LOADV();
          if (lat) {
              f32x16 o0 = f32x16{}, o1 = f32x16{};
#pragma unroll
              for (int ct = 0; ct < 4; ++ct)
#pragma unroll
                for (int kb = 0; kb < 2; ++kb) { const int cb = ct * 32 + kb * 16;
                    v4u sw; sw.x = pk2(S[ct][8 * kb + 0], S[ct][8 * kb + 1]); sw.y = pk2(S[ct][8 * kb + 2], S[ct][8 * kb + 3]); sw.z = pk2(S[ct][8 * kb + 4], S[ct][8 * kb + 5]); sw.w = pk2(S[ct][8 * kb + 6], S[ct][8 * kb + 7]);
                    const bf16x8 sb = __builtin_bit_cast(bf16x8, sw);
                    { const u16* p0 = qe + r32 * QP + cb + 4 * hi; const v2u lo = *(const v2u*)p0, hh = *(const v2u*)(p0 + 8); v4u aw = {lo.x, lo.y, hh.x, hh.y};
                      o0 = __builtin_amdgcn_mfma_f32_32x32x16_bf16(__builtin_bit_cast(bf16x8, aw), sb, o0, 0, 0, 0); }
                    { const u16* p1 = qe + (32 + r32) * QP + cb + 4 * hi; const v2u lo = *(const v2u*)p1, hh = *(const v2u*)(p1 + 8); v4u aw = {lo.x, lo.y, hh.x, hh.y};
                      o1 = __builtin_amdgcn_mfma_f32_32x32x16_bf16(__builtin_bit_cast(bf16x8, aw), sb, o1, 0, 0, 0); } }
              GLA_LOADV();
              asm volatile("s_waitcnt lgkmcnt(0)" ::: "memory"); GLA_SBAR();
              { const u16* a0 = am + r32 * AP + hi * 8; const u16* a1 = am + (32 + r32) * AP + hi * 8;
                o0 = __builtin_amdgcn_mfma_f32_32x32x16_bf16(*(const bf16x8*)(a0), GLA_PK(vl0, vh0), o0, 0, 0, 0);
                o0 = __builtin_amdgcn_mfma_f32_32x32x16_bf16(*(const bf16x8*)(a0 + 16), GLA_PK(vl1, vh1), o0, 0, 0, 0);
                o1 = __builtin_amdgcn_mfma_f32_32x32x16_bf16(*(const bf16x8*)(a1), GLA_PK(vl0, vh0), o1, 0, 0, 0);
                o1 = __builtin_amdgcn_mfma_f32_32x32x16_bf16(*(const bf16x8*)(a1 + 16), GLA_PK(vl1, vh1), o1, 0, 0, 0);
                o1 = __builtin_amdgcn_mfma_f32_32x32x16_bf16(*(const bf16x8*)(a1 + 32), GLA_PK(vl2, vh2), o1, 0, 0, 0);
                o1 = __builtin_amdgcn_mfma_f32_32x32x16_bf16(*(const bf16x8*)(a1 + 48), GLA_PK(vl3, vh3), o1, 0, 0, 0); }
              { u16* ow = ot + (4 * hi) * 256 + vt * 32 + r32;
#pragma unroll
                for (int r = 0; r < 16; ++r) { const int i0 = crow(r, 0); ow[i0 * 256] = f2bf(o0[r]); ow[(i0 + 32) * 256] = f2bf(o1[r]); } }
          }
#pragma unroll
          for (int ct = 0; ct < 4; ++ct) { const int kb_ = ldsb + L_KD + v_rd_base(lane) + ct * 512;
              const s16x4 al0 = tr_read<v_rd_off(0, 0, 0)>(kb_), ah0 = tr_read<v_rd_off(0, 0, 1)>(kb_), al1 = tr_read<v_rd_off(0, 1, 0)>(kb_), ah1 = tr_read<v_rd_off(0, 1, 1)>(kb_);
              const s16x4 al2 = tr_read<v_rd_off(0, 2, 0)>(kb_), ah2 = tr_read<v_rd_off(0, 2, 1)>(kb_), al3 = tr_read<v_rd_off(0, 3, 0)>(kb_), ah3 = tr_read<v_rd_off(0, 3, 1)>(kb_);
              const float* dp = dl + ct * 32 + 4 * hi;
#pragma unroll
              for (int rg = 0; rg < 4; ++rg) { const f32x4 d4 = *(const f32x4*)(dp + 8 * rg);
                  S[ct][4 * rg + 0] *= d4.x; S[ct][4 * rg + 1] *= d4.y; S[ct][4 * rg + 2] *= d4.z; S[ct][4 * rg + 3] *= d4.w; }
              asm volatile("s_waitcnt lgkmcnt(0)" ::: "memory"); GLA_SBAR();
              S[ct] = __builtin_amdgcn_mfma_f32_32x32x16_bf16(GLA_PK(al0, ah0), GLA_PK(vl0, vh0), S[ct], 0, 0, 0);
              S[ct] = __builtin_amdgcn_mfma_f32_32x32x16_bf16(GLA_PK(al1, ah1), GLA_PK(vl1, vh1), S[ct], 0, 0, 0);
              S[ct] = __builtin_amdgcn_mfma_f32_32x32x16_bf16(GLA_PK(al2, ah2), GLA_PK(vl2, vh2), S[ct], 0, 0, 0);
              S[ct] = __builtin_amdgcn_mfma_f32_32x32x16_bf16(GLA_PK(al3, ah3), GLA_PK(vl3, vh3), S[ct], 0, 0, 0); } }
        __syncthreads();
        pend_cc = lat ? cc : -1;
    }
    GLA_FLUSH();
    __syncthreads();
#undef GLA_FLUSH
#undef GLA_LOADV
#undef GLA_CHUNK
#undef GLA_LOAD
}
}
#define XB_TMO      128
#define XB_XCNT(j)  (256  + 64 * (j))
#define XB_XSUB(j)  (1280 + 64 * (j))
#define XB_XGEN(j)  (2304 + 64 * (j))
#define XB_TOP      3328
#define XB_TOPGEN   3392
#define XCD_BAR_WORDS 3456
#define XB_SPIN_CAP (1u << 18)

__device__ __forceinline__ unsigned xb_ld(unsigned* p)              { return __hip_atomic_load(p, __ATOMIC_RELAXED, __HIP_MEMORY_SCOPE_AGENT); }
__device__ __forceinline__ unsigned xb_add(unsigned* p, unsigned v) { return __hip_atomic_fetch_add(p, v, __ATOMIC_RELAXED, __HIP_MEMORY_SCOPE_AGENT); }
__device__ __forceinline__ unsigned xb_xcc_id() { return (unsigned)__builtin_amdgcn_s_getreg((3 << 11) | 20) & 0xFu; }
#define XB_SPIN(cond, bar) do { unsigned _sp = 0; while (cond) { __builtin_amdgcn_s_sleep(1); \
    if ((++_sp & 255u) == 0u) { if (xb_ld(&(bar)[XB_TMO])) break; if (_sp > XB_SPIN_CAP) { atomicAdd(&(bar)[XB_TMO], 1u); break; } } } } while (0)

struct XcdBarrier {
    unsigned* bar; unsigned x;
    volatile LAS unsigned* st;
};

__device__ __forceinline__ XcdBarrier xcd_barrier_post(unsigned* bar, volatile LAS unsigned* st, const bool tid0) {
    XcdBarrier b; b.bar = bar; b.x = xb_xcc_id(); b.st = st;
    if (tid0) (void)xb_add(&bar[XB_XCNT(b.x)], 1u);
    return b;
}
__device__ __forceinline__ void xcd_barrier_complete(unsigned* bar, unsigned x, unsigned& nloc, unsigned& nx) {
    const unsigned G = gridDim.x * gridDim.y * gridDim.z;
    unsigned sum, cnt, mine, sp = 0u;
    for (;;) {
        sum = 0u; cnt = 0u; mine = 0u;
#pragma unroll
        for (unsigned j = 0; j < 16; ++j) { const unsigned c = xb_ld(&bar[XB_XCNT(j)]); sum += c; cnt += (c > 0u) ? 1u : 0u; mine = (j == x) ? c : mine; }
        if (sum == G) break;
        __builtin_amdgcn_s_sleep(1);
        if ((++sp & 255u) == 0u) { if (xb_ld(&bar[XB_TMO])) break; if (sp > XB_SPIN_CAP) { atomicAdd(&bar[XB_TMO], 1u); break; } }
    }
    nloc = mine > 0u ? mine : 1u; nx = cnt > 0u ? cnt : 1u;
}

__device__ __forceinline__ void xcd_barrier(const XcdBarrier& b, const bool tid0) {
    asm volatile("s_waitcnt vmcnt(0)" ::: "memory");
    __syncthreads();
    if (tid0) {
        unsigned* bar = b.bar; const unsigned bx_ = (unsigned)__builtin_amdgcn_readfirstlane((int)xb_xcc_id());
        __builtin_amdgcn_s_waitcnt(0);
        unsigned nloc = b.st[0], nx = b.st[1];
        if (nloc == 0u) { xcd_barrier_complete(bar, bx_, nloc, nx); b.st[0] = nloc; b.st[1] = nx; }
        const unsigned old = xb_add(&bar[XB_XSUB(bx_)], 1u);
        const unsigned gen = old / nloc;
        if (old + 1u == (gen + 1u) * nloc) {
            __builtin_amdgcn_fence(__ATOMIC_RELEASE, "agent");
            asm volatile("s_waitcnt vmcnt(0)" ::: "memory");
            const unsigned og = xb_add(&bar[XB_TOP], 1u);
            const unsigned tg = og / nx;
            if (og + 1u == (tg + 1u) * nx) xb_add(&bar[XB_TOPGEN], 1u);
            else XB_SPIN(xb_ld(&bar[XB_TOPGEN]) == tg, bar);
            __builtin_amdgcn_fence(__ATOMIC_ACQUIRE, "agent");
            xb_add(&bar[XB_XGEN(bx_)], 1u);
            asm volatile("s_waitcnt vmcnt(0)" ::: "memory");
        } else {
            XB_SPIN(xb_ld(&bar[XB_XGEN(bx_)]) == gen, bar);
            __builtin_amdgcn_fence(__ATOMIC_ACQUIRE, "agent");
            asm volatile("s_waitcnt vmcnt(0)" ::: "memory");
        }
    }
    __syncthreads();
}
#ifndef MK_PER_PHASE
#define MK_PER_PHASE 0
#endif
__global__ void __launch_bounds__(512) mk_fwd(Args a) {
    extern __shared__ __attribute__((aligned(16))) unsigned char lds[];
    cg::grid_group grid = cg::this_grid();
    unsigned char* ws = a.ws;
    LAS unsigned char* lds3 = (LAS unsigned char*)lds;
    const int G = gridDim.x, bx = blockIdx.x;
    const int mk_wid = __builtin_amdgcn_readfirstlane(threadIdx.x >> 6);
#ifndef PHMASK
#define PHMASK 0x7ff
#endif
#define IN(k) (((PHMASK >> (k)) & 1) && a.ph_lo <= (k) && (k) < a.ph_hi)
    unsigned* bar_words = (unsigned*)(ws + 4096);
    volatile LAS unsigned* bar_st = (volatile LAS unsigned*)(lds3 + (LDS_BYTES - 64));
    { const int t0_ = MK_TID; if (t0_ < 2) bar_st[t0_] = 0u; }
    if (IN(0) && bx == 0) { for (int i = MK_TID; i < XCD_BAR_WORDS; i += 512) __hip_atomic_store(bar_words + i, 0u, __ATOMIC_RELAXED, __HIP_MEMORY_SCOPE_AGENT); }
#define SEAM(k) do { if (IN(k) && IN((k) + 1)) { if ((k) == 0) { grid.sync(); (void)xcd_barrier_post(bar_words, bar_st, MK_TID == 0); } else { unsigned long long bp_ = (unsigned long long)(a.ws + 4096); asm volatile("" : "+s"(bp_)); XcdBarrier xb_; xb_.bar = (unsigned*)bp_; xb_.x = 0; xb_.st = bar_st; xcd_barrier(xb_, MK_TID == 0); } } } while (0)
    if (IN(0)) p_adaln(a, lds, mk_wid);
    SEAM(0);
    if (IN(1)) { p_weights(a, lds, mk_wid, 0, (G == 256) ? WI_IN : WI_ALL, 0, true); p_h1rows(a, mk_wid); }
    SEAM(1);
    if (IN(2)) {
        pg8::Gemm g{(const pg8::bf16_t*)(ws + WS_H1), (const pg8::bf16_t*)(ws + WS_WIN), MALL, NIN, DM}; InProjOrder S; S.init(G, bx);
        EpiInProj E{ws, (u16*)a.out};
        p_lowrank(a, lds, mk_wid);
        __syncthreads();
        pg8::gemm_phase<EpiInProj, InProjOrder, true, true>(lds3, g, S, E, mk_wid);
        if (G == 256) p_weights(a, lds, mk_wid, WI_IN, WI_PROJ, 128, false);
    }
    SEAM(2);
    if (IN(3)) p_kprep(a, mk_wid);
    SEAM(3);
    if (IN(4)) {
        const att::bf16* Qp = (const att::bf16*)(ws + WS_Q); const att::bf16* Kp = (const att::bf16*)(ws + WS_K); const att::bf16* Vp = (const att::bf16*)(ws + WS_V);
        const float* rope = (const float*)(ws + WS_ROPE);
        const bool full = (G == 256);
        if (full) { if (bx < 128) gla::scan_unit(bx, a, lds, mk_wid); }
        else { for (int u = bx; u < 128; u += G) gla::scan_unit(u, a, lds, mk_wid); }
        __syncthreads();
        const int xj = bx >> 3, xx = bx & 7;
        const int nun = full ? (xj < 16 ? 3 : 5) : 0;
        for (int i = 0; ; ++i) {
            int bk, w;
            if (full) { if (i >= nun) break; const int idx = (xj < 16) ? 80 + i * 16 + xj : i * 16 + (xj - 16); bk = (idx >> 5) * 8 + xx; w = idx & 31; }
            else { const int u = i * G + bx; if (u >= 1024) break; bk = u >> 5; w = u & 31; }
            const int b = bk >> 1, kvh = bk & 1, hq = kvh * 4 + (w >> 3), qb = w & 7;
            const size_t qoff = ((size_t)b * T + (size_t)qb * 256) * 1024 + hq * 128;
            const size_t koff = (size_t)b * TA * 256 + kvh * 128;
            att::attn_unit(Qp + qoff, Kp + koff, Vp + koff, (att::bf16*)(ws + WS_Q) + qoff, TA, (char*)lds, rope + (size_t)qb * 256 * 128, a.in[8], mk_wid);
        }
        if (full) p_weights(a, lds, mk_wid, WI_PROJ, WI_ALL, 128, false);
    }
    SEAM(4);
    if (IN(5)) {
        pg8::StaticOrder S; S.init(MLAT, DM, G, bx, 2);
        { pg8::Gemm g{(const pg8::bf16_t*)(ws + WS_Q), (const pg8::bf16_t*)(ws + WS_WAP), MLAT, DM, DM};
          EpiMerge<0> E{(const u16*)a.out, (u16*)(ws + WS_T1), (u16*)(ws + WS_MRG)};
          pg8::gemm_phase<EpiMerge<0>, pg8::StaticOrder, true, true>(lds3, g, S, E, mk_wid); }
        p_glapost(a, mk_wid);
    }
    SEAM(5);
    if (IN(6)) {
        pg8::StaticOrder S; S.init(MLAT, DM, G, bx, 2);
        pg8::Gemm g{(const pg8::bf16_t*)(ws + WS_GG), (const pg8::bf16_t*)(ws + WS_WGP), MLAT, DM, DM};
        EpiMerge<1> E{(const u16*)a.out, (u16*)(ws + WS_T1), (u16*)(ws + WS_MRG)};
        pg8::gemm_phase<EpiMerge<1>, pg8::StaticOrder, true, true>(lds3, g, S, E, mk_wid);
    }
    SEAM(6);
    if (IN(7)) {
        pg8::Gemm g{(const pg8::bf16_t*)(ws + WS_MRG), (const pg8::bf16_t*)(ws + WS_WOUT), MLAT, DM, DM}; pg8::StaticOrder S; S.init(MLAT, DM, G, bx, 2);
        EpiGateResB<false> E{(const void*)a.in[0], (void*)(ws + WS_X1), (const float*)(ws + WS_MOD) + 2 * 1024};
        pg8::gemm_phase<EpiGateResB<false>, pg8::StaticOrder, true, true>(lds3, g, S, E, mk_wid);
    }
    SEAM(7);
    if (IN(8)) p_h2(a, mk_wid);
    SEAM(8);
    if (IN(9)) {
        pg8::Gemm g{(const pg8::bf16_t*)(ws + WS_H2), (const pg8::bf16_t*)(ws + WS_WFI), MLAT, 2 * DFF, DM}; pg8::StaticOrder S; S.init(MLAT, 2 * DFF, G, bx);
        EpiSwiglu E{(u16*)(ws + WS_ACT)};
        pg8::gemm_phase<EpiSwiglu, pg8::StaticOrder, true, true>(lds3, g, S, E, mk_wid);
    }
    SEAM(9);
    if (IN(10)) {
        pg8::Gemm g{(const pg8::bf16_t*)(ws + WS_ACT), (const pg8::bf16_t*)(ws + WS_WFO), MLAT, DM, DFF}; pg8::StaticOrder S; S.init(MLAT, DM, G, bx, 2);
        EpiGateResB<true> E{(const void*)(ws + WS_X1), (void*)a.out, (const float*)(ws + WS_MOD) + 5 * 1024};
        pg8::gemm_phase<EpiGateResB<true>, pg8::StaticOrder, true, true>(lds3, g, S, E, mk_wid);
    }
#undef IN
#undef SEAM
}

extern "C" void kernel_launch(void* const* d_in, const int* in_sizes, int n_in, void* d_out, int out_size, void* d_ws, size_t ws_size, hipStream_t stream) {
    static int grid = 0;
    if (grid == 0) {
        if (n_in != 21 || in_sizes[0] != MLAT * DM || out_size != MLAT * DM || ws_size < WS_END) {
            fprintf(stderr, "kernel_launch: unexpected shapes: n_in %d in0 %d out %d ws %zu (need >= %zu)\n", n_in, n_in > 0 ? in_sizes[0] : -1, out_size, ws_size, (size_t)WS_END); grid = -1; return; }
        int dev = 0, cus = 0, per_cu = 0;
        if (hipGetDevice(&dev) != hipSuccess || hipDeviceGetAttribute(&cus, hipDeviceAttributeMultiprocessorCount, dev) != hipSuccess) { grid = -1; return; }
        if (hipFuncSetAttribute((const void*)mk_fwd, hipFuncAttributeMaxDynamicSharedMemorySize, LDS_BYTES) != hipSuccess) { fprintf(stderr, "kernel_launch: hipFuncSetAttribute failed\n"); grid = -1; return; }
        if (hipOccupancyMaxActiveBlocksPerMultiprocessor(&per_cu, (const void*)mk_fwd, 512, LDS_BYTES) != hipSuccess || per_cu < 1) { fprintf(stderr, "kernel_launch: occupancy query says %d blocks per CU\n", per_cu); grid = -1; return; }
        grid = cus;
    }
    if (grid < 0) return;
    Args a{};
    for (int i = 0; i < 21; ++i) a.in[i] = (const float*)d_in[i];
    a.out = (float*)d_out; a.ws = (unsigned char*)d_ws;
#if MK_PER_PHASE
    for (int ph = 0; ph < NPH; ++ph) { a.ph_lo = ph; a.ph_hi = ph + 1; hipLaunchKernelGGL(mk_fwd, dim3(grid), dim3(512), LDS_BYTES, stream, a); }
#else
    a.ph_lo = 0; a.ph_hi = NPH;
    void* args[] = {&a};
    const hipError_t e = hipLaunchCooperativeKernel((const void*)mk_fwd, dim3(grid), dim3(512), args, LDS_BYTES, stream);
    if (e != hipSuccess) fprintf(stderr, "kernel_launch: cooperative launch failed: %s (grid %d)\n", hipGetErrorString(e), grid);
#endif
}
```

```cpp
#include <hip/hip_runtime.h>
#include <hip/hip_bf16.h>
#include <hip/hip_cooperative_groups.h>
#include <cstdio>
#include <cstdint>
namespace cg = cooperative_groups;
__device__ __forceinline__ int mk_lane_() { int l; asm volatile("v_mbcnt_lo_u32_b32 %0, -1, 0\n\tv_mbcnt_hi_u32_b32 %0, -1, %0" : "=v"(l)); return l; }
#define MK_LANE() mk_lane_()
#define MK_TID (mk_wid * 64 + MK_LANE())
namespace pg8 {
#define PG8_LAS __attribute__((address_space(3)))
typedef unsigned short bf16_t;
typedef short bf16x8 __attribute__((ext_vector_type(8)));
typedef float f32x4 __attribute__((ext_vector_type(4)));
typedef unsigned u32x4 __attribute__((ext_vector_type(4)));
constexpr int BM = 256, BK = 64, HALF = 128, HTB = HALF * BK * 2  , STAGE_BYTES = 8 * HTB, NXCD = 8, WGM = 4  ;

__host__ __device__ __forceinline__ int lds_byte(int r, int c) { const int st = (r >> 4) * 2 + (c >> 5), rr = r & 15, cc = c & 31, ob = rr * 64 + cc * 2; return st * 1024 + (ob ^ (((ob >> 9) & 1) << 5)); }
__host__ __device__ __forceinline__ void stage_rc(int b, int& R, int& C) { const int st = b / 1024, sb = b % 1024, swz = sb ^ (((sb >> 9) & 1) << 5); R = (st >> 1) * 16 + swz / 64; C = (st & 1) * 32 + (swz % 64) / 2; }
__host__ __device__ __forceinline__ int perm32(int rho) { const int n = rho >> 4, i = rho & 15; return 8 * (i >> 2) + 4 * n + (i & 3); }

struct Unit { int pm, pn; };
struct Gemm { const bf16_t* A; const bf16_t* Bt; int M, N, K; };

struct StaticOrder {
    int nM, nN, nwg, G, c, wgm;
    __host__ __device__ void init(int M, int N, int G_, int c_, int wgm_ = WGM) { nM = M / BM; nN = N / BM; nwg = nM * nN; G = G_; c = c_; wgm = wgm_; }
    __host__ __device__ bool next(int i, Unit& u) const {
        const long L = (long)i * G + c; if (L >= nwg) return false;
        int wgid = (int)L; { const int q = nwg / NXCD, r = nwg % NXCD, xcd = wgid % NXCD, off = wgid / NXCD; wgid = (xcd < r ? xcd * (q + 1) : r * (q + 1) + (xcd - r) * q) + off; }
        const int nig = wgm * nN, gid = wgid / nig, fm = gid * wgm, gsz = (nM - fm) < wgm ? (nM - fm) : wgm;
        u.pm = fm + ((wgid % nig) % gsz); u.pn = (wgid % nig) / gsz; return true;
    }
    __device__ __forceinline__ void a_ready(const Unit&) const {}
    __device__ __forceinline__ void done(const Unit&) const {}
};

__device__ __forceinline__ unsigned cvt_pk_bf16(float lo, float hi) { unsigned r; asm volatile("v_cvt_pk_bf16_f32 %0, %1, %2" : "=v"(r) : "v"(lo), "v"(hi)); return r; }
typedef float f32x2 __attribute__((ext_vector_type(2)));
template <class Epi, class Sched, bool ALIGN_EPI = false, bool SP2 = false>
__device__ __forceinline__ void gemm_phase(PG8_LAS unsigned char* lds, const Gemm g, const Sched& S, const Epi& E, const int mk_wid) {
    const int tid = MK_TID, wid = mk_wid, lane = tid & 63, wr = wid >> 2, wc = wid & 3, fr = lane & 15, fq = lane >> 4;
    const int K = g.K, nt = K / BK;
    unsigned voffA[2], voffB[2];
#pragma unroll
    for (int i = 0; i < 2; ++i) { int R, C; stage_rc(tid * 16 + i * 8192, R, C); const int Rb = Epi::PERM ? ((R & ~31) + perm32(R & 31)) : R;
        voffA[i] = (unsigned)(R * K + C) * 2u; voffB[i] = (unsigned)(Rb * K + C) * 2u; }
    const size_t kstep = (size_t)(BK * 2);
    const size_t hstep = (size_t)HALF * K * 2;
    const size_t tstep = 2 * hstep;
    const unsigned ldsw = (unsigned)wid * 1024u;
    const int aoff = lds_byte(wr * 64 + fr, fq * 8), boff = lds_byte(wc * 32 + fr, fq * 8);
#define PG8_SA(b, h) (((b) * 2 + (h)) * HTB)
#define PG8_SB(b, h) ((4 + (b) * 2 + (h)) * HTB)
#define PG8_STAGE(bufoff, gbase, voff) do { _Pragma("unroll") for (int _i = 0; _i < 2; ++_i) \
        __builtin_amdgcn_global_load_lds((const unsigned*)((const char*)(gbase) + (voff)[_i]), (PG8_LAS unsigned*)(lds + (bufoff) + ldsw + _i * 8192), 16, 0, 0); } while (0)
#define PG8_LDA(dst, b, h) do { _Pragma("unroll") for (int m = 0; m < 4; ++m) _Pragma("unroll") for (int k = 0; k < 2; ++k) dst[m][k] = *(const PG8_LAS bf16x8*)(lds + PG8_SA(b, h) + aoff + m * 2048 + k * 1024); } while (0)
#define PG8_LDB(dst, b, h) do { _Pragma("unroll") for (int n = 0; n < 2; ++n) _Pragma("unroll") for (int k = 0; k < 2; ++k) dst[n][k] = *(const PG8_LAS bf16x8*)(lds + PG8_SB(b, h) + boff + n * 2048 + k * 1024); } while (0)
#define PG8_MMA(ai, bj, At, Bt) do { __builtin_amdgcn_s_setprio(1); _Pragma("unroll") for (int m = 0; m < 4; ++m) _Pragma("unroll") for (int n = 0; n < 2; ++n) _Pragma("unroll") for (int k = 0; k < 2; ++k) \
        acc[ai][bj][m][n] = __builtin_amdgcn_mfma_f32_16x16x32_bf16(Bt[n][k], At[m][k], acc[ai][bj][m][n], 0, 0, 0); __builtin_amdgcn_s_setprio(0); } while (0)
#define PG8_WAIT_V(n) asm volatile("s_waitcnt vmcnt(" #n ")" ::: "memory")
#define PG8_WAIT_L(n) asm volatile("s_waitcnt lgkmcnt(" #n ")" ::: "memory")
#define PG8_BAR __builtin_amdgcn_s_barrier()
#define PG8_SCHED __builtin_amdgcn_sched_barrier(0)
    Unit cur, nxt; int ui = 0;
    if (!S.next(0, cur)) return;
    f32x4 acc[2][2][4][2];
#pragma unroll
    for (int a = 0; a < 2; ++a)
#pragma unroll
        for (int b = 0; b < 2; ++b)
#pragma unroll
            for (int m = 0; m < 4; ++m)
#pragma unroll
                for (int n = 0; n < 2; ++n) acc[a][b][m][n] = (f32x4){0.f, 0.f, 0.f, 0.f};
    bf16x8 At[4][2], B0[2][2], B1[2][2];
    const char* cA = (const char*)g.A + (size_t)cur.pm * tstep; const char* cB = (const char*)g.Bt + (size_t)cur.pn * tstep;
    S.a_ready(cur);
    if constexpr (SP2) {
        PG8_STAGE(PG8_SB(0, 0), cB, voffB); PG8_STAGE(PG8_SB(0, 1), cB + hstep, voffB); PG8_STAGE(PG8_SA(0, 0), cA, voffA); PG8_STAGE(PG8_SA(0, 1), cA + hstep, voffA);
        if (wr == 1) PG8_BAR;
        PG8_WAIT_V(2); PG8_BAR;
        PG8_STAGE(PG8_SB(1, 0), cB + kstep, voffB); PG8_STAGE(PG8_SA(1, 0), cA + kstep, voffA); PG8_STAGE(PG8_SB(1, 1), cB + hstep + kstep, voffB);
        PG8_WAIT_V(6); PG8_BAR;
    } else {
        PG8_STAGE(PG8_SB(0, 0), cB, voffB); PG8_STAGE(PG8_SA(0, 0), cA, voffA); PG8_STAGE(PG8_SB(0, 1), cB + hstep, voffB); PG8_STAGE(PG8_SA(0, 1), cA + hstep, voffA);
        if (wr == 1) PG8_BAR;
        PG8_WAIT_V(4); PG8_BAR;
        PG8_STAGE(PG8_SB(1, 0), cB + kstep, voffB); PG8_STAGE(PG8_SA(1, 0), cA + kstep, voffA); PG8_STAGE(PG8_SB(1, 1), cB + hstep + kstep, voffB);
        PG8_WAIT_V(6); PG8_BAR;
    }
    for (;;) {
        const bool has_next = S.next(ui + 1, nxt);
        const char* nA = has_next ? (const char*)g.A + (size_t)nxt.pm * tstep : cA; const char* nB = has_next ? (const char*)g.Bt + (size_t)nxt.pn * tstep : cB;
        for (int t = 0; t < nt; t += 2) {
            const bool last = (t == nt - 2);
            const char* a1 = cA + (size_t)(t + 1) * kstep;
            const char* a2 = last ? nA : cA + (size_t)(t + 2) * kstep; const char* b2 = last ? nB : cB + (size_t)(t + 2) * kstep;
            const char* a3 = a2 + kstep; const char* b3 = b2 + kstep;
            if (last && has_next) S.a_ready(nxt);
            if constexpr (SP2) {
            PG8_LDB(B0, 0, 0); PG8_LDB(B1, 0, 1); PG8_SCHED; PG8_LDA(At, 0, 0); PG8_STAGE(PG8_SA(1, 1), a1 + hstep, voffA);
            PG8_WAIT_V(8); PG8_WAIT_L(0); PG8_BAR; PG8_MMA(0, 0, At, B0); PG8_MMA(0, 1, At, B1); PG8_BAR; PG8_SCHED;
            PG8_LDA(At, 0, 1); PG8_STAGE(PG8_SB(0, 0), b2, voffB); PG8_STAGE(PG8_SB(0, 1), b2 + hstep, voffB); PG8_STAGE(PG8_SA(0, 0), a2, voffA);
            PG8_WAIT_V(8); PG8_WAIT_L(0); PG8_BAR; PG8_MMA(1, 0, At, B0); PG8_MMA(1, 1, At, B1); PG8_BAR; PG8_SCHED;
            PG8_LDB(B0, 1, 0); PG8_LDB(B1, 1, 1); PG8_SCHED; PG8_LDA(At, 1, 0); PG8_STAGE(PG8_SA(0, 1), a2 + hstep, voffA);
            PG8_WAIT_V(8); PG8_WAIT_L(0); PG8_BAR; PG8_MMA(0, 0, At, B0); PG8_MMA(0, 1, At, B1); PG8_BAR; PG8_SCHED;
            PG8_LDA(At, 1, 1); PG8_STAGE(PG8_SB(1, 0), b3, voffB); PG8_STAGE(PG8_SB(1, 1), b3 + hstep, voffB); PG8_STAGE(PG8_SA(1, 0), a3, voffA);
            PG8_WAIT_V(8); PG8_WAIT_L(0); PG8_BAR; PG8_MMA(1, 0, At, B0); PG8_MMA(1, 1, At, B1); PG8_BAR; PG8_SCHED;
            } else {
            PG8_LDB(B0, 0, 0); PG8_SCHED; PG8_LDA(At, 0, 0); PG8_STAGE(PG8_SA(1, 1), a1 + hstep, voffA);
            PG8_WAIT_L(8); PG8_BAR; PG8_WAIT_L(0); PG8_MMA(0, 0, At, B0); PG8_BAR; PG8_SCHED;
            PG8_LDB(B1, 0, 1); PG8_STAGE(PG8_SB(0, 0), b2, voffB);
            PG8_BAR; PG8_WAIT_L(0); PG8_MMA(0, 1, At, B1); PG8_BAR;
            PG8_LDA(At, 0, 1); PG8_STAGE(PG8_SA(0, 0), a2, voffA);
            PG8_BAR; PG8_WAIT_L(0); PG8_MMA(1, 0, At, B0); PG8_BAR; PG8_SCHED;
            PG8_STAGE(PG8_SB(0, 1), b2 + hstep, voffB);
            PG8_WAIT_V(6); PG8_BAR; PG8_MMA(1, 1, At, B1); PG8_BAR;
            PG8_LDB(B0, 1, 0); PG8_SCHED; PG8_LDA(At, 1, 0); PG8_STAGE(PG8_SA(0, 1), a2 + hstep, voffA);
            PG8_WAIT_L(8); PG8_BAR; PG8_WAIT_L(0); PG8_MMA(0, 0, At, B0); PG8_BAR; PG8_SCHED;
            PG8_LDB(B1, 1, 1); PG8_STAGE(PG8_SB(1, 0), b3, voffB);
            PG8_BAR; PG8_WAIT_L(0); PG8_MMA(0, 1, At, B1); PG8_BAR;
            PG8_LDA(At, 1, 1); PG8_STAGE(PG8_SA(1, 0), a3, voffA);
            PG8_BAR; PG8_WAIT_L(0); PG8_MMA(1, 0, At, B0); PG8_BAR; PG8_SCHED;
            PG8_STAGE(PG8_SB(1, 1), b3 + hstep, voffB);
            PG8_WAIT_V(6); PG8_BAR; PG8_MMA(1, 1, At, B1); PG8_BAR;
            }
        }
        if constexpr (ALIGN_EPI) { if (wr == 0) PG8_BAR; }
        if constexpr (!Epi::AFTER_DRAIN) { E(acc, cur, wr, wc, fr, fq); S.done(cur); }
        if (!has_next) break;
#pragma unroll
        for (int a = 0; a < 2; ++a)
#pragma unroll
            for (int b = 0; b < 2; ++b)
#pragma unroll
                for (int m = 0; m < 4; ++m)
#pragma unroll
                    for (int n = 0; n < 2; ++n) acc[a][b][m][n] = (f32x4){0.f, 0.f, 0.f, 0.f};
        cur = nxt; cA = nA; cB = nB; ++ui;
        if constexpr (ALIGN_EPI) { if (wr == 1) PG8_BAR; }
    }
    PG8_WAIT_V(0);
    if constexpr (!ALIGN_EPI) { if (wr == 0) PG8_BAR; }
    PG8_BAR;
    if constexpr (Epi::AFTER_DRAIN) { E.fused(acc, cur, wr, wc, fr, fq, lds, wid, lane); S.done(cur); }
#undef PG8_SA
#undef PG8_SB
#undef PG8_STAGE
#undef PG8_LDA
#undef PG8_LDB
#undef PG8_MMA
#undef PG8_WAIT_V
#undef PG8_WAIT_L
#undef PG8_BAR
#undef PG8_SCHED
}
}
namespace att {
using bf16 = __hip_bfloat16;
constexpr int   D = 128, NW = 8, QBLK = 32, KVBLK = 64;
constexpr float SCALE = 0.088388347648318440f;
constexpr float THR = 8.f;
constexpr int LDQ = 1024, LDK = 256, LDO = 1024;
constexpr size_t SHM_V = KVBLK * D * 2, SHM_K = KVBLK * D * 2, SHM_ATTN = 2 * SHM_V + 2 * SHM_K + NW * 64 * 4;
using bf16x8 = __attribute__((ext_vector_type(8))) short;
using s16x4  = __attribute__((ext_vector_type(4))) short;
using f32x16 = __attribute__((ext_vector_type(16))) float;
using f32x8  = __attribute__((ext_vector_type(8))) float;
using u32x4  = __attribute__((ext_vector_type(4))) unsigned;
#define KSWZ(row, colB) ((row) * 256 + ((colB) ^ (((row) & 7) << 4)))
#define SBAR() __builtin_amdgcn_sched_barrier(0)
__device__ __forceinline__ int crow(int r, int hi) { return (r & 3) + 8 * (r >> 2) + 4 * hi; }
__device__ __forceinline__ unsigned cvtpk(float lo, float hi) {
  unsigned r; asm volatile("v_cvt_pk_bf16_f32 %0, %1, %2" : "=v"(r) : "v"(lo), "v"(hi)); return r;
}
template <typename TIn> struct Stage;
template <> struct Stage<bf16>  { using T = bf16x8;
  __device__ static __forceinline__ T ld8(const bf16* p) { return *reinterpret_cast<const bf16x8*>(p); }
  __device__ static __forceinline__ bf16x8 tobf(T x) { return x; } };
template <> struct Stage<float> { using T = f32x8;
  __device__ static __forceinline__ T ld8(const float* p) { return *reinterpret_cast<const f32x8*>(p); }
  __device__ static __forceinline__ bf16x8 tobf(T x) {
    u32x4 w = {cvtpk(x[0], x[1]), cvtpk(x[2], x[3]), cvtpk(x[4], x[5]), cvtpk(x[6], x[7])}; return *reinterpret_cast<bf16x8*>(&w); } };

__device__ __forceinline__ void partialSM(f32x16& p0, f32x16& p1, float& m_reg, float& mn, float& alpha) {
  constexpr float C = SCALE * 1.4426950408889634f;
  float pmax = p0[0]; for (int r = 1; r < 16; ++r) pmax = fmaxf(pmax, p0[r]); for (int r = 0; r < 16; ++r) pmax = fmaxf(pmax, p1[r]);
  { auto rr = __builtin_amdgcn_permlane32_swap(__float_as_uint(pmax), __float_as_uint(pmax), false, false);
    pmax = fmaxf(__uint_as_float(rr[0]), __uint_as_float(rr[1])); }
  if (__builtin_expect(__all(pmax - m_reg <= THR / SCALE), 1)) { mn = m_reg; alpha = 1.f; }
  else { mn = fmaxf(m_reg, pmax); alpha = __builtin_amdgcn_exp2f((m_reg - mn) * C); m_reg = mn; }
  float mnC = -mn * C;
  for (int r = 0; r < 16; ++r) p0[r] = fmaf(p0[r], C, mnC); for (int r = 0; r < 16; ++r) p1[r] = fmaf(p1[r], C, mnC);
  for (int r = 0; r < 16; ++r) p0[r] = __builtin_amdgcn_exp2f(p0[r]);
}
__device__ __forceinline__ void finishSM(f32x16& p0, f32x16& p1, float alpha, float& l_reg, bf16x8& pa0, bf16x8& pa1, bf16x8& pa2, bf16x8& pa3) {
  for (int r = 0; r < 16; ++r) p1[r] = __builtin_amdgcn_exp2f(p1[r]);
  float ps = 0; for (int r = 0; r < 16; ++r) ps += p0[r]; for (int r = 0; r < 16; ++r) ps += p1[r];
  { auto rr = __builtin_amdgcn_permlane32_swap(__float_as_uint(ps), __float_as_uint(ps), false, false);
    ps = __uint_as_float(rr[0]) + __uint_as_float(rr[1]); }
  l_reg = l_reg * alpha + ps;
#define PK4(P, BASE, OUT) do { unsigned a0 = cvtpk(P[BASE + 0], P[BASE + 1]), a1 = cvtpk(P[BASE + 2], P[BASE + 3]);   \
    unsigned b0 = cvtpk(P[BASE + 4], P[BASE + 5]), b1 = cvtpk(P[BASE + 6], P[BASE + 7]);                              \
    auto r0 = __builtin_amdgcn_permlane32_swap(a0, b0, false, false); auto r1 = __builtin_amdgcn_permlane32_swap(a1, b1, false, false); \
    u32x4 w = {r0[0], r1[0], r0[1], r1[1]}; OUT = *reinterpret_cast<bf16x8*>(&w); } while (0)
  PK4(p0, 0, pa0); PK4(p0, 8, pa1); PK4(p1, 0, pa2); PK4(p1, 8, pa3);
#undef PK4
}
__device__ __forceinline__ void qkt(f32x16& p0, f32x16& p1, const bf16* Ks, const bf16x8* qr, int r32, int hi) {
  p0 = f32x16{}; p1 = f32x16{};
  for (int d0 = 0; d0 < 8; ++d0) { int cb = (d0 * 16 + hi * 8) * 2;
    bf16x8 b0 = *reinterpret_cast<const bf16x8*>((const char*)Ks + KSWZ(r32, cb));
    bf16x8 b1 = *reinterpret_cast<const bf16x8*>((const char*)Ks + KSWZ(32 + r32, cb));
    p0 = __builtin_amdgcn_mfma_f32_32x32x16_bf16(b0, qr[d0], p0, 0, 0, 0);
    p1 = __builtin_amdgcn_mfma_f32_32x32x16_bf16(b1, qr[d0], p1, 0, 0, 0); }
}
__device__ __forceinline__ int v_st(int k, int c) { const int kk = (k & ~0xC) | ((k & 4) << 1) | ((k & 8) >> 1); return ((kk >> 3) * 4 + (c >> 5)) * 512 + ((kk & 7) * 32 + (c & 31)) * 2; }
__device__ __forceinline__ int v_rd_base(int lane) { return ((lane & 3) << 3) | (((lane >> 2) & 3) << 6) | (((lane >> 4) & 1) << 5) | (((lane >> 5) & 1) << 8); }
constexpr int v_rd_off(int d0, int ks, int half) { return d0 * 512 + ks * 4096 + half * 2048; }
template <int OFF> __device__ __forceinline__ s16x4 tr_read(int vb) {
  s16x4 r; asm volatile("ds_read_b64_tr_b16 %0, %1 offset:%2" : "=&v"(r) : "v"(vb), "i"(OFF) : "memory"); return r;
}
template <int D0> __device__ __forceinline__ void pv_one(f32x16& od, int vb, bf16x8 pa0, bf16x8 pa1, bf16x8 pa2, bf16x8 pa3) {
  const s16x4 l0 = tr_read<v_rd_off(D0, 0, 0)>(vb), h0 = tr_read<v_rd_off(D0, 0, 1)>(vb), l1 = tr_read<v_rd_off(D0, 1, 0)>(vb), h1 = tr_read<v_rd_off(D0, 1, 1)>(vb);
  const s16x4 l2 = tr_read<v_rd_off(D0, 2, 0)>(vb), h2 = tr_read<v_rd_off(D0, 2, 1)>(vb), l3 = tr_read<v_rd_off(D0, 3, 0)>(vb), h3 = tr_read<v_rd_off(D0, 3, 1)>(vb);
  asm volatile("s_waitcnt lgkmcnt(0)" ::: "memory"); SBAR();
#define PK(L, H) (bf16x8){L[0], L[1], L[2], L[3], H[0], H[1], H[2], H[3]}
  od = __builtin_amdgcn_mfma_f32_32x32x16_bf16(pa0, PK(l0, h0), od, 0, 0, 0);
  od = __builtin_amdgcn_mfma_f32_32x32x16_bf16(pa1, PK(l1, h1), od, 0, 0, 0);
  od = __builtin_amdgcn_mfma_f32_32x32x16_bf16(pa2, PK(l2, h2), od, 0, 0, 0);
  od = __builtin_amdgcn_mfma_f32_32x32x16_bf16(pa3, PK(l3, h3), od, 0, 0, 0);
#undef PK
}
__device__ __forceinline__ void pv_d0(f32x16* o, int vb, bf16x8 pa0, bf16x8 pa1, bf16x8 pa2, bf16x8 pa3) {
  pv_one<0>(o[0], vb, pa0, pa1, pa2, pa3); pv_one<1>(o[1], vb, pa0, pa1, pa2, pa3); pv_one<2>(o[2], vb, pa0, pa1, pa2, pa3); pv_one<3>(o[3], vb, pa0, pa1, pa2, pa3);
}
__device__ __forceinline__ float bf2f(short s) { return __uint_as_float(((unsigned)(unsigned short)s) << 16); }
__device__ __forceinline__ void attn_unit(const bf16* Qb, const bf16* __restrict__ Kh, const bf16* __restrict__ Vh, bf16* Ob, int seq, char* lds,
                                          const float* __restrict__ rope, const float* __restrict__ qg, const int mk_wid) {
  using St = Stage<bf16>;
  int tid = MK_TID; asm volatile("" : "+v"(tid));
  const int wid = mk_wid, lane = tid & 63, r32 = lane & 31, hi = lane >> 5;
  bf16* V_lds = (bf16*)lds; bf16* K_lds = (bf16*)(lds + 2 * SHM_V);
  float* ws = (float*)(lds + 2 * SHM_V + 2 * SHM_K) + wid * 64; float* li_l = ws; float* al_l = ws + 32;
  float m_reg = -1e30f, l_reg = 0; f32x16 o[4] = {}; bf16x8 qr[8];
  const int sr = tid >> 4, sc = (tid & 15) * 8, vst0 = v_st(sr, sc), vst1 = v_st(32 + sr, sc);
  const int vb0 = (int)(uintptr_t)V_lds + v_rd_base(lane);
  struct { typename St::T vs0, vs1, ks0, ks1; } sr_[2];
#define SLOAD(i, k0) do { sr_[i].vs0 = St::ld8(&Vh[(long)((k0) + sr) * LDK + sc]); sr_[i].vs1 = St::ld8(&Vh[(long)((k0) + 32 + sr) * LDK + sc]); \
    sr_[i].ks0 = St::ld8(&Kh[(long)((k0) + sr) * LDK + sc]); sr_[i].ks1 = St::ld8(&Kh[(long)((k0) + 32 + sr) * LDK + sc]); } while (0)
#define SWRITE(b, i) do { *(bf16x8*)((char*)V_lds + (b) * SHM_V + vst0) = St::tobf(sr_[i].vs0);          \
    *(bf16x8*)((char*)V_lds + (b) * SHM_V + vst1) = St::tobf(sr_[i].vs1); int kc = sc * 2;               \
    *(bf16x8*)((char*)K_lds + (b) * SHM_K + KSWZ(sr, kc)) = St::tobf(sr_[i].ks0);                       \
    *(bf16x8*)((char*)K_lds + (b) * SHM_K + KSWZ(32 + sr, kc)) = St::tobf(sr_[i].ks1); } while (0)
#define SWAIT() do { asm volatile("s_waitcnt vmcnt(4)" ::: "memory"); } while (0)
#define RESC(a) do { if (__any((a) < 1.f)) { if (hi == 0) al_l[r32] = (a); asm volatile("s_waitcnt lgkmcnt(0)" ::: "memory"); \
    for (int d = 0; d < 4; ++d) for (int r = 0; r < 16; ++r) o[d][r] *= al_l[crow(r, hi)]; } } while (0)
  constexpr int SE = 0, SO = 1;
  {
    int tp = MK_TID; asm volatile("" : "+v"(tp)); const int r32 = tp & 31, hi = (tp >> 5) & 1;
    const bf16* Qw = Qb + (long)(wid * QBLK + r32) * LDQ + hi * 8;
    const float* rp = rope + ((long)(wid * QBLK + r32) * 64 + hi * 4) * 2;
    bf16x8 rw[8]; float4 gA[8], gB[8], cA[8], cB[8];
#pragma unroll
    for (int d0 = 0; d0 < 8; ++d0) { rw[d0] = *reinterpret_cast<const bf16x8*>(Qw + d0 * 16);
      gA[d0] = *reinterpret_cast<const float4*>(qg + d0 * 16 + hi * 8); gB[d0] = *reinterpret_cast<const float4*>(qg + d0 * 16 + hi * 8 + 4);
      cA[d0] = *reinterpret_cast<const float4*>(rp + d0 * 16); cB[d0] = *reinterpret_cast<const float4*>(rp + d0 * 16 + 4); }
    float ss = 0.f;
#pragma unroll
    for (int d0 = 0; d0 < 8; ++d0)
#pragma unroll
      for (int e = 0; e < 8; ++e) { const float f = bf2f(rw[d0][e]); ss += f * f; }
    { auto rr = __builtin_amdgcn_permlane32_swap(__float_as_uint(ss), __float_as_uint(ss), false, false); ss = __uint_as_float(rr[0]) + __uint_as_float(rr[1]); }
    const float rinv = rsqrtf(ss * (1.f / 128.f) + 1e-6f);
#pragma unroll
    for (int d0 = 0; d0 < 8; ++d0) {
      const float4 g0 = gA[d0], g1 = gB[d0], cs0 = cA[d0], cs1 = cB[d0];
      const float x0 = bf2f(rw[d0][0]) * rinv * g0.x, x1 = bf2f(rw[d0][1]) * rinv * g0.y, x2 = bf2f(rw[d0][2]) * rinv * g0.z, x3 = bf2f(rw[d0][3]) * rinv * g0.w;
      const float x4 = bf2f(rw[d0][4]) * rinv * g1.x, x5 = bf2f(rw[d0][5]) * rinv * g1.y, x6 = bf2f(rw[d0][6]) * rinv * g1.z, x7 = bf2f(rw[d0][7]) * rinv * g1.w;
      u32x4 w = {cvtpk(x0 * cs0.x - x1 * cs0.y, x0 * cs0.y + x1 * cs0.x), cvtpk(x2 * cs0.z - x3 * cs0.w, x2 * cs0.w + x3 * cs0.z),
                 cvtpk(x4 * cs1.x - x5 * cs1.y, x4 * cs1.y + x5 * cs1.x), cvtpk(x6 * cs1.z - x7 * cs1.w, x6 * cs1.w + x7 * cs1.z)};
      qr[d0] = *reinterpret_cast<bf16x8*>(&w);
    }
  }
  f32x16 pA0, pA1, pB0, pB1; float mnA, mnB, alA, alB; bf16x8 pa0, pa1, pa2, pa3; const int NT = seq / KVBLK;
  SLOAD(SE, 0); asm volatile("s_waitcnt vmcnt(0)" ::: "memory"); SWRITE(0, SE); __syncthreads();
  qkt(pA0, pA1, K_lds, qr, r32, hi); partialSM(pA0, pA1, m_reg, mnA, alA);
  SLOAD(SO, KVBLK); if (2 < NT) SLOAD(SE, 2 * KVBLK);
  SWAIT(); SWRITE(1, SO); __syncthreads();
  for (int j = 1; j + 1 < NT; j += 2) {
    SBAR(); qkt(pB0, pB1, (bf16*)((char*)K_lds + SHM_K), qr, r32, hi);
    finishSM(pA0, pA1, alA, l_reg, pa0, pa1, pa2, pa3); SBAR();
    SLOAD(SO, (j + 2) * KVBLK); SBAR();
    pv_d0(o, vb0, pa0, pa1, pa2, pa3); partialSM(pB0, pB1, m_reg, mnB, alB);
    __syncthreads(); SWAIT(); SWRITE(0, SE);
    RESC(alB); __syncthreads();
    SBAR(); qkt(pA0, pA1, K_lds, qr, r32, hi);
    finishSM(pB0, pB1, alB, l_reg, pa0, pa1, pa2, pa3); SBAR();
    if (j + 3 < NT) SLOAD(SE, (j + 3) * KVBLK); SBAR();
    pv_d0(o, vb0 + (int)SHM_V, pa0, pa1, pa2, pa3); partialSM(pA0, pA1, m_reg, mnA, alA);
    __syncthreads(); SWAIT(); SWRITE(1, SO);
    RESC(alA); __syncthreads();
  }
  SBAR(); qkt(pB0, pB1, (bf16*)((char*)K_lds + SHM_K), qr, r32, hi);
  finishSM(pA0, pA1, alA, l_reg, pa0, pa1, pa2, pa3); SBAR();
  pv_d0(o, vb0, pa0, pa1, pa2, pa3); partialSM(pB0, pB1, m_reg, mnB, alB);
  __syncthreads(); RESC(alB);
  finishSM(pB0, pB1, alB, l_reg, pa0, pa1, pa2, pa3); SBAR();
  pv_d0(o, vb0 + (int)SHM_V, pa0, pa1, pa2, pa3);
  if (hi == 0) li_l[r32] = l_reg; asm volatile("s_waitcnt lgkmcnt(0)" ::: "memory");
  float rli[16];
#pragma unroll
  for (int r = 0; r < 16; ++r) rli[r] = __builtin_amdgcn_rcpf(li_l[crow(r, hi)]);
  __syncthreads();
  { int te = MK_TID; asm volatile("" : "+v"(te)); const int lane = te & 63, r32 = lane & 31, hi = lane >> 5;
    unsigned short* stg = (unsigned short*)(lds + wid * 8192);
#pragma unroll
    for (int r = 0; r < 16; ++r) { const int orow = crow(r, hi);
#pragma unroll
      for (int d0 = 0; d0 < 4; ++d0) stg[orow * 128 + d0 * 32 + r32] = (unsigned short)(cvtpk(o[d0][r] * rli[r], 0.f) & 0xffffu); }
    asm volatile("s_waitcnt lgkmcnt(0)" ::: "memory");
    bf16* Ow = Ob + (long)(wid * QBLK) * LDO;
#pragma unroll
    for (int i = 0; i < 8; ++i) { const int row = i * 4 + (lane >> 4), ch = lane & 15; const u32x4 v = *(const u32x4*)(stg + row * 128 + ch * 8); *(u32x4*)(Ow + (long)row * LDO + ch * 8) = v; } }
  __syncthreads();
#undef SLOAD
#undef SWRITE
#undef SWAIT
#undef RESC
}
}
constexpr int NB = 16, T = 2048, TC = 256, TA = T + TC, DM = 1024;
constexpr int MLAT = NB * T, MALL = NB * TA;
constexpr int NIN = 6912;
constexpr int DFF = 2816;
constexpr float EPS = 1e-6f;
constexpr size_t MiB = 1u << 20;
constexpr size_t WS_MOD = 1 * MiB, WS_ROPE = 2 * MiB, WS_WIN = 4 * MiB, WS_WAP = 18 * MiB, WS_WGP = 20 * MiB, WS_WOUT = 22 * MiB, WS_WFI = 24 * MiB, WS_WFO = 36 * MiB,
                 WS_H1 = 42 * MiB, WS_Q = 114 * MiB, WS_K = 178 * MiB, WS_V = 196 * MiB, WS_GQ = 214 * MiB, WS_GK = 250 * MiB, WS_GV = 286 * MiB, WS_GG = 358 * MiB,
                 WS_LR = 422 * MiB, WS_OB = 426 * MiB, WS_END = 490 * MiB;
constexpr size_t WS_OF = WS_H1, WS_T1 = WS_GQ  , WS_H2 = WS_H1, WS_MRG = WS_GV, WS_ACT = WS_Q, WS_X1 = WS_OB  ;
constexpr int LDS_BYTES = 147456;
constexpr int NPH = 11;
constexpr int WI_IN = 16 * 216, WI_PROJ = WI_IN + 3 * 16 * 32, WI_ALL = WI_PROJ + 16 * 176 + 44 * 32;

typedef unsigned short u16;
typedef unsigned v4u __attribute__((ext_vector_type(4)));
typedef unsigned v2u __attribute__((ext_vector_type(2)));
typedef float f32x4 __attribute__((ext_vector_type(4)));
#define LAS __attribute__((address_space(3)))

struct Args { const float* in[21]; float* out; unsigned char* ws; int ph_lo, ph_hi; };

__device__ __forceinline__ float bf2f(u16 u) { return __uint_as_float((unsigned)u << 16); }
typedef float f32x2_t __attribute__((ext_vector_type(2))); typedef __bf16 bf16x2_t __attribute__((ext_vector_type(2)));
__device__ __forceinline__ unsigned pk2(float lo, float hi) { f32x2_t v = {lo, hi}; bf16x2_t b = __builtin_convertvector(v, bf16x2_t); return __builtin_bit_cast(unsigned, b); }
__device__ __forceinline__ u16 f2bf(float f) { return (u16)(pk2(f, 0.f) & 0xffffu); }
__device__ __forceinline__ float wave_sum(float v) {
#pragma unroll
    for (int o = 1; o < 64; o <<= 1) v += __shfl_xor(v, o);
    return v;
}
__device__ __forceinline__ float sigmoidf_(float x) { return 1.f / (1.f + __expf(-x)); }

struct EpiInProj {
    static constexpr bool PERM = true, AFTER_DRAIN = false;
    unsigned char* ws; u16* MG;
    __device__ __forceinline__ void operator()(const pg8::f32x4 (&acc)[2][2][4][2], const pg8::Unit& u, int wr, int wc, int fr, int fq) const {
        const int b = u.pm / 9, j = u.pm % 9, pn = u.pn; const bool isctx = (j == 0);
        const long rall = (long)u.pm * 256, rlat = (long)b * T + (j - 1) * 256;
        u16* base; int ld, colt; long row0;
        if (pn < 4)       { if (isctx) return; base = (u16*)(ws + WS_Q);  ld = 1024; colt = pn * 256;        row0 = rlat; }
        else if (pn == 4) {                    base = (u16*)(ws + WS_K);  ld = 256;  colt = 0;               row0 = rall; }
        else if (pn == 5) {                    base = (u16*)(ws + WS_V);  ld = 256;  colt = 0;               row0 = rall; }
        else if (pn < 8)  { if (isctx) return; base = (u16*)(ws + WS_GQ); ld = 512;  colt = (pn - 6) * 256;  row0 = rall; }
        else if (pn < 10) {                    base = (u16*)(ws + WS_GK); ld = 512;  colt = (pn - 8) * 256;  row0 = rall; }
        else if (pn < 14) {                    base = (u16*)(ws + WS_GV); ld = 1024; colt = (pn - 10) * 256; row0 = rall; }
        else if (pn < 18) { if (isctx) return; base = (u16*)(ws + WS_GG); ld = 1024; colt = (pn - 14) * 256; row0 = rlat; }
        else if (pn < 26) { if (isctx) return; base = MG;                 ld = 2048; colt = (pn - 18) * 256; row0 = rlat; }
        else              {                    base = (u16*)(ws + WS_LR); ld = 32;   colt = 0;               row0 = rall; }
        const bool lr = (pn == 26);
        if (lr && wc != 0) return;
        const int col0 = colt + wc * 32 + 8 * fq;
#pragma unroll
        for (int ai = 0; ai < 2; ++ai)
#pragma unroll
            for (int m = 0; m < 4; ++m) { u16* rowp = base + (size_t)(row0 + ai * 128 + wr * 64 + m * 16 + fr) * ld + col0;
#pragma unroll
                for (int bj = 0; bj < 2; ++bj) { if (lr && bj) continue;
                    const pg8::f32x4 v0 = acc[ai][bj][m][0], v1 = acc[ai][bj][m][1];
                    v4u w; w.x = pk2(v0[0], v0[1]); w.y = pk2(v0[2], v0[3]); w.z = pk2(v1[0], v1[1]); w.w = pk2(v1[2], v1[3]);
                    *(v4u*)(rowp + bj * 128) = w; } }
    }
};
struct InProjOrder {
    pg8::StaticOrder so; int G, c;
    __device__ void init(int G_, int c_) { so.init(128 * 256, 26 * 256, G_, c_); G = G_; c = c_; }
    __device__ bool next(int i, pg8::Unit& u) const {
        if (so.next(i, u)) { u.pm = (u.pm >> 3) * 9 + 1 + (u.pm & 7); return true; }
        const long q = (long)i * G + c - 3328; if (q < 0 || q >= 128) return false;
        const int b = (int)(q >> 3), t = (int)(q & 7);
        u.pm = b * 9; u.pn = t == 0 ? 4 : (t == 1 ? 5 : (t < 4 ? 6 + t : 6 + t)); return true;
    }
    __device__ __forceinline__ void a_ready(const pg8::Unit&) const {}
    __device__ __forceinline__ void done(const pg8::Unit&) const {}
};
template <int MODE> struct EpiMerge {
    static constexpr bool PERM = true, AFTER_DRAIN = false;
    const u16* MG; u16* T1; u16* MRG;
    __device__ __forceinline__ void operator()(const pg8::f32x4 (&acc)[2][2][4][2], const pg8::Unit& u, int wr, int wc, int fr, int fq) const {
        const int col0 = u.pn * 256 + wc * 32 + 8 * fq;
#pragma unroll
        for (int ai = 0; ai < 2; ++ai) {
            v4u gwv[4][2], twv[4][2];
#pragma unroll
            for (int m = 0; m < 4; ++m) { const size_t row = (size_t)u.pm * 256 + ai * 128 + wr * 64 + m * 16 + fr;
#pragma unroll
                for (int bj = 0; bj < 2; ++bj) { const int col = col0 + bj * 128;
                    gwv[m][bj] = __builtin_nontemporal_load((const v4u*)(MG + row * 2048 + MODE * 1024 + col));
                    twv[m][bj] = (MODE == 1) ? __builtin_nontemporal_load((const v4u*)(T1 + row * 1024 + col)) : (v4u){0u, 0u, 0u, 0u}; } }
#pragma unroll
            for (int m = 0; m < 4; ++m) { const size_t row = (size_t)u.pm * 256 + ai * 128 + wr * 64 + m * 16 + fr;
#pragma unroll
                for (int bj = 0; bj < 2; ++bj) { const int col = col0 + bj * 128;
                    const pg8::f32x4 v0 = acc[ai][bj][m][0], v1 = acc[ai][bj][m][1];
                    const float r[8] = {v0[0], v0[1], v0[2], v0[3], v1[0], v1[1], v1[2], v1[3]};
                    const unsigned gws[4] = {gwv[m][bj].x, gwv[m][bj].y, gwv[m][bj].z, gwv[m][bj].w};
                    const unsigned tws[4] = {twv[m][bj].x, twv[m][bj].y, twv[m][bj].z, twv[m][bj].w};
                    unsigned ow[4];
#pragma unroll
                    for (int e = 0; e < 4; ++e) {
                        float a0 = sigmoidf_(bf2f((u16)(gws[e] & 0xffffu))) * r[2 * e], a1 = sigmoidf_(bf2f((u16)(gws[e] >> 16))) * r[2 * e + 1];
                        if (MODE == 1) { a0 += bf2f((u16)(tws[e] & 0xffffu)); a1 += bf2f((u16)(tws[e] >> 16)); }
                        ow[e] = pk2(a0, a1); }
                    v4u w = {ow[0], ow[1], ow[2], ow[3]};
                    *(v4u*)((MODE == 0 ? T1 : MRG) + row * 1024 + col) = w; } }
        }
    }
};
struct EpiGateRes {
    static constexpr bool PERM = true, AFTER_DRAIN = false;
    const float* base; float* out; const float* gate;
    __device__ __forceinline__ void operator()(const pg8::f32x4 (&acc)[2][2][4][2], const pg8::Unit& u, int wr, int wc, int fr, int fq) const {
        const int col0 = u.pn * 256 + wc * 32 + 8 * fq; const int b = (u.pm * 256) / T;
        pg8::f32x4 gv[2][2];
#pragma unroll
        for (int bj = 0; bj < 2; ++bj)
#pragma unroll
            for (int n = 0; n < 2; ++n) gv[bj][n] = *(const pg8::f32x4*)(gate + (size_t)b * 6144 + col0 + bj * 128 + n * 4);
#pragma unroll
        for (int ai = 0; ai < 2; ++ai)
#pragma unroll
            for (int m = 0; m < 4; ++m) { const size_t off = ((size_t)u.pm * 256 + ai * 128 + wr * 64 + m * 16 + fr) * DM + col0;
#pragma unroll
                for (int bj = 0; bj < 2; ++bj)
#pragma unroll
                    for (int n = 0; n < 2; ++n) { const pg8::f32x4 bs = *(const pg8::f32x4*)(base + off + bj * 128 + n * 4);
                        *(pg8::f32x4*)(out + off + bj * 128 + n * 4) = bs + gv[bj][n] * acc[ai][bj][m][n]; } }
    }
};
template <bool IN_BF16> struct EpiGateResB {
    static constexpr bool PERM = true, AFTER_DRAIN = false;
    const void* base; void* out; const float* gate;
    __device__ __forceinline__ void operator()(const pg8::f32x4 (&acc)[2][2][4][2], const pg8::Unit& u, int wr, int wc, int fr, int fq) const {
        const int col0 = u.pn * 256 + wc * 32 + 8 * fq; const int b = (u.pm * 256) / T;
        pg8::f32x4 gv[2][2];
#pragma unroll
        for (int bj = 0; bj < 2; ++bj)
#pragma unroll
            for (int n = 0; n < 2; ++n) gv[bj][n] = *(const pg8::f32x4*)(gate + (size_t)b * 6144 + col0 + bj * 128 + n * 4);
#pragma unroll
        for (int ai = 0; ai < 2; ++ai) {
            pg8::f32x4 bs[4][2][2]; v4u bw[4][2];
#pragma unroll
            for (int m = 0; m < 4; ++m) { const size_t off = ((size_t)u.pm * 256 + ai * 128 + wr * 64 + m * 16 + fr) * DM + col0;
#pragma unroll
                for (int bj = 0; bj < 2; ++bj) {
                    if (IN_BF16) bw[m][bj] = __builtin_nontemporal_load((const v4u*)((const u16*)base + off + bj * 128));
                    else { bs[m][bj][0] = __builtin_nontemporal_load((const pg8::f32x4*)((const float*)base + off + bj * 128)); bs[m][bj][1] = __builtin_nontemporal_load((const pg8::f32x4*)((const float*)base + off + bj * 128 + 4)); } } }
#pragma unroll
            for (int m = 0; m < 4; ++m) { const size_t off = ((size_t)u.pm * 256 + ai * 128 + wr * 64 + m * 16 + fr) * DM + col0;
#pragma unroll
                for (int bj = 0; bj < 2; ++bj) {
                    pg8::f32x4 b0, b1;
                    if (IN_BF16) { const v4u w = bw[m][bj];
                        b0 = (pg8::f32x4){bf2f((u16)(w.x & 0xffffu)), bf2f((u16)(w.x >> 16)), bf2f((u16)(w.y & 0xffffu)), bf2f((u16)(w.y >> 16))};
                        b1 = (pg8::f32x4){bf2f((u16)(w.z & 0xffffu)), bf2f((u16)(w.z >> 16)), bf2f((u16)(w.w & 0xffffu)), bf2f((u16)(w.w >> 16))}; }
                    else { b0 = bs[m][bj][0]; b1 = bs[m][bj][1]; }
                    const pg8::f32x4 o0 = b0 + gv[bj][0] * acc[ai][bj][m][0], o1 = b1 + gv[bj][1] * acc[ai][bj][m][1];
                    if (IN_BF16) { *(pg8::f32x4*)((float*)out + off + bj * 128) = o0; *(pg8::f32x4*)((float*)out + off + bj * 128 + 4) = o1; }
                    else { v4u w; w.x = pk2(o0[0], o0[1]); w.y = pk2(o0[2], o0[3]); w.z = pk2(o1[0], o1[1]); w.w = pk2(o1[2], o1[3]); *(v4u*)((u16*)out + off + bj * 128) = w; } } }
        }
    }
};
struct EpiSwiglu {
    static constexpr bool PERM = true, AFTER_DRAIN = false;
    u16* ACT;
    __device__ __forceinline__ void operator()(const pg8::f32x4 (&acc)[2][2][4][2], const pg8::Unit& u, int wr, int wc, int fr, int fq) const {
        const int col0 = u.pn * 128 + wc * 32 + 8 * fq;
#pragma unroll
        for (int ai = 0; ai < 2; ++ai)
#pragma unroll
            for (int m = 0; m < 4; ++m) { const size_t row = (size_t)u.pm * 256 + ai * 128 + wr * 64 + m * 16 + fr;
                unsigned ow[4];
#pragma unroll
                for (int n = 0; n < 2; ++n) { const pg8::f32x4 av = acc[ai][0][m][n], bv = acc[ai][1][m][n];
                    float s[4];
#pragma unroll
                    for (int e = 0; e < 4; ++e) s[e] = av[e] * sigmoidf_(av[e]) * bv[e];
                    ow[2 * n] = pk2(s[0], s[1]); ow[2 * n + 1] = pk2(s[2], s[3]); }
                v4u w = {ow[0], ow[1], ow[2], ow[3]};
                *(v4u*)(ACT + row * DFF + col0) = w; }
    }
};
__device__ __forceinline__ void p_adaln(const Args& a, unsigned char* lds, const int mk_wid) {
    float* sl = (float*)lds;
    float* part = (float*)(lds + 17 * 1024 * 4);
    const int tid = MK_TID;
    const float* c = a.in[1]; const float* cctx = a.in[3]; const float* W = a.in[4]; const float* bada = a.in[5];
    float* MOD = (float*)(a.ws + WS_MOD);
    for (int i = tid; i < 17 * 1024; i += 512) { const float v = (i < 16 * 1024) ? c[i] : cctx[i - 16 * 1024]; sl[i] = v / (1.f + expf(-v)); }
    __syncthreads();
    for (int w = blockIdx.x; w < 192; w += gridDim.x) {
        const int col = w * 32 + (tid & 31), kg = tid >> 5;
        float acc[17];
#pragma unroll
        for (int v = 0; v < 17; ++v) acc[v] = 0.f;
        for (int kk = 0; kk < 64; kk += 16) { const int k = kg * 64 + kk; float wv[16];
#pragma unroll
            for (int j = 0; j < 16; ++j) wv[j] = __builtin_nontemporal_load(W + (size_t)(k + j) * 6144 + col);
#pragma unroll
            for (int v = 0; v < 17; ++v)
#pragma unroll
                for (int j4 = 0; j4 < 4; ++j4) { const f32x4 s4 = *(const f32x4*)(sl + v * 1024 + k + 4 * j4);
                    acc[v] += (s4.x * wv[4 * j4] + s4.y * wv[4 * j4 + 1]) + (s4.z * wv[4 * j4 + 2] + s4.w * wv[4 * j4 + 3]); } }
#pragma unroll
        for (int v = 0; v < 17; ++v) part[(kg * 17 + v) * 32 + (tid & 31)] = acc[v];
        __syncthreads();
        for (int i = tid; i < 17 * 32; i += 512) { const int v = i >> 5, cl = i & 31; float s = bada[w * 32 + cl];
            for (int g = 0; g < 16; ++g) s += part[(g * 17 + v) * 32 + cl];
            MOD[v * 6144 + w * 32 + cl] = s; }
        __syncthreads();
    }
}

__device__ __forceinline__ void transpose_item(const float* W, int ldw, int src_n0, int k0, u16* WT, int K, int dst_n0, bool zero, float* scr, int lane) {
    { const int kr = lane >> 3, n4 = (lane & 7) * 4; f32x4 v[8];
#pragma unroll
      for (int i = 0; i < 8; ++i) v[i] = zero ? (f32x4){0.f, 0.f, 0.f, 0.f} : __builtin_nontemporal_load((const f32x4*)(W + (size_t)(k0 + 8 * i + kr) * ldw + src_n0 + n4));
#pragma unroll
      for (int i = 0; i < 8; ++i) { float* d = scr + (8 * i + kr) * 33 + n4; d[0] = v[i].x; d[1] = v[i].y; d[2] = v[i].z; d[3] = v[i].w; } }
    asm volatile("s_waitcnt lgkmcnt(0)" ::: "memory");
    const int c = lane & 7;
#pragma unroll
    for (int j = 0; j < 4; ++j) { const int n = (lane >> 3) + 8 * j; const float* s = scr + (8 * c) * 33 + n;
        v4u o; o.x = pk2(s[0 * 33], s[1 * 33]); o.y = pk2(s[2 * 33], s[3 * 33]); o.z = pk2(s[4 * 33], s[5 * 33]); o.w = pk2(s[6 * 33], s[7 * 33]);
        *(v4u*)(WT + (size_t)(dst_n0 + n) * K + k0 + 8 * c) = o; }
    asm volatile("s_waitcnt lgkmcnt(0)" ::: "memory");
}
__device__ __forceinline__ void norm_mod_row2(const float* xrow0, const float* xrow1, const float* g, const float* shift0, const float* scale0, const float* shift1, const float* scale1, u16* orow0, u16* orow1, int lane) {
    const f32x4* xr0 = (const f32x4*)xrow0 + lane; const f32x4* xr1 = (const f32x4*)xrow1 + lane;
    f32x4 v0[4], v1[4]; float s0 = 0.f, s1 = 0.f;
#pragma unroll
    for (int j = 0; j < 4; ++j) { v0[j] = __builtin_nontemporal_load(xr0 + 64 * j); v1[j] = __builtin_nontemporal_load(xr1 + 64 * j); }
#pragma unroll
    for (int j = 0; j < 4; ++j) { s0 += (v0[j].x * v0[j].x + v0[j].y * v0[j].y) + (v0[j].z * v0[j].z + v0[j].w * v0[j].w); s1 += (v1[j].x * v1[j].x + v1[j].y * v1[j].y) + (v1[j].z * v1[j].z + v1[j].w * v1[j].w); }
#pragma unroll
    for (int o = 1; o < 64; o <<= 1) { s0 += __shfl_xor(s0, o); s1 += __shfl_xor(s1, o); }
    const float r0 = rsqrtf(s0 * (1.f / DM) + EPS), r1 = rsqrtf(s1 * (1.f / DM) + EPS);
    unsigned long long* o80 = (unsigned long long*)orow0 + lane; unsigned long long* o81 = (unsigned long long*)orow1 + lane;
#pragma unroll
    for (int j = 0; j < 4; ++j) { const f32x4 gg = ((const f32x4*)g)[lane + 64 * j];
        const f32x4 sh0 = ((const f32x4*)shift0)[lane + 64 * j], sc0 = ((const f32x4*)scale0)[lane + 64 * j], sh1 = ((const f32x4*)shift1)[lane + 64 * j], sc1 = ((const f32x4*)scale1)[lane + 64 * j];
        const f32x4 y0 = (v0[j] * r0 * gg) * (sc0 + 1.f) + sh0, y1 = (v1[j] * r1 * gg) * (sc1 + 1.f) + sh1;
        o80[64 * j] = (unsigned long long)pk2(y0.x, y0.y) | ((unsigned long long)pk2(y0.z, y0.w) << 32);
        o81[64 * j] = (unsigned long long)pk2(y1.x, y1.y) | ((unsigned long long)pk2(y1.z, y1.w) << 32); }
}
__device__ __forceinline__ void norm_mod_row2_bf(const u16* xrow0, const u16* xrow1, const float* g, const float* shift, const float* scale, u16* orow0, u16* orow1, int lane) {
    v4u w0[2], w1[2]; float x0[2][8], x1[2][8]; float s0 = 0.f, s1 = 0.f;
#pragma unroll
    for (int j = 0; j < 2; ++j) { w0[j] = *(const v4u*)(xrow0 + 512 * j + 8 * lane); w1[j] = *(const v4u*)(xrow1 + 512 * j + 8 * lane); }
#pragma unroll
    for (int j = 0; j < 2; ++j) { const unsigned a_[4] = {w0[j].x, w0[j].y, w0[j].z, w0[j].w}, b_[4] = {w1[j].x, w1[j].y, w1[j].z, w1[j].w};
#pragma unroll
        for (int e = 0; e < 4; ++e) { x0[j][2 * e] = bf2f((u16)(a_[e] & 0xffffu)); x0[j][2 * e + 1] = bf2f((u16)(a_[e] >> 16)); x1[j][2 * e] = bf2f((u16)(b_[e] & 0xffffu)); x1[j][2 * e + 1] = bf2f((u16)(b_[e] >> 16)); }
#pragma unroll
        for (int e = 0; e < 8; ++e) { s0 += x0[j][e] * x0[j][e]; s1 += x1[j][e] * x1[j][e]; } }
#pragma unroll
    for (int o = 1; o < 64; o <<= 1) { s0 += __shfl_xor(s0, o); s1 += __shfl_xor(s1, o); }
    const float r0 = rsqrtf(s0 * (1.f / DM) + EPS), r1 = rsqrtf(s1 * (1.f / DM) + EPS);
#pragma unroll
    for (int j = 0; j < 2; ++j) { const int c0 = 512 * j + 8 * lane; float y0[8], y1[8];
#pragma unroll
        for (int h4 = 0; h4 < 2; ++h4) { const f32x4 gg = *(const f32x4*)(g + c0 + 4 * h4), sh = *(const f32x4*)(shift + c0 + 4 * h4), sc = *(const f32x4*)(scale + c0 + 4 * h4);
#pragma unroll
            for (int e = 0; e < 4; ++e) { y0[4 * h4 + e] = (x0[j][4 * h4 + e] * r0 * gg[e]) * (sc[e] + 1.f) + sh[e]; y1[4 * h4 + e] = (x1[j][4 * h4 + e] * r1 * gg[e]) * (sc[e] + 1.f) + sh[e]; } }
        v4u o0 = {pk2(y0[0], y0[1]), pk2(y0[2], y0[3]), pk2(y0[4], y0[5]), pk2(y0[6], y0[7])}, o1 = {pk2(y1[0], y1[1]), pk2(y1[2], y1[3]), pk2(y1[4], y1[5]), pk2(y1[6], y1[7])};
        *(v4u*)(orow0 + c0) = o0; *(v4u*)(orow1 + c0) = o1; }
}
__device__ __forceinline__ void p_weights(const Args& a, unsigned char* lds, const int mk_wid, const int item_lo, const int item_hi, const int blk_lo, const bool do_rope) {
    const int tid = MK_TID, lane = tid & 63, wave = mk_wid;
    float* scr = (float*)(lds + wave * 16384);
    if ((int)blockIdx.x < blk_lo) return;
    const int gw = ((int)blockIdx.x - blk_lo) * 8 + wave, NGW = ((int)gridDim.x - blk_lo) * 8;
    unsigned char* ws = a.ws;
    constexpr int I_IN = 16 * 216, I_SQ = 16 * 32, I_FI = 16 * 176, I_FO = 44 * 32;
    constexpr int NITEMS = I_IN + 3 * I_SQ + I_FI + I_FO;
    for (int it = item_lo + gw; it < (item_hi < NITEMS ? item_hi : NITEMS); it += NGW) {
        int r = it;
        if (r < I_IN) { const int kb = r / 216, nb = r % 216, n0 = 32 * nb; const bool zero = n0 >= 6688;
            const int src = n0 < 4608 ? n0 : (n0 < 6656 ? n0 + 32 : n0 - 2048);
            transpose_item(a.in[7], 6688, zero ? 0 : src, 64 * kb, (u16*)(ws + WS_WIN), 1024, n0, zero, scr, lane); continue; }
        r -= I_IN;
        if (r < 3 * I_SQ) { const int which = r / I_SQ, q = r % I_SQ, kb = q / 32, nb = q % 32;
            const float* W = which == 0 ? a.in[15] : (which == 1 ? a.in[16] : a.in[17]);
            u16* WT = (u16*)(ws + (which == 0 ? WS_WAP : (which == 1 ? WS_WGP : WS_WOUT)));
            transpose_item(W, 1024, 32 * nb, 64 * kb, WT, 1024, 32 * nb, false, scr, lane); continue; }
        r -= 3 * I_SQ;
        if (r < I_FI) { const int kb = r / 176, nb = r % 176, n0 = 32 * nb, pn = n0 >> 8, j = n0 & 255;
            const int src = j < 128 ? pn * 128 + j : DFF + pn * 128 + (j - 128);
            transpose_item(a.in[19], 2 * DFF, src, 64 * kb, (u16*)(ws + WS_WFI), 1024, n0, false, scr, lane); continue; }
        r -= I_FI;
        { const int kb = r / 32, nb = r % 32; transpose_item(a.in[20], 1024, 32 * nb, 64 * kb, (u16*)(ws + WS_WFO), DFF, 32 * nb, false, scr, lane); }
    }
    float* rope = (float*)(ws + WS_ROPE);
    if (do_rope) for (int idx = blockIdx.x * 512 + tid; idx < T * 64; idx += gridDim.x * 512) { const int t = idx >> 6, i = idx & 63, j = i & 31;
        const float pos = (float)(i < 32 ? (t >> 6) : (t & 63));
        const float inv = 1.0f / powf(10000.f, (float)(2 * j) / 64.f);
        const float ang = pos * inv;
        rope[2 * idx] = cosf(ang); rope[2 * idx + 1] = sinf(ang); }
}

__device__ __forceinline__ void p_h1rows(const Args& a, const int mk_wid) {
    const int tid = MK_TID, lane = tid & 63, wave = mk_wid;
    const int gw = blockIdx.x * 8 + wave, NGW = gridDim.x * 8;
    unsigned char* ws = a.ws;
    const float* MOD = (const float*)(ws + WS_MOD);
    for (int m0 = gw * 2; m0 < MALL; m0 += NGW * 2) {
        const float* src[2]; const float* mod[2];
#pragma unroll
        for (int e = 0; e < 2; ++e) { const int m = m0 + e, b = m / TA, r = m % TA; const bool isc = r < TC;
            src[e] = isc ? a.in[2] + ((size_t)b * TC + r) * DM : a.in[0] + ((size_t)b * T + (r - TC)) * DM; mod[e] = MOD + (size_t)(isc ? 16 : b) * 6144; }
        norm_mod_row2(src[0], src[1], a.in[6], mod[0], mod[0] + 1024, mod[1], mod[1] + 1024, (u16*)(ws + WS_H1) + (size_t)m0 * DM, (u16*)(ws + WS_H1) + (size_t)(m0 + 1) * DM, lane); }
}

__device__ __forceinline__ void p_lowrank(const Args& a, unsigned char* lds, const int mk_wid) {
    const int tid = MK_TID, lane = tid & 63, r32 = lane & 31, hi = lane >> 5;
    constexpr int WP = 1032, APT = 136;
    u16* wl = (u16*)lds; u16* al = (u16*)(lds + 32 * WP * 2);
    const u16* H1 = (const u16*)(a.ws + WS_H1); const u16* WL = (const u16*)(a.ws + WS_WIN) + (size_t)6656 * 1024; u16* LR = (u16*)(a.ws + WS_LR);
    const int rb0 = (int)gridDim.x >= 256 ? (int)blockIdx.x - ((int)gridDim.x - MALL / 256) : (int)blockIdx.x;
    if (rb0 < 0 || rb0 >= MALL / 256) return;
#pragma unroll
    for (int p = 0; p < 8; ++p) { const int piece = p * 512 + tid, row = piece >> 7, c8 = piece & 127; *(v4u*)(wl + row * WP + c8 * 8) = *(const v4u*)(WL + (size_t)row * 1024 + c8 * 8); }
    for (int rb = rb0; rb < MALL / 256; rb += gridDim.x) {
        const u16* Ab = H1 + (size_t)rb * 256 * 1024;
        v4u st[8];
#pragma unroll
        for (int p = 0; p < 8; ++p) { const int piece = p * 512 + tid, row = piece >> 4, c8 = piece & 15; st[p] = *(const v4u*)(Ab + (size_t)row * 1024 + c8 * 8); }
        att::f32x16 acc = att::f32x16{};
        for (int kc = 0; kc < 8; ++kc) {
            __syncthreads();
#pragma unroll
            for (int p = 0; p < 8; ++p) { const int piece = p * 512 + tid, row = piece >> 4, c8 = piece & 15; *(v4u*)(al + row * APT + c8 * 8) = st[p]; }
            if (kc + 1 < 8) {
#pragma unroll
                for (int p = 0; p < 8; ++p) { const int piece = p * 512 + tid, row = piece >> 4, c8 = piece & 15; st[p] = *(const v4u*)(Ab + (size_t)row * 1024 + (kc + 1) * 128 + c8 * 8); } }
            __syncthreads();
            const u16* ap = al + (mk_wid * 32 + r32) * APT + 8 * hi; const u16* bp = wl + r32 * WP + kc * 128 + 8 * hi;
#pragma unroll
            for (int kb = 0; kb < 8; ++kb) acc = __builtin_amdgcn_mfma_f32_32x32x16_bf16(*(const att::bf16x8*)(ap + kb * 16), *(const att::bf16x8*)(bp + kb * 16), acc, 0, 0, 0);
        }
#pragma unroll
        for (int r = 0; r < 16; ++r) LR[(size_t)(rb * 256 + mk_wid * 32 + att::crow(r, hi)) * 32 + r32] = f2bf(acc[r]);
    }
    __syncthreads();
}
__device__ __forceinline__ void p_kprep(const Args& a, const int mk_wid) {
    const int tid = MK_TID, lane = tid & 63, wave = mk_wid;
    const int gw = blockIdx.x * 8 + wave, NGW = gridDim.x * 8;
    u16* Kb = (u16*)(a.ws + WS_K); const float* rope = (const float*)(a.ws + WS_ROPE); const float* kg = a.in[9];
    const int head = lane >> 5, l = lane & 31;
    const f32x4 g = *(const f32x4*)(kg + 4 * l);
    for (int m0 = gw * 6; m0 < MALL; m0 += NGW * 6) {
        v2u w[6]; f32x4 cs[6]; float f[6][4], s[6];
#pragma unroll
        for (int e = 0; e < 6; ++e) { const int m = m0 + e, r = m % TA; w[e] = *(const v2u*)(Kb + (size_t)m * 256 + head * 128 + 4 * l);
            cs[e] = (r >= TC) ? *(const f32x4*)(rope + ((size_t)(r - TC) * 64 + 2 * l) * 2) : (f32x4){1.f, 0.f, 1.f, 0.f}; }
#pragma unroll
        for (int e = 0; e < 6; ++e) { f[e][0] = bf2f((u16)(w[e].x & 0xffffu)); f[e][1] = bf2f((u16)(w[e].x >> 16)); f[e][2] = bf2f((u16)(w[e].y & 0xffffu)); f[e][3] = bf2f((u16)(w[e].y >> 16));
            s[e] = (f[e][0] * f[e][0] + f[e][1] * f[e][1]) + (f[e][2] * f[e][2] + f[e][3] * f[e][3]); }
#pragma unroll
        for (int o = 1; o < 32; o <<= 1) {
#pragma unroll
            for (int e = 0; e < 6; ++e) s[e] += __shfl_xor(s[e], o); }
#pragma unroll
        for (int e = 0; e < 6; ++e) { const float rinv = rsqrtf(s[e] * (1.f / 128.f) + EPS);
            const float f0 = f[e][0] * rinv * g.x, f1 = f[e][1] * rinv * g.y, f2 = f[e][2] * rinv * g.z, f3 = f[e][3] * rinv * g.w;
            v2u o; o.x = pk2(f0 * cs[e].x - f1 * cs[e].y, f0 * cs[e].y + f1 * cs[e].x); o.y = pk2(f2 * cs[e].z - f3 * cs[e].w, f2 * cs[e].w + f3 * cs[e].z);
            *(v2u*)(Kb + (size_t)(m0 + e) * 256 + head * 128 + 4 * l) = o; } }
}
__device__ __forceinline__ void p_glapost(const Args& a, const int mk_wid) {
    const int tid = MK_TID, lane = tid & 63, wave = mk_wid;
    const int gw = blockIdx.x * 8 + wave, NGW = gridDim.x * 8;
    const u16* OF = (const u16*)(a.ws + WS_OF); const u16* OB = (const u16*)(a.ws + WS_OB); u16* GG = (u16*)(a.ws + WS_GG);
    const f32x4 g = *(const f32x4*)(a.in[14] + 4 * lane);
    for (int it0 = gw * 4; it0 < MLAT * 4; it0 += NGW * 4) {
        v2u wf[4], wb[4], wg[4]; float o_[4][4], ss[4];
#pragma unroll
        for (int e = 0; e < 4; ++e) { const size_t off = (size_t)(it0 + e) * 256 + 4 * lane; wf[e] = __builtin_nontemporal_load((const v2u*)(OF + off)); wb[e] = __builtin_nontemporal_load((const v2u*)(OB + off)); wg[e] = __builtin_nontemporal_load((const v2u*)(GG + off)); }
#pragma unroll
        for (int e = 0; e < 4; ++e) {
            o_[e][0] = bf2f((u16)(wf[e].x & 0xffffu)) + bf2f((u16)(wb[e].x & 0xffffu)); o_[e][1] = bf2f((u16)(wf[e].x >> 16)) + bf2f((u16)(wb[e].x >> 16));
            o_[e][2] = bf2f((u16)(wf[e].y & 0xffffu)) + bf2f((u16)(wb[e].y & 0xffffu)); o_[e][3] = bf2f((u16)(wf[e].y >> 16)) + bf2f((u16)(wb[e].y >> 16));
            ss[e] = (o_[e][0] * o_[e][0] + o_[e][1] * o_[e][1]) + (o_[e][2] * o_[e][2] + o_[e][3] * o_[e][3]); }
#pragma unroll
        for (int o = 1; o < 64; o <<= 1) {
#pragma unroll
            for (int e = 0; e < 4; ++e) ss[e] += __shfl_xor(ss[e], o); }
#pragma unroll
        for (int e = 0; e < 4; ++e) { const float rinv = rsqrtf(ss[e] * (1.f / 256.f) + EPS);
            const float g0 = bf2f((u16)(wg[e].x & 0xffffu)), g1 = bf2f((u16)(wg[e].x >> 16)), g2 = bf2f((u16)(wg[e].y & 0xffffu)), g3 = bf2f((u16)(wg[e].y >> 16));
            v2u o; o.x = pk2(o_[e][0] * rinv * g.x * (g0 * sigmoidf_(g0)), o_[e][1] * rinv * g.y * (g1 * sigmoidf_(g1)));
            o.y = pk2(o_[e][2] * rinv * g.z * (g2 * sigmoidf_(g2)), o_[e][3] * rinv * g.w * (g3 * sigmoidf_(g3)));
            *(v2u*)(GG + (size_t)(it0 + e) * 256 + 4 * lane) = o; } }
}
__device__ __forceinline__ void p_h2(const Args& a, const int mk_wid) {
    const int tid = MK_TID, lane = tid & 63, wave = mk_wid;
    const int gw = blockIdx.x * 8 + wave, NGW = gridDim.x * 8;
    const float* MOD = (const float*)(a.ws + WS_MOD);
    const u16* X1 = (const u16*)(a.ws + WS_X1);
    for (int m0 = gw * 2; m0 < MLAT; m0 += NGW * 2) { const float* mod = MOD + (size_t)(m0 / T) * 6144;
        norm_mod_row2_bf(X1 + (size_t)m0 * DM, X1 + (size_t)(m0 + 1) * DM, a.in[18], mod + 3 * 1024, mod + 4 * 1024,
                         (u16*)(a.ws + WS_H2) + (size_t)m0 * DM, (u16*)(a.ws + WS_H2) + (size_t)(m0 + 1) * DM, lane); }
}
namespace gla {
using att::bf16x8; using att::s16x4; using att::f32x16; using att::crow; using att::v_st; using att::v_rd_base; using att::v_rd_off; using att::tr_read;
constexpr int QP = 136, AP = 72;
constexpr int L_QE = 0, L_KE = 17408, L_KD = 34816, L_V = 51200, L_AM = 83968, L_LAS = 93184, L_LR = 125952, L_GS = 128000, L_DL = 130048, L_END = 130560;
static_assert(L_END <= LDS_BYTES - 64, "GLA LDS map");
#define GLA_PK(L, H) (bf16x8){L[0], L[1], L[2], L[3], H[0], H[1], H[2], H[3]}
#define GLA_SBAR() __builtin_amdgcn_sched_barrier(0)
#define OPAQUE_TID(name) int name = MK_TID; asm volatile("" : "+v"(name))

__device__ __forceinline__ void scan_unit(const int unit, const Args& a, unsigned char* lds, const int mk_wid) {
    const int wid = mk_wid;
    const int dir = unit & 1, h = (unit >> 1) & 3, b = unit >> 3;
    const int vt = wid;
    const u16* GQ = (const u16*)(a.ws + WS_GQ); const u16* GK = (const u16*)(a.ws + WS_GK); const u16* GV = (const u16*)(a.ws + WS_GV); const u16* LR = (const u16*)(a.ws + WS_LR);
    u16* OUT = (u16*)(a.ws + (dir ? WS_OB : WS_OF));
    bf16x8 upf; float biasc;
    { const int l_ = MK_TID & 63, r32 = l_ & 31, hi = l_ >> 5; const float* up = a.in[dir ? 12 : 10] + (size_t)(8 * hi) * 512 + h * 128 + (wid & 3) * 32 + r32;
      v4u w; w.x = pk2(up[0], up[512]); w.y = pk2(up[2 * 512], up[3 * 512]); w.z = pk2(up[4 * 512], up[5 * 512]); w.w = pk2(up[6 * 512], up[7 * 512]);
      upf = __builtin_bit_cast(bf16x8, w); biasc = a.in[dir ? 13 : 11][h * 128 + (wid & 3) * 32 + r32]; }
    u16* qe = (u16*)(lds + L_QE); u16* ke = (u16*)(lds + L_KE); u16* am = (u16*)(lds + L_AM);
    float* las = (float*)(lds + L_LAS); float* gs = (float*)(lds + L_GS); float* dl = (float*)(lds + L_DL);
    const int ldsb = (int)(uintptr_t)lds;
    u16* ot = (u16*)(lds + L_LAS);
    int pend_cc = -1;
#define GLA_FLUSH() do { if (pend_cc >= 0) { OPAQUE_TID(tf_); const size_t rl0_ = (size_t)b * T + (size_t)(pend_cc - 4) * 64; \
      _Pragma("unroll") for (int p = 0; p < 4; ++p) { const int idx_ = p * 512 + tf_, i_ = idx_ >> 5, c16_ = idx_ & 31; \
          *(v4u*)(OUT + (rl0_ + (dir ? 63 - i_ : i_)) * 1024 + h * 256 + c16_ * 8) = *(const v4u*)(ot + i_ * 256 + c16_ * 8); } } } while (0)
    f32x16 S[4]; S[0] = f32x16{}; S[1] = f32x16{}; S[2] = f32x16{}; S[3] = f32x16{};
    bf16x8 qraw[2], kraw[2], vraw[4]; bf16x8 lraw = bf16x8{};
#define GLA_CHUNK(s) (dir ? ((s) < 4 ? 3 - (s) : 39 - (s)) : (s))
#define GLA_LOAD(s) do { OPAQUE_TID(t_); const int cc_ = GLA_CHUNK(s); const size_t rowb_ = (size_t)b * TA + (size_t)cc_ * 64; \
      _Pragma("unroll") for (int p = 0; p < 2; ++p) { const int i_ = p * 32 + (t_ >> 4); const size_t row_ = rowb_ + (dir ? 63 - i_ : i_); \
          kraw[p] = __builtin_nontemporal_load((const bf16x8*)(GK + row_ * 512 + h * 128 + (t_ & 15) * 8)); \
          qraw[p] = (cc_ >= 4) ? __builtin_nontemporal_load((const bf16x8*)(GQ + row_ * 512 + h * 128 + (t_ & 15) * 8)) : bf16x8{}; } \
      _Pragma("unroll") for (int p = 0; p < 4; ++p) { const int i_ = p * 16 + (t_ >> 5); const size_t row_ = rowb_ + (dir ? 63 - i_ : i_); \
          vraw[p] = __builtin_nontemporal_load((const bf16x8*)(GV + row_ * 1024 + h * 256 + (t_ & 31) * 8)); } \
      if (t_ < 128) { const int i_ = t_ >> 1; const size_t row_ = rowb_ + (dir ? 63 - i_ : i_); lraw = *(const bf16x8*)(LR + row_ * 32 + dir * 16 + (t_ & 1) * 8); } } while (0)
    GLA_LOAD(0);
    for (int step = 0; step < 36; ++step) {
        const int cc = GLA_CHUNK(step); const bool lat = cc >= 4;
        GLA_FLUSH();
        { OPAQUE_TID(t_);
#pragma unroll
          for (int p = 0; p < 2; ++p) { const int i_ = p * 32 + (t_ >> 4), c_ = (t_ & 15) * 8; *(bf16x8*)(qe + i_ * QP + c_) = qraw[p]; *(bf16x8*)(ke + i_ * QP + c_) = kraw[p]; }
#pragma unroll
          for (int p = 0; p < 4; ++p) { const int i_ = p * 16 + (t_ >> 5), c8 = t_ & 31; *(bf16x8*)(lds + L_V + (c8 >> 4) * 16384 + v_st(i_, (c8 & 15) * 8)) = vraw[p]; }
          if (t_ < 128) *(bf16x8*)(lds + L_LR + (t_ >> 1) * 32 + (t_ & 1) * 16) = lraw; }
        __syncthreads();
        { OPAQUE_TID(t_); const int lane = t_ & 63, r32 = lane & 31, hi = lane >> 5; const int tt = wid >> 2, ct = wid & 3;
          const bf16x8 af = *(const bf16x8*)(lds + L_LR + (tt * 32 + r32) * 32 + hi * 16);
          const f32x16 z = __builtin_amdgcn_mfma_f32_32x32x16_bf16(af, upf, f32x16{}, 0, 0, 0);
          float* lw = las + (tt * 32 + 4 * hi) * 128 + ct * 32 + r32;
#pragma unroll
          for (int r = 0; r < 16; ++r) { const float zz = z[r] + biasc;
              lw[crow(r, 0) * 128] = (fminf(zz, 0.f) - __builtin_amdgcn_logf(1.f + __builtin_amdgcn_exp2f(-1.4426950408889634f * fabsf(zz))) * 0.6931471805599453f) * (1.f / 16.f); } }
        __syncthreads();
        { OPAQUE_TID(t_); const int c = t_ & 127, g = t_ >> 7;
          float bl[16]; float run = 0.f;
          { const float* lp = las + (g * 16) * 128 + c;
#pragma unroll
            for (int ii = 0; ii < 16; ++ii) { run += lp[ii * 128]; bl[ii] = run; } }
          gs[g * 128 + c] = run;
          __syncthreads();
          const float g0 = gs[c], g1 = gs[128 + c], g2 = gs[256 + c], g3 = gs[384 + c];
          const float off = (g > 0 ? g0 : 0.f) + (g > 1 ? g1 : 0.f) + (g > 2 ? g2 : 0.f);
          const float btot = (g0 + g1) + (g2 + g3);
          const float dlc = __builtin_amdgcn_exp2f(btot * 1.4426950408889634f);
          if (g == 0) dl[c] = dlc;
          u16* qcol = qe + (g * 16) * QP + c; u16* kcol = ke + (g * 16) * QP + c; unsigned char* kdb = lds + L_KD + v_st(g * 16, c);
#pragma unroll
          for (int ii = 0; ii < 16; ++ii) { const float bb = bl[ii] + off;
              const float qf = bf2f(qcol[ii * QP]), kf = bf2f(kcol[ii * QP]);
              const float e = __builtin_amdgcn_exp2f(bb * 1.4426950408889634f), ker = kf * __builtin_amdgcn_rcpf(e);
              qcol[ii * QP] = f2bf(qf * (0.088388347648318440f * e));
              kcol[ii * QP] = f2bf(ker);
              *(u16*)(kdb + v_st(ii, 0)) = f2bf(ker * dlc); } }
        if (step + 1 < 36) GLA_LOAD(step + 1);
        __syncthreads();
        if (lat) {
            if (wid < 4) { OPAQUE_TID(t_); const int r32 = t_ & 31, hi = (t_ >> 5) & 1;
                const int jt = wid >> 1, it = wid & 1; f32x16 ct = f32x16{};
                const u16* kp = ke + (jt * 32 + r32) * QP + hi * 8; const u16* qp = qe + (it * 32 + r32) * QP + hi * 8;
#pragma unroll
                for (int kb = 0; kb < 8; ++kb) ct = __builtin_amdgcn_mfma_f32_32x32x16_bf16(*(const bf16x8*)(kp + kb * 16), *(const bf16x8*)(qp + kb * 16), ct, 0, 0, 0);
                const int i = it * 32 + r32;
#pragma unroll
                for (int rg = 0; rg < 4; ++rg) { const int j0 = jt * 32 + 8 * rg + 4 * hi;
                    const float x0 = (j0 + 0 <= i) ? ct[4 * rg + 0] : 0.f, x1 = (j0 + 1 <= i) ? ct[4 * rg + 1] : 0.f, x2 = (j0 + 2 <= i) ? ct[4 * rg + 2] : 0.f, x3 = (j0 + 3 <= i) ? ct[4 * rg + 3] : 0.f;
                    v2u w; w.x = pk2(x0, x1); w.y = pk2(x2, x3); *(v2u*)(am + i * AP + j0) = w; } }
            __syncthreads();
        }
        { OPAQUE_TID(t_); const int lane = t_ & 63, r32 = lane & 31, hi = lane >> 5;
          const int vb = ldsb + L_V + (vt >> 2) * 16384 + v_rd_base(lane) + (vt & 3) * 512;
          s16x4 vl0, vh0, vl1, vh1, vl2, vh2, vl3, vh3;
#define GLA_LOADV() do { vl0 = tr_read<v_rd_off(0, 0, 0)>(vb); vh0 = tr_read<v_rd_off(0, 0, 1)>(vb); vl1 = tr_read<v_rd_off(0, 1, 0)>(vb); vh1 = tr_read<v_rd_off(0, 1, 1)>(vb); \
              vl2 = tr_read<v_rd_off(0, 2, 0)>(vb); vh2 = tr_read<v_rd_off(0, 2, 1)>(vb); vl3 = tr_read<v_rd_off(0, 3, 0)>(vb); vh3 = tr_read<v_rd_off(0, 3, 1)>(vb); } while (0)
          if (!lat) GLA_LOADV();
          if (lat) {
              f32x16 o0 = f32x16{}, o1 = f32x16{};
#pragma unroll
              for (int ct = 0; ct < 4; ++ct)
#pragma unroll
                for (int kb = 0; kb < 2; ++kb) { const int cb = ct * 32 + kb * 16;
                    v4u sw; sw.x = pk2(S[ct][8 * kb + 0], S[ct][8 * kb + 1]); sw.y = pk2(S[ct][8 * kb + 2], S[ct][8 * kb + 3]); sw.z = pk2(S[ct][8 * kb + 4], S[ct][8 * kb + 5]); sw.w = pk2(S[ct][8 * kb + 6], S[ct][8 * kb + 7]);
                    const bf16x8 sb = __builtin_bit_cast(bf16x8, sw);
                    { const u16* p0 = qe + r32 * QP + cb + 4 * hi; const v2u lo = *(const v2u*)p0, hh = *(const v2u*)(p0 + 8); v4u aw = {lo.x, lo.y, hh.x, hh.y};
                      o0 = __builtin_amdgcn_mfma_f32_32x32x16_bf16(__builtin_bit_cast(bf16x8, aw), sb, o0, 0, 0, 0); }
                    { const u16* p1 = qe + (32 + r32) * QP + cb + 4 * hi; const v2u lo = *(const v2u*)p1, hh = *(const v2u*)(p1 + 8); v4u aw = {lo.x, lo.y, hh.x, hh.y};
                      o1 = __builtin_amdgcn_mfma_f32_32x32x16_bf16(__builtin_bit_cast(bf16x8, aw), sb, o1, 0, 0, 0); } }
              GLA_LOADV();
              asm volatile("s_waitcnt lgkmcnt(0)" ::: "memory"); GLA_SBAR();
              { const u16* a0 = am + r32 * AP + hi * 8; const u16* a1 = am + (32 + r32) * AP + hi * 8;
                o0 = __builtin_amdgcn_mfma_f32_32x32x16_bf16(*(const bf16x8*)(a0), GLA_PK(vl0, vh0), o0, 0, 0, 0);
                o0 = __builtin_amdgcn_mfma_f32_32x32x16_bf16(*(const bf16x8*)(a0 + 16), GLA_PK(vl1, vh1), o0, 0, 0, 0);
                o1 = __builtin_amdgcn_mfma_f32_32x32x16_bf16(*(const bf16x8*)(a1), GLA_PK(vl0, vh0), o1, 0, 0, 0);
                o1 = __builtin_amdgcn_mfma_f32_32x32x16_bf16(*(const bf16x8*)(a1 + 16), GLA_PK(vl1, vh1), o1, 0, 0, 0);
                o1 = __builtin_amdgcn_mfma_f32_32x32x16_bf16(*(const bf16x8*)(a1 + 32), GLA_PK(vl2, vh2), o1, 0, 0, 0);
                o1 = __builtin_amdgcn_mfma_f32_32x32x16_bf16(*(const bf16x8*)(a1 + 48), GLA_PK(vl3, vh3), o1, 0, 0, 0); }
              { u16* ow = ot + (4 * hi) * 256 + vt * 32 + r32;
#pragma unroll
                for (int r = 0; r < 16; ++r) { const int i0 = crow(r, 0); ow[i0 * 256] = f2bf(o0[r]); ow[(i0 + 32) * 256] = f2bf(o1[r]); } }
          }
#pragma unroll
          for (int ct = 0; ct < 4; ++ct) { const int kb_ = ldsb + L_KD + v_rd_base(lane) + ct * 512;
              const s16x4 al0 = tr_read<v_rd_off(0, 0, 0)>(kb_), ah0 = tr_read<v_rd_off(0, 0, 1)>(kb_), al1 = tr_read<v_rd_off(0, 1, 0)>(kb_), ah1 = tr_read<v_rd_off(0, 1, 1)>(kb_);
              const s16x4 al2 = tr_read<v_rd_off(0, 2, 0)>(kb_), ah2 = tr_read<v_rd_off(0, 2, 1)>(kb_), al3 = tr_read<v_rd_off(0, 3, 0)>(kb_), ah3 = tr_read<v_rd_off(0, 3, 1)>(kb_);
              const float* dp = dl + ct * 32 + 4 * hi;
#pragma unroll
              for (int rg = 0; rg < 4; ++rg) { const f32x4 d4 = *(const f32x4*)(dp + 8 * rg);
                  S[ct][4 * rg + 0] *= d4.x; S[ct][4 * rg + 1] *= d4.y; S[ct][4 * rg + 2] *= d4.z; S[ct][4 * rg + 3] *= d4.w; }
              asm volatile("s_waitcnt lgkmcnt(0)" ::: "memory"); GLA_SBAR();
              S[ct] = __builtin_amdgcn_mfma_f32_32x32x16_bf16(GLA_PK(al0, ah0), GLA_PK(vl0, vh0), S[ct], 0, 0, 0);
              S[ct] = __builtin_amdgcn_mfma_f32_32x32x16_bf16(GLA_PK(al1, ah1), GLA_PK(vl1, vh1), S[ct], 0, 0, 0);
              S[ct] = __builtin_amdgcn_mfma_f32_32x32x16_bf16(GLA_PK(al2, ah2), GLA_PK(vl2, vh2), S[ct], 0, 0, 0);
              S[ct] = __builtin_amdgcn_mfma_f32_32x32x16_bf16(GLA_PK(al3, ah3), GLA_PK(vl3, vh3), S[ct], 0, 0, 0); } }
        __syncthreads();
        pend_cc = lat ? cc : -1;
    }
    GLA_FLUSH();
    __syncthreads();
#undef GLA_FLUSH
#undef GLA_LOADV
#undef GLA_CHUNK
#undef GLA_LOAD
}
}
#define XB_TMO      128
#define XB_XCNT(j)  (256  + 64 * (j))
#define XB_XSUB(j)  (1280 + 64 * (j))
#define XB_XGEN(j)  (2304 + 64 * (j))
#define XB_TOP      3328
#define XB_TOPGEN   3392
#define XCD_BAR_WORDS 3456
#define XB_SPIN_CAP (1u << 18)

__device__ __forceinline__ unsigned xb_ld(unsigned* p)              { return __hip_atomic_load(p, __ATOMIC_RELAXED, __HIP_MEMORY_SCOPE_AGENT); }
__device__ __forceinline__ unsigned xb_add(unsigned* p, unsigned v) { return __hip_atomic_fetch_add(p, v, __ATOMIC_RELAXED, __HIP_MEMORY_SCOPE_AGENT); }
__device__ __forceinline__ unsigned xb_xcc_id() { return (unsigned)__builtin_amdgcn_s_getreg((3 << 11) | 20) & 0xFu; }
#define XB_SPIN(cond, bar) do { unsigned _sp = 0; while (cond) { __builtin_amdgcn_s_sleep(1); \
    if ((++_sp & 255u) == 0u) { if (xb_ld(&(bar)[XB_TMO])) break; if (_sp > XB_SPIN_CAP) { atomicAdd(&(bar)[XB_TMO], 1u); break; } } } } while (0)

struct XcdBarrier {
    unsigned* bar; unsigned x;
    volatile LAS unsigned* st;
};

__device__ __forceinline__ XcdBarrier xcd_barrier_post(unsigned* bar, volatile LAS unsigned* st, const bool tid0) {
    XcdBarrier b; b.bar = bar; b.x = xb_xcc_id(); b.st = st;
    if (tid0) (void)xb_add(&bar[XB_XCNT(b.x)], 1u);
    return b;
}
__device__ __forceinline__ void xcd_barrier_complete(unsigned* bar, unsigned x, unsigned& nloc, unsigned& nx) {
    const unsigned G = gridDim.x * gridDim.y * gridDim.z;
    unsigned sum, cnt, mine, sp = 0u;
    for (;;) {
        sum = 0u; cnt = 0u; mine = 0u;
#pragma unroll
        for (unsigned j = 0; j < 16; ++j) { const unsigned c = xb_ld(&bar[XB_XCNT(j)]); sum += c; cnt += (c > 0u) ? 1u : 0u; mine = (j == x) ? c : mine; }
        if (sum == G) break;
        __builtin_amdgcn_s_sleep(1);
        if ((++sp & 255u) == 0u) { if (xb_ld(&bar[XB_TMO])) break; if (sp > XB_SPIN_CAP) { atomicAdd(&bar[XB_TMO], 1u); break; } }
    }
    nloc = mine > 0u ? mine : 1u; nx = cnt > 0u ? cnt : 1u;
}

__device__ __forceinline__ void xcd_barrier(const XcdBarrier& b, const bool tid0) {
    asm volatile("s_waitcnt vmcnt(0)" ::: "memory");
    __syncthreads();
    if (tid0) {
        unsigned* bar = b.bar; const unsigned bx_ = (unsigned)__builtin_amdgcn_readfirstlane((int)xb_xcc_id());
        __builtin_amdgcn_s_waitcnt(0);
        unsigned nloc = b.st[0], nx = b.st[1];
        if (nloc == 0u) { xcd_barrier_complete(bar, bx_, nloc, nx); b.st[0] = nloc; b.st[1] = nx; }
        const unsigned old = xb_add(&bar[XB_XSUB(bx_)], 1u);
        const unsigned gen = old / nloc;
        if (old + 1u == (gen + 1u) * nloc) {
            __builtin_amdgcn_fence(__ATOMIC_RELEASE, "agent");
            asm volatile("s_waitcnt vmcnt(0)" ::: "memory");
            const unsigned og = xb_add(&bar[XB_TOP], 1u);
            const unsigned tg = og / nx;
            if (og + 1u == (tg + 1u) * nx) xb_add(&bar[XB_TOPGEN], 1u);
            else XB_SPIN(xb_ld(&bar[XB_TOPGEN]) == tg, bar);
            __builtin_amdgcn_fence(__ATOMIC_ACQUIRE, "agent");
            xb_add(&bar[XB_XGEN(bx_)], 1u);
            asm volatile("s_waitcnt vmcnt(0)" ::: "memory");
        } else {
            XB_SPIN(xb_ld(&bar[XB_XGEN(bx_)]) == gen, bar);
            __builtin_amdgcn_fence(__ATOMIC_ACQUIRE, "agent");
            asm volatile("s_waitcnt vmcnt(0)" ::: "memory");
        }
    }
    __syncthreads();
}
#ifndef MK_PER_PHASE
#define MK_PER_PHASE 0
#endif
__global__ void __launch_bounds__(512) mk_fwd(Args a) {
    extern __shared__ __attribute__((aligned(16))) unsigned char lds[];
    cg::grid_group grid = cg::this_grid();
    unsigned char* ws = a.ws;
    LAS unsigned char* lds3 = (LAS unsigned char*)lds;
    const int G = gridDim.x, bx = blockIdx.x;
    const int mk_wid = __builtin_amdgcn_readfirstlane(threadIdx.x >> 6);
#ifndef PHMASK
#define PHMASK 0x7ff
#endif
#define IN(k) (((PHMASK >> (k)) & 1) && a.ph_lo <= (k) && (k) < a.ph_hi)
    unsigned* bar_words = (unsigned*)(ws + 4096);
    volatile LAS unsigned* bar_st = (volatile LAS unsigned*)(lds3 + (LDS_BYTES - 64));
    { const int t0_ = MK_TID; if (t0_ < 2) bar_st[t0_] = 0u; }
    if (IN(0) && bx == 0) { for (int i = MK_TID; i < XCD_BAR_WORDS; i += 512) __hip_atomic_store(bar_words + i, 0u, __ATOMIC_RELAXED, __HIP_MEMORY_SCOPE_AGENT); }
#define SEAM(k) do { if (IN(k) && IN((k) + 1)) { if ((k) == 0) { grid.sync(); (void)xcd_barrier_post(bar_words, bar_st, MK_TID == 0); } else { unsigned long long bp_ = (unsigned long long)(a.ws + 4096); asm volatile("" : "+s"(bp_)); XcdBarrier xb_; xb_.bar = (unsigned*)bp_; xb_.x = 0; xb_.st = bar_st; xcd_barrier(xb_, MK_TID == 0); } } } while (0)
    if (IN(0)) p_adaln(a, lds, mk_wid);
    SEAM(0);
    if (IN(1)) { p_weights(a, lds, mk_wid, 0, (G == 256) ? WI_IN : WI_ALL, 0, true); p_h1rows(a, mk_wid); }
    SEAM(1);
    if (IN(2)) {
        pg8::Gemm g{(const pg8::bf16_t*)(ws + WS_H1), (const pg8::bf16_t*)(ws + WS_WIN), MALL, NIN, DM}; InProjOrder S; S.init(G, bx);
        EpiInProj E{ws, (u16*)a.out};
        p_lowrank(a, lds, mk_wid);
        __syncthreads();
        pg8::gemm_phase<EpiInProj, InProjOrder, true, true>(lds3, g, S, E, mk_wid);
        if (G == 256) p_weights(a, lds, mk_wid, WI_IN, WI_PROJ, 128, false);
    }
    SEAM(2);
    if (IN(3)) p_kprep(a, mk_wid);
    SEAM(3);
    if (IN(4)) {
        const att::bf16* Qp = (const att::bf16*)(ws + WS_Q); const att::bf16* Kp = (const att::bf16*)(ws + WS_K); const att::bf16* Vp = (const att::bf16*)(ws + WS_V);
        const float* rope = (const float*)(ws + WS_ROPE);
        const bool full = (G == 256);
        if (full) { if (bx < 128) gla::scan_unit(bx, a, lds, mk_wid); }
        else { for (int u = bx; u < 128; u += G) gla::scan_unit(u, a, lds, mk_wid); }
        __syncthreads();
        const int xj = bx >> 3, xx = bx & 7;
        const int nun = full ? (xj < 16 ? 3 : 5) : 0;
        for (int i = 0; ; ++i) {
            int bk, w;
            if (full) { if (i >= nun) break; const int idx = (xj < 16) ? 80 + i * 16 + xj : i * 16 + (xj - 16); bk = (idx >> 5) * 8 + xx; w = idx & 31; }
            else { const int u = i * G + bx; if (u >= 1024) break; bk = u >> 5; w = u & 31; }
            const int b = bk >> 1, kvh = bk & 1, hq = kvh * 4 + (w >> 3), qb = w & 7;
            const size_t qoff = ((size_t)b * T + (size_t)qb * 256) * 1024 + hq * 128;
            const size_t koff = (size_t)b * TA * 256 + kvh * 128;
            att::attn_unit(Qp + qoff, Kp + koff, Vp + koff, (att::bf16*)(ws + WS_Q) + qoff, TA, (char*)lds, rope + (size_t)qb * 256 * 128, a.in[8], mk_wid);
        }
        if (full) p_weights(a, lds, mk_wid, WI_PROJ, WI_ALL, 128, false);
    }
    SEAM(4);
    if (IN(5)) {
        pg8::StaticOrder S; S.init(MLAT, DM, G, bx, 2);
        { pg8::Gemm g{(const pg8::bf16_t*)(ws + WS_Q), (const pg8::bf16_t*)(ws + WS_WAP), MLAT, DM, DM};
          EpiMerge<0> E{(const u16*)a.out, (u16*)(ws + WS_T1), (u16*)(ws + WS_MRG)};
          pg8::gemm_phase<EpiMerge<0>, pg8::StaticOrder, true, true>(lds3, g, S, E, mk_wid); }
        p_glapost(a, mk_wid);
    }
    SEAM(5);
    if (IN(6)) {
        pg8::StaticOrder S; S.init(MLAT, DM, G, bx, 2);
        pg8::Gemm g{(const pg8::bf16_t*)(ws + WS_GG), (const pg8::bf16_t*)(ws + WS_WGP), MLAT, DM, DM};
        EpiMerge<1> E{(const u16*)a.out, (u16*)(ws + WS_T1), (u16*)(ws + WS_MRG)};
        pg8::gemm_phase<EpiMerge<1>, pg8::StaticOrder, true, true>(lds3, g, S, E, mk_wid);
    }
    SEAM(6);
    if (IN(7)) {
        pg8::Gemm g{(const pg8::bf16_t*)(ws + WS_MRG), (const pg8::bf16_t*)(ws + WS_WOUT), MLAT, DM, DM}; pg8::StaticOrder S; S.init(MLAT, DM, G, bx, 2);
        EpiGateResB<false> E{(const void*)a.in[0], (void*)(ws + WS_X1), (const float*)(ws + WS_MOD) + 2 * 1024};
        pg8::gemm_phase<EpiGateResB<false>, pg8::StaticOrder, true, true>(lds3, g, S, E, mk_wid);
    }
    SEAM(7);
    if (IN(8)) p_h2(a, mk_wid);
    SEAM(8);
    if (IN(9)) {
        pg8::Gemm g{(const pg8::bf16_t*)(ws + WS_H2), (const pg8::bf16_t*)(ws + WS_WFI), MLAT, 2 * DFF, DM}; pg8::StaticOrder S; S.init(MLAT, 2 * DFF, G, bx);
        EpiSwiglu E{(u16*)(ws + WS_ACT)};
        pg8::gemm_phase<EpiSwiglu, pg8::StaticOrder, true, true>(lds3, g, S, E, mk_wid);
    }
    SEAM(9);
    if (IN(10)) {
        pg8::Gemm g{(const pg8::bf16_t*)(ws + WS_ACT), (const pg8::bf16_t*)(ws + WS_WFO), MLAT, DM, DFF}; pg8::StaticOrder S; S.init(MLAT, DM, G, bx, 2);
        EpiGateResB<true> E{(const void*)(ws + WS_X1), (void*)a.out, (const float*)(ws + WS_MOD) + 5 * 1024};
        pg8::gemm_phase<EpiGateResB<true>, pg8::StaticOrder, true, true>(lds3, g, S, E, mk_wid);
    }
#undef IN
#undef SEAM
}

extern "C" void kernel_launch(void* const* d_in, const int* in_sizes, int n_in, void* d_out, int out_size, void* d_ws, size_t ws_size, hipStream_t stream) {
    static int grid = 0;
    if (grid == 0) {
        if (n_in != 21 || in_sizes[0] != MLAT * DM || out_size != MLAT * DM || ws_size < WS_END) {
            fprintf(stderr, "kernel_launch: unexpected shapes: n_in %d in0 %d out %d ws %zu (need >= %zu)\n", n_in, n_in > 0 ? in_sizes[0] : -1, out_size, ws_size, (size_t)WS_END); grid = -1; return; }
        int dev = 0, cus = 0, per_cu = 0;
        if (hipGetDevice(&dev) != hipSuccess || hipDeviceGetAttribute(&cus, hipDeviceAttributeMultiprocessorCount, dev) != hipSuccess) { grid = -1; return; }
        if (hipFuncSetAttribute((const void*)mk_fwd, hipFuncAttributeMaxDynamicSharedMemorySize, LDS_BYTES) != hipSuccess) { fprintf(stderr, "kernel_launch: hipFuncSetAttribute failed\n"); grid = -1; return; }
        if (hipOccupancyMaxActiveBlocksPerMultiprocessor(&per_cu, (const void*)mk_fwd, 512, LDS_BYTES) != hipSuccess || per_cu < 1) { fprintf(stderr, "kernel_launch: occupancy query says %d blocks per CU\n", per_cu); grid = -1; return; }
        grid = cus;
    }
    if (grid < 0) return;
    Args a{};
    for (int i = 0; i < 21; ++i) a.in[i] = (const float*)d_in[i];
    a.out = (float*)d_out; a.ws = (unsigned char*)d_ws;
#if MK_PER_PHASE
    for (int ph = 0; ph < NPH; ++ph) { a.ph_lo = ph; a.ph_hi = ph + 1; hipLaunchKernelGGL(mk_fwd, dim3(grid), dim3(512), LDS_BYTES, stream, a); }
#else
    a.ph_lo = 0; a.ph_hi = NPH;
    void* args[] = {&a};
    const hipError_t e = hipLaunchCooperativeKernel((const void*)mk_fwd, dim3(grid), dim3(512), args, LDS_BYTES, stream);
    if (e != hipSuccess) fprintf(stderr, "kernel_launch: cooperative launch failed: %s (grid %d)\n", hipGetErrorString(e), grid);
#endif
}
```

```cpp
#include <hip/hip_runtime.h>
#include <hip/hip_bf16.h>
#include <hip/hip_cooperative_groups.h>
#include <cstdio>
#include <cstdint>
namespace cg = cooperative_groups;
__device__ __forceinline__ int mk_lane_() { int l; asm volatile("v_mbcnt_lo_u32_b32 %0, -1, 0\n\tv_mbcnt_hi_u32_b32 %0, -1, %0" : "=v"(l)); return l; }
#define MK_LANE() mk_lane_()
#define MK_TID (mk_wid * 64 + MK_LANE())
namespace pg8 {
#define PG8_LAS __attribute__((address_space(3)))
typedef unsigned short bf16_t;
typedef short bf16x8 __attribute__((ext_vector_type(8)));
typedef float f32x4 __attribute__((ext_vector_type(4)));
typedef unsigned u32x4 __attribute__((ext_vector_type(4)));
constexpr int BM = 256, BK = 64, HALF = 128, HTB = HALF * BK * 2  , STAGE_BYTES = 8 * HTB, NXCD = 8, WGM = 4  ;

__host__ __device__ __forceinline__ int lds_byte(int r, int c) { const int st = (r >> 4) * 2 + (c >> 5), rr = r & 15, cc = c & 31, ob = rr * 64 + cc * 2; return st * 1024 + (ob ^ (((ob >> 9) & 1) << 5)); }
__host__ __device__ __forceinline__ void stage_rc(int b, int& R, int& C) { const int st = b / 1024, sb = b % 1024, swz = sb ^ (((sb >> 9) & 1) << 5); R = (st >> 1) * 16 + swz / 64; C = (st & 1) * 32 + (swz % 64) / 2; }
__host__ __device__ __forceinline__ int perm32(int rho) { const int n = rho >> 4, i = rho & 15; return 8 * (i >> 2) + 4 * n + (i & 3); }

struct Unit { int pm, pn; };
struct Gemm { const bf16_t* A; const bf16_t* Bt; int M, N, K; };

struct StaticOrder {
    int nM, nN, nwg, G, c, wgm;
    __host__ __device__ void init(int M, int N, int G_, int c_, int wgm_ = WGM) { nM = M / BM; nN = N / BM; nwg = nM * nN; G = G_; c = c_; wgm = wgm_; }
    __host__ __device__ bool next(int i, Unit& u) const {
        const long L = (long)i * G + c; if (L >= nwg) return false;
        int wgid = (int)L; { const int q = nwg / NXCD, r = nwg % NXCD, xcd = wgid % NXCD, off = wgid / NXCD; wgid = (xcd < r ? xcd * (q + 1) : r * (q + 1) + (xcd - r) * q) + off; }
        const int nig = wgm * nN, gid = wgid / nig, fm = gid * wgm, gsz = (nM - fm) < wgm ? (nM - fm) : wgm;
        u.pm = fm + ((wgid % nig) % gsz); u.pn = (wgid % nig) / gsz; return true;
    }
    __device__ __forceinline__ void a_ready(const Unit&) const {}
    __device__ __forceinline__ void done(const Unit&) const {}
};

__device__ __forceinline__ unsigned cvt_pk_bf16(float lo, float hi) { unsigned r; asm volatile("v_cvt_pk_bf16_f32 %0, %1, %2" : "=v"(r) : "v"(lo), "v"(hi)); return r; }
typedef float f32x2 __attribute__((ext_vector_type(2)));
template <class Epi, class Sched, bool ALIGN_EPI = false, bool SP2 = false>
__device__ __forceinline__ void gemm_phase(PG8_LAS unsigned char* lds, const Gemm g, const Sched& S, const Epi& E, const int mk_wid) {
    const int tid = MK_TID, wid = mk_wid, lane = tid & 63, wr = wid >> 2, wc = wid & 3, fr = lane & 15, fq = lane >> 4;
    const int K = g.K, nt = K / BK;
    unsigned voffA[2], voffB[2];
#pragma unroll
    for (int i = 0; i < 2; ++i) { int R, C; stage_rc(tid * 16 + i * 8192, R, C); const int Rb = Epi::PERM ? ((R & ~31) + perm32(R & 31)) : R;
        voffA[i] = (unsigned)(R * K + C) * 2u; voffB[i] = (unsigned)(Rb * K + C) * 2u; }
    const size_t kstep = (size_t)(BK * 2);
    const size_t hstep = (size_t)HALF * K * 2;
    const size_t tstep = 2 * hstep;
    const unsigned ldsw = (unsigned)wid * 1024u;
    const int aoff = lds_byte(wr * 64 + fr, fq * 8), boff = lds_byte(wc * 32 + fr, fq * 8);
#define PG8_SA(b, h) (((b) * 2 + (h)) * HTB)
#define PG8_SB(b, h) ((4 + (b) * 2 + (h)) * HTB)
#define PG8_STAGE(bufoff, gbase, voff) do { _Pragma("unroll") for (int _i = 0; _i < 2; ++_i) \
        __builtin_amdgcn_global_load_lds((const unsigned*)((const char*)(gbase) + (voff)[_i]), (PG8_LAS unsigned*)(lds + (bufoff) + ldsw + _i * 8192), 16, 0, 0); } while (0)
#define PG8_LDA(dst, b, h) do { _Pragma("unroll") for (int m = 0; m < 4; ++m) _Pragma("unroll") for (int k = 0; k < 2; ++k) dst[m][k] = *(const PG8_LAS bf16x8*)(lds + PG8_SA(b, h) + aoff + m * 2048 + k * 1024); } while (0)
#define PG8_LDB(dst, b, h) do { _Pragma("unroll") for (int n = 0; n < 2; ++n) _Pragma("unroll") for (int k = 0; k < 2; ++k) dst[n][k] = *(const PG8_LAS bf16x8*)(lds + PG8_SB(b, h) + boff + n * 2048 + k * 1024); } while (0)
#define PG8_MMA(ai, bj, At, Bt) do { __builtin_amdgcn_s_setprio(1); _Pragma("unroll") for (int m = 0; m < 4; ++m) _Pragma("unroll") for (int n = 0; n < 2; ++n) _Pragma("unroll") for (int k = 0; k < 2; ++k) \
        acc[ai][bj][m][n] = __builtin_amdgcn_mfma_f32_16x16x32_bf16(Bt[n][k], At[m][k], acc[ai][bj][m][n], 0, 0, 0); __builtin_amdgcn_s_setprio(0); } while (0)
#define PG8_WAIT_V(n) asm volatile("s_waitcnt vmcnt(" #n ")" ::: "memory")
#define PG8_WAIT_L(n) asm volatile("s_waitcnt lgkmcnt(" #n ")" ::: "memory")
#define PG8_BAR __builtin_amdgcn_s_barrier()
#define PG8_SCHED __builtin_amdgcn_sched_barrier(0)
    Unit cur, nxt; int ui = 0;
    if (!S.next(0, cur)) return;
    f32x4 acc[2][2][4][2];
#pragma unroll
    for (int a = 0; a < 2; ++a)
#pragma unroll
        for (int b = 0; b < 2; ++b)
#pragma unroll
            for (int m = 0; m < 4; ++m)
#pragma unroll
                for (int n = 0; n < 2; ++n) acc[a][b][m][n] = (f32x4){0.f, 0.f, 0.f, 0.f};
    bf16x8 At[4][2], B0[2][2], B1[2][2];
    const char* cA = (const char*)g.A + (size_t)cur.pm * tstep; const char* cB = (const char*)g.Bt + (size_t)cur.pn * tstep;
    S.a_ready(cur);
    if constexpr (SP2) {
        PG8_STAGE(PG8_SB(0, 0), cB, voffB); PG8_STAGE(PG8_SB(0, 1), cB + hstep, voffB); PG8_STAGE(PG8_SA(0, 0), cA, voffA); PG8_STAGE(PG8_SA(0, 1), cA + hstep, voffA);
        if (wr == 1) PG8_BAR;
        PG8_WAIT_V(2); PG8_BAR;
        PG8_STAGE(PG8_SB(1, 0), cB + kstep, voffB); PG8_STAGE(PG8_SA(1, 0), cA + kstep, voffA); PG8_STAGE(PG8_SB(1, 1), cB + hstep + kstep, voffB);
        PG8_WAIT_V(6); PG8_BAR;
    } else {
        PG8_STAGE(PG8_SB(0, 0), cB, voffB); PG8_STAGE(PG8_SA(0, 0), cA, voffA); PG8_STAGE(PG8_SB(0, 1), cB + hstep, voffB); PG8_STAGE(PG8_SA(0, 1), cA + hstep, voffA);
        if (wr == 1) PG8_BAR;
        PG8_WAIT_V(4); PG8_BAR;
        PG8_STAGE(PG8_SB(1, 0), cB + kstep, voffB); PG8_STAGE(PG8_SA(1, 0), cA + kstep, voffA); PG8_STAGE(PG8_SB(1, 1), cB + hstep + kstep, voffB);
        PG8_WAIT_V(6); PG8_BAR;
    }
    for (;;) {
        const bool has_next = S.next(ui + 1, nxt);
        const char* nA = has_next ? (const char*)g.A + (size_t)nxt.pm * tstep : cA; const char* nB = has_next ? (const char*)g.Bt + (size_t)nxt.pn * tstep : cB;
        for (int t = 0; t < nt; t += 2) {
            const bool last = (t == nt - 2);
            const char* a1 = cA + (size_t)(t + 1) * kstep;
            const char* a2 = last ? nA : cA + (size_t)(t + 2) * kstep; const char* b2 = last ? nB : cB + (size_t)(t + 2) * kstep;
            const char* a3 = a2 + kstep; const char* b3 = b2 + kstep;
            if (last && has_next) S.a_ready(nxt);
            if constexpr (SP2) {
            PG8_LDB(B0, 0, 0); PG8_LDB(B1, 0, 1); PG8_SCHED; PG8_LDA(At, 0, 0); PG8_STAGE(PG8_SA(1, 1), a1 + hstep, voffA);
            PG8_WAIT_V(8); PG8_WAIT_L(0); PG8_BAR; PG8_MMA(0, 0, At, B0); PG8_MMA(0, 1, At, B1); PG8_BAR; PG8_SCHED;
            PG8_LDA(At, 0, 1); PG8_STAGE(PG8_SB(0, 0), b2, voffB); PG8_STAGE(PG8_SB(0, 1), b2 + hstep, voffB); PG8_STAGE(PG8_SA(0, 0), a2, voffA);
            PG8_WAIT_V(8); PG8_WAIT_L(0); PG8_BAR; PG8_MMA(1, 0, At, B0); PG8_MMA(1, 1, At, B1); PG8_BAR; PG8_SCHED;
            PG8_LDB(B0, 1, 0); PG8_LDB(B1, 1, 1); PG8_SCHED; PG8_LDA(At, 1, 0); PG8_STAGE(PG8_SA(0, 1), a2 + hstep, voffA);
            PG8_WAIT_V(8); PG8_WAIT_L(0); PG8_BAR; PG8_MMA(0, 0, At, B0); PG8_MMA(0, 1, At, B1); PG8_BAR; PG8_SCHED;
            PG8_LDA(At, 1, 1); PG8_STAGE(PG8_SB(1, 0), b3, voffB); PG8_STAGE(PG8_SB(1, 1), b3 + hstep, voffB); PG8_STAGE(PG8_SA(1, 0), a3, voffA);
            PG8_WAIT_V(8); PG8_WAIT_L(0); PG8_BAR; PG8_MMA(1, 0, At, B0); PG8_MMA(1, 1, At, B1); PG8_BAR; PG8_SCHED;
            } else {
            PG8_LDB(B0, 0, 0); PG8_SCHED; PG8_LDA(At, 0, 0); PG8_STAGE(PG8_SA(1, 1), a1 + hstep, voffA);
            PG8_WAIT_L(8); PG8_BAR; PG8_WAIT_L(0); PG8_MMA(0, 0, At, B0); PG8_BAR; PG8_SCHED;
            PG8_LDB(B1, 0, 1); PG8_STAGE(PG8_SB(0, 0), b2, voffB);
            PG8_BAR; PG8_WAIT_L(0); PG8_MMA(0, 1, At, B1); PG8_BAR;
            PG8_LDA(At, 0, 1); PG8_STAGE(PG8_SA(0, 0), a2, voffA);
            PG8_BAR; PG8_WAIT_L(0); PG8_MMA(1, 0, At, B0); PG8_BAR; PG8_SCHED;
            PG8_STAGE(PG8_SB(0, 1), b2 + hstep, voffB);
            PG8_WAIT_V(6); PG8_BAR; PG8_MMA(1, 1, At, B1); PG8_BAR;
            PG8_LDB(B0, 1, 0); PG8_SCHED; PG8_LDA(At, 1, 0); PG8_STAGE(PG8_SA(0, 1), a2 + hstep, voffA);
            PG8_WAIT_L(8); PG8_BAR; PG8_WAIT_L(0); PG8_MMA(0, 0, At, B0); PG8_BAR; PG8_SCHED;
            PG8_LDB(B1, 1, 1); PG8_STAGE(PG8_SB(1, 0), b3, voffB);
            PG8_BAR; PG8_WAIT_L(0); PG8_MMA(0, 1, At, B1); PG8_BAR;
            PG8_LDA(At, 1, 1); PG8_STAGE(PG8_SA(1, 0), a3, voffA);
            PG8_BAR; PG8_WAIT_L(0); PG8_MMA(1, 0, At, B0); PG8_BAR; PG8_SCHED;
            PG8_STAGE(PG8_SB(1, 1), b3 + hstep, voffB);
            PG8_WAIT_V(6); PG8_BAR; PG8_MMA(1, 1, At, B1); PG8_BAR;
            }
        }
        if constexpr (ALIGN_EPI) { if (wr == 0) PG8_BAR; }
        if constexpr (!Epi::AFTER_DRAIN) { E(acc, cur, wr, wc, fr, fq); S.done(cur); }
        if (!has_next) break;
#pragma unroll
        for (int a = 0; a < 2; ++a)
#pragma unroll
            for (int b = 0; b < 2; ++b)
#pragma unroll
                for (int m = 0; m < 4; ++m)
#pragma unroll
                    for (int n = 0; n < 2; ++n) acc[a][b][m][n] = (f32x4){0.f, 0.f, 0.f, 0.f};
        cur = nxt; cA = nA; cB = nB; ++ui;
        if constexpr (ALIGN_EPI) { if (wr == 1) PG8_BAR; }
    }
    PG8_WAIT_V(0);
    if constexpr (!ALIGN_EPI) { if (wr == 0) PG8_BAR; }
    PG8_BAR;
    if constexpr (Epi::AFTER_DRAIN) { E.fused(acc, cur, wr, wc, fr, fq, lds, wid, lane); S.done(cur); }
#undef PG8_SA
#undef PG8_SB
#undef PG8_STAGE
#undef PG8_LDA
#undef PG8_LDB
#undef PG8_MMA
#undef PG8_WAIT_V
#undef PG8_WAIT_L
#undef PG8_BAR
#undef PG8_SCHED
}
}
namespace att {
using bf16 = __hip_bfloat16;
constexpr int   D = 128, NW = 8, QBLK = 32, KVBLK = 64;
constexpr float SCALE = 0.088388347648318440f;
constexpr float THR = 8.f;
constexpr int LDQ = 1024, LDK = 256, LDO = 1024;
constexpr size_t SHM_V = KVBLK * D * 2, SHM_K = KVBLK * D * 2, SHM_ATTN = 2 * SHM_V + 2 * SHM_K + NW * 64 * 4;
using bf16x8 = __attribute__((ext_vector_type(8))) short;
using s16x4  = __attribute__((ext_vector_type(4))) short;
using f32x16 = __attribute__((ext_vector_type(16))) float;
using f32x8  = __attribute__((ext_vector_type(8))) float;
using u32x4  = __attribute__((ext_vector_type(4))) unsigned;
#define KSWZ(row, colB) ((row) * 256 + ((colB) ^ (((row) & 7) << 4)))
#define SBAR() __builtin_amdgcn_sched_barrier(0)
__device__ __forceinline__ int crow(int r, int hi) { return (r & 3) + 8 * (r >> 2) + 4 * hi; }
__device__ __forceinline__ unsigned cvtpk(float lo, float hi) {
  unsigned r; asm volatile("v_cvt_pk_bf16_f32 %0, %1, %2" : "=v"(r) : "v"(lo), "v"(hi)); return r;
}
template <typename TIn> struct Stage;
template <> struct Stage<bf16>  { using T = bf16x8;
  __device__ static __forceinline__ T ld8(const bf16* p) { return *reinterpret_cast<const bf16x8*>(p); }
  __device__ static __forceinline__ bf16x8 tobf(T x) { return x; } };
template <> struct Stage<float> { using T = f32x8;
  __device__ static __forceinline__ T ld8(const float* p) { return *reinterpret_cast<const f32x8*>(p); }
  __device__ static __forceinline__ bf16x8 tobf(T x) {
    u32x4 w = {cvtpk(x[0], x[1]), cvtpk(x[2], x[3]), cvtpk(x[4], x[5]), cvtpk(x[6], x[7])}; return *reinterpret_cast<bf16x8*>(&w); } };

__device__ __forceinline__ void partialSM(f32x16& p0, f32x16& p1, float& m_reg, float& mn, float& alpha) {
  constexpr float C = SCALE * 1.4426950408889634f;
  float pmax = p0[0]; for (int r = 1; r < 16; ++r) pmax = fmaxf(pmax, p0[r]); for (int r = 0; r < 16; ++r) pmax = fmaxf(pmax, p1[r]);
  { auto rr = __builtin_amdgcn_permlane32_swap(__float_as_uint(pmax), __float_as_uint(pmax), false, false);
    pmax = fmaxf(__uint_as_float(rr[0]), __uint_as_float(rr[1])); }
  if (__builtin_expect(__all(pmax - m_reg <= THR / SCALE), 1)) { mn = m_reg; alpha = 1.f; }
  else { mn = fmaxf(m_reg, pmax); alpha = __builtin_amdgcn_exp2f((m_reg - mn) * C); m_reg = mn; }
  float mnC = -mn * C;
  for (int r = 0; r < 16; ++r) p0[r] = fmaf(p0[r], C, mnC); for (int r = 0; r < 16; ++r) p1[r] = fmaf(p1[r], C, mnC);
  for (int r = 0; r < 16; ++r) p0[r] = __builtin_amdgcn_exp2f(p0[r]);
}
__device__ __forceinline__ void finishSM(f32x16& p0, f32x16& p1, float alpha, float& l_reg, bf16x8& pa0, bf16x8& pa1, bf16x8& pa2, bf16x8& pa3) {
  for (int r = 0; r < 16; ++r) p1[r] = __builtin_amdgcn_exp2f(p1[r]);
  float ps = 0; for (int r = 0; r < 16; ++r) ps += p0[r]; for (int r = 0; r < 16; ++r) ps += p1[r];
  { auto rr = __builtin_amdgcn_permlane32_swap(__float_as_uint(ps), __float_as_uint(ps), false, false);
    ps = __uint_as_float(rr[0]) + __uint_as_float(rr[1]); }
  l_reg = l_reg * alpha + ps;
#define PK4(P, BASE, OUT) do { unsigned a0 = cvtpk(P[BASE + 0], P[BASE + 1]), a1 = cvtpk(P[BASE + 2], P[BASE + 3]);   \
    unsigned b0 = cvtpk(P[BASE + 4], P[BASE + 5]), b1 = cvtpk(P[BASE + 6], P[BASE + 7]);                              \
    auto r0 = __builtin_amdgcn_permlane32_swap(a0, b0, false, false); auto r1 = __builtin_amdgcn_permlane32_swap(a1, b1, false, false); \
    u32x4 w = {r0[0], r1[0], r0[1], r1[1]}; OUT = *reinterpret_cast<bf16x8*>(&w); } while (0)
  PK4(p0, 0, pa0); PK4(p0, 8, pa1); PK4(p1, 0, pa2); PK4(p1, 8, pa3);
#undef PK4
}
__device__ __forceinline__ void qkt(f32x16& p0, f32x16& p1, const bf16* Ks, const bf16x8* qr, int r32, int hi) {
  p0 = f32x16{}; p1 = f32x16{};
  for (int d0 = 0; d0 < 8; ++d0) { int cb = (d0 * 16 + hi * 8) * 2;
    bf16x8 b0 = *reinterpret_cast<const bf16x8*>((const char*)Ks + KSWZ(r32, cb));
    bf16x8 b1 = *reinterpret_cast<const bf16x8*>((const char*)Ks + KSWZ(32 + r32, cb));
    p0 = __builtin_amdgcn_mfma_f32_32x32x16_bf16(b0, qr[d0], p0, 0, 0, 0);
    p1 = __builtin_amdgcn_mfma_f32_32x32x16_bf16(b1, qr[d0], p1, 0, 0, 0); }
}
__device__ __forceinline__ int v_st(int k, int c) { const int kk = (k & ~0xC) | ((k & 4) << 1) | ((k & 8) >> 1); return ((kk >> 3) * 4 + (c >> 5)) * 512 + ((kk & 7) * 32 + (c & 31)) * 2; }
__device__ __forceinline__ int v_rd_base(int lane) { return ((lane & 3) << 3) | (((lane >> 2) & 3) << 6) | (((lane >> 4) & 1) << 5) | (((lane >> 5) & 1) << 8); }
constexpr int v_rd_off(int d0, int ks, int half) { return d0 * 512 + ks * 4096 + half * 2048; }
template <int OFF> __device__ __forceinline__ s16x4 tr_read(int vb) {
  s16x4 r; asm volatile("ds_read_b64_tr_b16 %0, %1 offset:%2" : "=&v"(r) : "v"(vb), "i"(OFF) : "memory"); return r;
}
template <int D0> __device__ __forceinline__ void pv_one(f32x16& od, int vb, bf16x8 pa0, bf16x8 pa1, bf16x8 pa2, bf16x8 pa3) {
  const s16x4 l0 = tr_read<v_rd_off(D0, 0, 0)>(vb), h0 = tr_read<v_rd_off(D0, 0, 1)>(vb), l1 = tr_read<v_rd_off(D0, 1, 0)>(vb), h1 = tr_read<v_rd_off(D0, 1, 1)>(vb);
  const s16x4 l2 = tr_read<v_rd_off(D0, 2, 0)>(vb), h2 = tr_read<v_rd_off(D0, 2, 1)>(vb), l3 = tr_read<v_rd_off(D0, 3, 0)>(vb), h3 = tr_read<v_rd_off(D0, 3, 1)>(vb);
  asm volatile("s_waitcnt lgkmcnt(0)" ::: "memory"); SBAR();
#define PK(L, H) (bf16x8){L[0], L[1], L[2], L[3], H[0], H[1], H[2], H[3]}
  od = __builtin_amdgcn_mfma_f32_32x32x16_bf16(pa0, PK(l0, h0), od, 0, 0, 0);
  od = __builtin_amdgcn_mfma_f32_32x32x16_bf16(pa1, PK(l1, h1), od, 0, 0, 0);
  od = __builtin_amdgcn_mfma_f32_32x32x16_bf16(pa2, PK(l2, h2), od, 0, 0, 0);
  od = __builtin_amdgcn_mfma_f32_32x32x16_bf16(pa3, PK(l3, h3), od, 0, 0, 0);
#undef PK
}
__device__ __forceinline__ void pv_d0(f32x16* o, int vb, bf16x8 pa0, bf16x8 pa1, bf16x8 pa2, bf16x8 pa3) {
  pv_one<0>(o[0], vb, pa0, pa1, pa2, pa3); pv_one<1>(o[1], vb, pa0, pa1, pa2, pa3); pv_one<2>(o[2], vb, pa0, pa1, pa2, pa3); pv_one<3>(o[3], vb, pa0, pa1, pa2, pa3);
}
__device__ __forceinline__ float bf2f(short s) { return __uint_as_float(((unsigned)(unsigned short)s) << 16); }
__device__ __forceinline__ void attn_unit(const bf16* Qb, const bf16* __restrict__ Kh, const bf16* __restrict__ Vh, bf16* Ob, int seq, char* lds,
                                          const float* __restrict__ rope, const float* __restrict__ qg, const int mk_wid) {
  using St = Stage<bf16>;
  int tid = MK_TID; asm volatile("" : "+v"(tid));
  const int wid = mk_wid, lane = tid & 63, r32 = lane & 31, hi = lane >> 5;
  bf16* V_lds = (bf16*)lds; bf16* K_lds = (bf16*)(lds + 2 * SHM_V);
  float* ws = (float*)(lds + 2 * SHM_V + 2 * SHM_K) + wid * 64; float* li_l = ws; float* al_l = ws + 32;
  float m_reg = -1e30f, l_reg = 0; f32x16 o[4] = {}; bf16x8 qr[8];
  const int sr = tid >> 4, sc = (tid & 15) * 8, vst0 = v_st(sr, sc), vst1 = v_st(32 + sr, sc);
  const int vb0 = (int)(uintptr_t)V_lds + v_rd_base(lane);
  struct { typename St::T vs0, vs1, ks0, ks1; } sr_[2];
#define SLOAD(i, k0) do { sr_[i].vs0 = St::ld8(&Vh[(long)((k0) + sr) * LDK + sc]); sr_[i].vs1 = St::ld8(&Vh[(long)((k0) + 32 + sr) * LDK + sc]); \
    sr_[i].ks0 = St::ld8(&Kh[(long)((k0) + sr) * LDK + sc]); sr_[i].ks1 = St::ld8(&Kh[(long)((k0) + 32 + sr) * LDK + sc]); } while (0)
#define SWRITE(b, i) do { *(bf16x8*)((char*)V_lds + (b) * SHM_V + vst0) = St::tobf(sr_[i].vs0);          \
    *(bf16x8*)((char*)V_lds + (b) * SHM_V + vst1) = St::tobf(sr_[i].vs1); int kc = sc * 2;               \
    *(bf16x8*)((char*)K_lds + (b) * SHM_K + KSWZ(sr, kc)) = St::tobf(sr_[i].ks0);                       \
    *(bf16x8*)((char*)K_lds + (b) * SHM_K + KSWZ(32 + sr, kc)) = St::tobf(sr_[i].ks1); } while (0)
#define SWAIT() do { asm volatile("s_waitcnt vmcnt(4)" ::: "memory"); } while (0)
#define RESC(a) do { if (__any((a) < 1.f)) { if (hi == 0) al_l[r32] = (a); asm volatile("s_waitcnt lgkmcnt(0)" ::: "memory"); \
    for (int d = 0; d < 4; ++d) for (int r = 0; r < 16; ++r) o[d][r] *= al_l[crow(r, hi)]; } } while (0)
  constexpr int SE = 0, SO = 1;
  {
    int tp = MK_TID; asm volatile("" : "+v"(tp)); const int r32 = tp & 31, hi = (tp >> 5) & 1;
    const bf16* Qw = Qb + (long)(wid * QBLK + r32) * LDQ + hi * 8;
    const float* rp = rope + ((long)(wid * QBLK + r32) * 64 + hi * 4) * 2;
    bf16x8 rw[8]; float4 gA[8], gB[8], cA[8], cB[8];
#pragma unroll
    for (int d0 = 0; d0 < 8; ++d0) { rw[d0] = *reinterpret_cast<const bf16x8*>(Qw + d0 * 16);
      gA[d0] = *reinterpret_cast<const float4*>(qg + d0 * 16 + hi * 8); gB[d0] = *reinterpret_cast<const float4*>(qg + d0 * 16 + hi * 8 + 4);
      cA[d0] = *reinterpret_cast<const float4*>(rp + d0 * 16); cB[d0] = *reinterpret_cast<const float4*>(rp + d0 * 16 + 4); }
    float ss = 0.f;
#pragma unroll
    for (int d0 = 0; d0 < 8; ++d0)
#pragma unroll
      for (int e = 0; e < 8; ++e) { const float f = bf2f(rw[d0][e]); ss += f * f; }
    { auto rr = __builtin_amdgcn_permlane32_swap(__float_as_uint(ss), __float_as_uint(ss), false, false); ss = __uint_as_float(rr[0]) + __uint_as_float(rr[1]); }
    const float rinv = rsqrtf(ss * (1.f / 128.f) + 1e-6f);
#pragma unroll
    for (int d0 = 0; d0 < 8; ++d0) {
      const float4 g0 = gA[d0], g1 = gB[d0], cs0 = cA[d0], cs1 = cB[d0];
      const float x0 = bf2f(rw[d0][0]) * rinv * g0.x, x1 = bf2f(rw[d0][1]) * rinv * g0.y, x2 = bf2f(rw[d0][2]) * rinv * g0.z, x3 = bf2f(rw[d0][3]) * rinv * g0.w;
      const float x4 = bf2f(rw[d0][4]) * rinv * g1.x, x5 = bf2f(rw[d0][5]) * rinv * g1.y, x6 = bf2f(rw[d0][6]) * rinv * g1.z, x7 = bf2f(rw[d0][7]) * rinv * g1.w;
      u32x4 w = {cvtpk(x0 * cs0.x - x1 * cs0.y, x0 * cs0.y + x1 * cs0.x), cvtpk(x2 * cs0.z - x3 * cs0.w, x2 * cs0.w + x3 * cs0.z),
                 cvtpk(x4 * cs1.x - x5 * cs1.y, x4 * cs1.y + x5 * cs1.x), cvtpk(x6 * cs1.z - x7 * cs1.w, x6 * cs1.w + x7 * cs1.z)};
      qr[d0] = *reinterpret_cast<bf16x8*>(&w);
    }
  }
  f32x16 pA0, pA1, pB0, pB1; float mnA, mnB, alA, alB; bf16x8 pa0, pa1, pa2, pa3; const int NT = seq / KVBLK;
  SLOAD(SE, 0); asm volatile("s_waitcnt vmcnt(0)" ::: "memory"); SWRITE(0, SE); __syncthreads();
  qkt(pA0, pA1, K_lds, qr, r32, hi); partialSM(pA0, pA1, m_reg, mnA, alA);
  SLOAD(SO, KVBLK); if (2 < NT) SLOAD(SE, 2 * KVBLK);
  SWAIT(); SWRITE(1, SO); __syncthreads();
  for (int j = 1; j + 1 < NT; j += 2) {
    SBAR(); qkt(pB0, pB1, (bf16*)((char*)K_lds + SHM_K), qr, r32, hi);
    finishSM(pA0, pA1, alA, l_reg, pa0, pa1, pa2, pa3); SBAR();
    SLOAD(SO, (j + 2) * KVBLK); SBAR();
    pv_d0(o, vb0, pa0, pa1, pa2, pa3); partialSM(pB0, pB1, m_reg, mnB, alB);
    __syncthreads(); SWAIT(); SWRITE(0, SE);
    RESC(alB); __syncthreads();
    SBAR(); qkt(pA0, pA1, K_lds, qr, r32, hi);
    finishSM(pB0, pB1, alB, l_reg, pa0, pa1, pa2, pa3); SBAR();
    if (j + 3 < NT) SLOAD(SE, (j + 3) * KVBLK); SBAR();
    pv_d0(o, vb0 + (int)SHM_V, pa0, pa1, pa2, pa3); partialSM(pA0, pA1, m_reg, mnA, alA);
    __syncthreads(); SWAIT(); SWRITE(1, SO);
    RESC(alA); __syncthreads();
  }
  SBAR(); qkt(pB0, pB1, (bf16*)((char*)K_lds + SHM_K), qr, r32, hi);
  finishSM(pA0, pA1, alA, l_reg, pa0, pa1, pa2, pa3); SBAR();
  pv_d0(o, vb0, pa0, pa1, pa2, pa3); partialSM(pB0, pB1, m_reg, mnB, alB);
  __syncthreads(); RESC(alB);
  finishSM(pB0, pB1, alB, l_reg, pa0, pa1, pa2, pa3); SBAR();
  pv_d0(o, vb0 + (int)SHM_V, pa0, pa1, pa2, pa3);
  if (hi == 0) li_l[r32] = l_reg; asm volatile("s_waitcnt lgkmcnt(0)" ::: "memory");
  float rli[16];
#pragma unroll
  for (int r = 0; r < 16; ++r) rli[r] = __builtin_amdgcn_rcpf(li_l[crow(r, hi)]);
  __syncthreads();
  { int te = MK_TID; asm volatile("" : "+v"(te)); const int lane = te & 63, r32 = lane & 31, hi = lane >> 5;
    unsigned short* stg = (unsigned short*)(lds + wid * 8192);
#pragma unroll
    for (int r = 0; r < 16; ++r) { const int orow = crow(r, hi);
#pragma unroll
      for (int d0 = 0; d0 < 4; ++d0) stg[orow * 128 + d0 * 32 + r32] = (unsigned short)(cvtpk(o[d0][r] * rli[r], 0.f) & 0xffffu); }
    asm volatile("s_waitcnt lgkmcnt(0)" ::: "memory");
    bf16* Ow = Ob + (long)(wid * QBLK) * LDO;
#pragma unroll
    for (int i = 0; i < 8; ++i) { const int row = i * 4 + (lane >> 4), ch = lane & 15; const u32x4 v = *(const u32x4*)(stg + row * 128 + ch * 8); *(u32x4*)(Ow + (long)row * LDO + ch * 8) = v; } }
  __syncthreads();
#undef SLOAD
#undef SWRITE
#undef SWAIT
#undef RESC
}
}
constexpr int NB = 16, T = 2048, TC = 256, TA = T + TC, DM = 1024;
constexpr int MLAT = NB * T, MALL = NB * TA;
constexpr int NIN = 6912;
constexpr int DFF = 2816;
constexpr float EPS = 1e-6f;
constexpr size_t MiB = 1u << 20;
constexpr size_t WS_MOD = 1 * MiB, WS_ROPE = 2 * MiB, WS_WIN = 4 * MiB, WS_WAP = 18 * MiB, WS_WGP = 20 * MiB, WS_WOUT = 22 * MiB, WS_WFI = 24 * MiB, WS_WFO = 36 * MiB,
                 WS_H1 = 42 * MiB, WS_Q = 114 * MiB, WS_K = 178 * MiB, WS_V = 196 * MiB, WS_GQ = 214 * MiB, WS_GK = 250 * MiB, WS_GV = 286 * MiB, WS_GG = 358 * MiB,
                 WS_LR = 422 * MiB, WS_OB = 426 * MiB, WS_END = 490 * MiB;
constexpr size_t WS_OF = WS_H1, WS_T1 = WS_GQ  , WS_H2 = WS_H1, WS_MRG = WS_GV, WS_ACT = WS_Q, WS_X1 = WS_OB  ;
constexpr int LDS_BYTES = 147456;
constexpr int NPH = 11;
constexpr int WI_IN = 16 * 216, WI_PROJ = WI_IN + 3 * 16 * 32, WI_ALL = WI_PROJ + 16 * 176 + 44 * 32;

typedef unsigned short u16;
typedef unsigned v4u __attribute__((ext_vector_type(4)));
typedef unsigned v2u __attribute__((ext_vector_type(2)));
typedef float f32x4 __attribute__((ext_vector_type(4)));
#define LAS __attribute__((address_space(3)))

struct Args { const float* in[21]; float* out; unsigned char* ws; int ph_lo, ph_hi; };

__device__ __forceinline__ float bf2f(u16 u) { return __uint_as_float((unsigned)u << 16); }
typedef float f32x2_t __attribute__((ext_vector_type(2))); typedef __bf16 bf16x2_t __attribute__((ext_vector_type(2)));
__device__ __forceinline__ unsigned pk2(float lo, float hi) { f32x2_t v = {lo, hi}; bf16x2_t b = __builtin_convertvector(v, bf16x2_t); return __builtin_bit_cast(unsigned, b); }
__device__ __forceinline__ u16 f2bf(float f) { return (u16)(pk2(f, 0.f) & 0xffffu); }
__device__ __forceinline__ float wave_sum(float v) {
#pragma unroll
    for (int o = 1; o < 64; o <<= 1) v += __shfl_xor(v, o);
    return v;
}
__device__ __forceinline__ float sigmoidf_(float x) { return 1.f / (1.f + __expf(-x)); }

struct EpiInProj {
    static constexpr bool PERM = true, AFTER_DRAIN = false;
    unsigned char* ws; u16* MG;
    __device__ __forceinline__ void operator()(const pg8::f32x4 (&acc)[2][2][4][2], const pg8::Unit& u, int wr, int wc, int fr, int fq) const {
        const int b = u.pm / 9, j = u.pm % 9, pn = u.pn; const bool isctx = (j == 0);
        const long rall = (long)u.pm * 256, rlat = (long)b * T + (j - 1) * 256;
        u16* base; int ld, colt; long row0;
        if (pn < 4)       { if (isctx) return; base = (u16*)(ws + WS_Q);  ld = 1024; colt = pn * 256;        row0 = rlat; }
        else if (pn == 4) {                    base = (u16*)(ws + WS_K);  ld = 256;  colt = 0;               row0 = rall; }
        else if (pn == 5) {                    base = (u16*)(ws + WS_V);  ld = 256;  colt = 0;               row0 = rall; }
        else if (pn < 8)  { if (isctx) return; base = (u16*)(ws + WS_GQ); ld = 512;  colt = (pn - 6) * 256;  row0 = rall; }
        else if (pn < 10) {                    base = (u16*)(ws + WS_GK); ld = 512;  colt = (pn - 8) * 256;  row0 = rall; }
        else if (pn < 14) {                    base = (u16*)(ws + WS_GV); ld = 1024; colt = (pn - 10) * 256; row0 = rall; }
        else if (pn < 18) { if (isctx) return; base = (u16*)(ws + WS_GG); ld = 1024; colt = (pn - 14) * 256; row0 = rlat; }
        else if (pn < 26) { if (isctx) return; base = MG;                 ld = 2048; colt = (pn - 18) * 256; row0 = rlat; }
        else              {                    base = (u16*)(ws + WS_LR); ld = 32;   colt = 0;               row0 = rall; }
        const bool lr = (pn == 26);
        if (lr && wc != 0) return;
        const int col0 = colt + wc * 32 + 8 * fq;
#pragma unroll
        for (int ai = 0; ai < 2; ++ai)
#pragma unroll
            for (int m = 0; m < 4; ++m) { u16* rowp = base + (size_t)(row0 + ai * 128 + wr * 64 + m * 16 + fr) * ld + col0;
#pragma unroll
                for (int bj = 0; bj < 2; ++bj) { if (lr && bj) continue;
                    const pg8::f32x4 v0 = acc[ai][bj][m][0], v1 = acc[ai][bj][m][1];
                    v4u w; w.x = pk2(v0[0], v0[1]); w.y = pk2(v0[2], v0[3]); w.z = pk2(v1[0], v1[1]); w.w = pk2(v1[2], v1[3]);
                    *(v4u*)(rowp + bj * 128) = w; } }
    }
};
struct InProjOrder {
    pg8::StaticOrder so; int G, c;
    __device__ void init(int G_, int c_) { so.init(128 * 256, 26 * 256, G_, c_, 8); G = G_; c = c_; }
    __device__ bool next(int i, pg8::Unit& u) const {
        if (so.next(i, u)) { u.pm = (u.pm >> 3) * 9 + 1 + (u.pm & 7); return true; }
        const long q = (long)i * G + c - 3328; if (q < 0 || q >= 128) return false;
        const int b = (int)(q >> 3), t = (int)(q & 7);
        u.pm = b * 9; u.pn = t == 0 ? 4 : (t == 1 ? 5 : (t < 4 ? 6 + t : 6 + t)); return true;
    }
    __device__ __forceinline__ void a_ready(const pg8::Unit&) const {}
    __device__ __forceinline__ void done(const pg8::Unit&) const {}
};
template <int MODE> struct EpiMerge {
    static constexpr bool PERM = true, AFTER_DRAIN = false;
    const u16* MG; u16* T1; u16* MRG;
    __device__ __forceinline__ void operator()(const pg8::f32x4 (&acc)[2][2][4][2], const pg8::Unit& u, int wr, int wc, int fr, int fq) const {
        const int col0 = u.pn * 256 + wc * 32 + 8 * fq;
#pragma unroll
        for (int ai = 0; ai < 2; ++ai) {
            v4u gwv[4][2], twv[4][2];
#pragma unroll
            for (int m = 0; m < 4; ++m) { const size_t row = (size_t)u.pm * 256 + ai * 128 + wr * 64 + m * 16 + fr;
#pragma unroll
                for (int bj = 0; bj < 2; ++bj) { const int col = col0 + bj * 128;
                    gwv[m][bj] = __builtin_nontemporal_load((const v4u*)(MG + row * 2048 + MODE * 1024 + col));
                    twv[m][bj] = (MODE == 1) ? __builtin_nontemporal_load((const v4u*)(T1 + row * 1024 + col)) : (v4u){0u, 0u, 0u, 0u}; } }
#pragma unroll
            for (int m = 0; m < 4; ++m) { const size_t row = (size_t)u.pm * 256 + ai * 128 + wr * 64 + m * 16 + fr;
#pragma unroll
                for (int bj = 0; bj < 2; ++bj) { const int col = col0 + bj * 128;
                    const pg8::f32x4 v0 = acc[ai][bj][m][0], v1 = acc[ai][bj][m][1];
                    const float r[8] = {v0[0], v0[1], v0[2], v0[3], v1[0], v1[1], v1[2], v1[3]};
                    const unsigned gws[4] = {gwv[m][bj].x, gwv[m][bj].y, gwv[m][bj].z, gwv[m][bj].w};
                    const unsigned tws[4] = {twv[m][bj].x, twv[m][bj].y, twv[m][bj].z, twv[m][bj].w};
                    unsigned ow[4];
#pragma unroll
                    for (int e = 0; e < 4; ++e) {
                        float a0 = sigmoidf_(bf2f((u16)(gws[e] & 0xffffu))) * r[2 * e], a1 = sigmoidf_(bf2f((u16)(gws[e] >> 16))) * r[2 * e + 1];
                        if (MODE == 1) { a0 += bf2f((u16)(tws[e] & 0xffffu)); a1 += bf2f((u16)(tws[e] >> 16)); }
                        ow[e] = pk2(a0, a1); }
                    v4u w = {ow[0], ow[1], ow[2], ow[3]};
                    *(v4u*)((MODE == 0 ? T1 : MRG) + row * 1024 + col) = w; } }
        }
    }
};
struct EpiGateRes {
    static constexpr bool PERM = true, AFTER_DRAIN = false;
    const float* base; float* out; const float* gate;
    __device__ __forceinline__ void operator()(const pg8::f32x4 (&acc)[2][2][4][2], const pg8::Unit& u, int wr, int wc, int fr, int fq) const {
        const int col0 = u.pn * 256 + wc * 32 + 8 * fq; const int b = (u.pm * 256) / T;
        pg8::f32x4 gv[2][2];
#pragma unroll
        for (int bj = 0; bj < 2; ++bj)
#pragma unroll
            for (int n = 0; n < 2; ++n) gv[bj][n] = *(const pg8::f32x4*)(gate + (size_t)b * 6144 + col0 + bj * 128 + n * 4);
#pragma unroll
        for (int ai = 0; ai < 2; ++ai)
#pragma unroll
            for (int m = 0; m < 4; ++m) { const size_t off = ((size_t)u.pm * 256 + ai * 128 + wr * 64 + m * 16 + fr) * DM + col0;
#pragma unroll
                for (int bj = 0; bj < 2; ++bj)
#pragma unroll
                    for (int n = 0; n < 2; ++n) { const pg8::f32x4 bs = *(const pg8::f32x4*)(base + off + bj * 128 + n * 4);
                        *(pg8::f32x4*)(out + off + bj * 128 + n * 4) = bs + gv[bj][n] * acc[ai][bj][m][n]; } }
    }
};
template <bool IN_BF16> struct EpiGateResB {
    static constexpr bool PERM = true, AFTER_DRAIN = false;
    const void* base; void* out; const float* gate;
    __device__ __forceinline__ void operator()(const pg8::f32x4 (&acc)[2][2][4][2], const pg8::Unit& u, int wr, int wc, int fr, int fq) const {
        const int col0 = u.pn * 256 + wc * 32 + 8 * fq; const int b = (u.pm * 256) / T;
        pg8::f32x4 gv[2][2];
#pragma unroll
        for (int bj = 0; bj < 2; ++bj)
#pragma unroll
            for (int n = 0; n < 2; ++n) gv[bj][n] = *(const pg8::f32x4*)(gate + (size_t)b * 6144 + col0 + bj * 128 + n * 4);
#pragma unroll
        for (int ai = 0; ai < 2; ++ai) {
            pg8::f32x4 bs[4][2][2]; v4u bw[4][2];
#pragma unroll
            for (int m = 0; m < 4; ++m) { const size_t off = ((size_t)u.pm * 256 + ai * 128 + wr * 64 + m * 16 + fr) * DM + col0;
#pragma unroll
                for (int bj = 0; bj < 2; ++bj) {
                    if (IN_BF16) bw[m][bj] = __builtin_nontemporal_load((const v4u*)((const u16*)base + off + bj * 128));
                    else { bs[m][bj][0] = __builtin_nontemporal_load((const pg8::f32x4*)((const float*)base + off + bj * 128)); bs[m][bj][1] = __builtin_nontemporal_load((const pg8::f32x4*)((const float*)base + off + bj * 128 + 4)); } } }
#pragma unroll
            for (int m = 0; m < 4; ++m) { const size_t off = ((size_t)u.pm * 256 + ai * 128 + wr * 64 + m * 16 + fr) * DM + col0;
#pragma unroll
                for (int bj = 0; bj < 2; ++bj) {
                    pg8::f32x4 b0, b1;
                    if (IN_BF16) { const v4u w = bw[m][bj];
                        b0 = (pg8::f32x4){bf2f((u16)(w.x & 0xffffu)), bf2f((u16)(w.x >> 16)), bf2f((u16)(w.y & 0xffffu)), bf2f((u16)(w.y >> 16))};
                        b1 = (pg8::f32x4){bf2f((u16)(w.z & 0xffffu)), bf2f((u16)(w.z >> 16)), bf2f((u16)(w.w & 0xffffu)), bf2f((u16)(w.w >> 16))}; }
                    else { b0 = bs[m][bj][0]; b1 = bs[m][bj][1]; }
                    const pg8::f32x4 o0 = b0 + gv[bj][0] * acc[ai][bj][m][0], o1 = b1 + gv[bj][1] * acc[ai][bj][m][1];
                    if (IN_BF16) { *(pg8::f32x4*)((float*)out + off + bj * 128) = o0; *(pg8::f32x4*)((float*)out + off + bj * 128 + 4) = o1; }
                    else { v4u w; w.x = pk2(o0[0], o0[1]); w.y = pk2(o0[2], o0[3]); w.z = pk2(o1[0], o1[1]); w.w = pk2(o1[2], o1[3]); *(v4u*)((u16*)out + off + bj * 128) = w; } } }
        }
    }
};
struct EpiSwiglu {
    static constexpr bool PERM = true, AFTER_DRAIN = false;
    u16* ACT;
    __device__ __forceinline__ void operator()(const pg8::f32x4 (&acc)[2][2][4][2], const pg8::Unit& u, int wr, int wc, int fr, int fq) const {
        const int col0 = u.pn * 128 + wc * 32 + 8 * fq;
#pragma unroll
        for (int ai = 0; ai < 2; ++ai)
#pragma unroll
            for (int m = 0; m < 4; ++m) { const size_t row = (size_t)u.pm * 256 + ai * 128 + wr * 64 + m * 16 + fr;
                unsigned ow[4];
#pragma unroll
                for (int n = 0; n < 2; ++n) { const pg8::f32x4 av = acc[ai][0][m][n], bv = acc[ai][1][m][n];
                    float s[4];
#pragma unroll
                    for (int e = 0; e < 4; ++e) s[e] = av[e] * sigmoidf_(av[e]) * bv[e];
                    ow[2 * n] = pk2(s[0], s[1]); ow[2 * n + 1] = pk2(s[2], s[3]); }
                v4u w = {ow[0], ow[1], ow[2], ow[3]};
                *(v4u*)(ACT + row * DFF + col0) = w; }
    }
};
__device__ __forceinline__ void p_adaln(const Args& a, unsigned char* lds, const int mk_wid) {
    float* sl = (float*)lds;
    float* part = (float*)(lds + 17 * 1024 * 4);
    const int tid = MK_TID;
    const float* c = a.in[1]; const float* cctx = a.in[3]; const float* W = a.in[4]; const float* bada = a.in[5];
    float* MOD = (float*)(a.ws + WS_MOD);
    for (int i = tid; i < 17 * 1024; i += 512) { const float v = (i < 16 * 1024) ? c[i] : cctx[i - 16 * 1024]; sl[i] = v / (1.f + expf(-v)); }
    __syncthreads();
    for (int w = blockIdx.x; w < 192; w += gridDim.x) {
        const int col = w * 32 + (tid & 31), kg = tid >> 5;
        float acc[17];
#pragma unroll
        for (int v = 0; v < 17; ++v) acc[v] = 0.f;
        for (int kk = 0; kk < 64; kk += 16) { const int k = kg * 64 + kk; float wv[16];
#pragma unroll
            for (int j = 0; j < 16; ++j) wv[j] = __builtin_nontemporal_load(W + (size_t)(k + j) * 6144 + col);
#pragma unroll
            for (int v = 0; v < 17; ++v)
#pragma unroll
                for (int j4 = 0; j4 < 4; ++j4) { const f32x4 s4 = *(const f32x4*)(sl + v * 1024 + k + 4 * j4);
                    acc[v] += (s4.x * wv[4 * j4] + s4.y * wv[4 * j4 + 1]) + (s4.z * wv[4 * j4 + 2] + s4.w * wv[4 * j4 + 3]); } }
#pragma unroll
        for (int v = 0; v < 17; ++v) part[(kg * 17 + v) * 32 + (tid & 31)] = acc[v];
        __syncthreads();
        for (int i = tid; i < 17 * 32; i += 512) { const int v = i >> 5, cl = i & 31; float s = bada[w * 32 + cl];
            for (int g = 0; g < 16; ++g) s += part[(g * 17 + v) * 32 + cl];
            MOD[v * 6144 + w * 32 + cl] = s; }
        __syncthreads();
    }
}

__device__ __forceinline__ void transpose_item(const float* W, int ldw, int src_n0, int k0, u16* WT, int K, int dst_n0, bool zero, float* scr, int lane) {
    { const int kr = lane >> 3, n4 = (lane & 7) * 4; f32x4 v[8];
#pragma unroll
      for (int i = 0; i < 8; ++i) v[i] = zero ? (f32x4){0.f, 0.f, 0.f, 0.f} : __builtin_nontemporal_load((const f32x4*)(W + (size_t)(k0 + 8 * i + kr) * ldw + src_n0 + n4));
#pragma unroll
      for (int i = 0; i < 8; ++i) { float* d = scr + (8 * i + kr) * 33 + n4; d[0] = v[i].x; d[1] = v[i].y; d[2] = v[i].z; d[3] = v[i].w; } }
    asm volatile("s_waitcnt lgkmcnt(0)" ::: "memory");
    const int c = lane & 7;
#pragma unroll
    for (int j = 0; j < 4; ++j) { const int n = (lane >> 3) + 8 * j; const float* s = scr + (8 * c) * 33 + n;
        v4u o; o.x = pk2(s[0 * 33], s[1 * 33]); o.y = pk2(s[2 * 33], s[3 * 33]); o.z = pk2(s[4 * 33], s[5 * 33]); o.w = pk2(s[6 * 33], s[7 * 33]);
        *(v4u*)(WT + (size_t)(dst_n0 + n) * K + k0 + 8 * c) = o; }
    asm volatile("s_waitcnt lgkmcnt(0)" ::: "memory");
}
__device__ __forceinline__ void norm_mod_row2(const float* xrow0, const float* xrow1, const float* g, const float* shift0, const float* scale0, const float* shift1, const float* scale1, u16* orow0, u16* orow1, int lane) {
    const f32x4* xr0 = (const f32x4*)xrow0 + lane; const f32x4* xr1 = (const f32x4*)xrow1 + lane;
    f32x4 v0[4], v1[4]; float s0 = 0.f, s1 = 0.f;
#pragma unroll
    for (int j = 0; j < 4; ++j) { v0[j] = __builtin_nontemporal_load(xr0 + 64 * j); v1[j] = __builtin_nontemporal_load(xr1 + 64 * j); }
#pragma unroll
    for (int j = 0; j < 4; ++j) { s0 += (v0[j].x * v0[j].x + v0[j].y * v0[j].y) + (v0[j].z * v0[j].z + v0[j].w * v0[j].w); s1 += (v1[j].x * v1[j].x + v1[j].y * v1[j].y) + (v1[j].z * v1[j].z + v1[j].w * v1[j].w); }
#pragma unroll
    for (int o = 1; o < 64; o <<= 1) { s0 += __shfl_xor(s0, o); s1 += __shfl_xor(s1, o); }
    const float r0 = rsqrtf(s0 * (1.f / DM) + EPS), r1 = rsqrtf(s1 * (1.f / DM) + EPS);
    unsigned long long* o80 = (unsigned long long*)orow0 + lane; unsigned long long* o81 = (unsigned long long*)orow1 + lane;
#pragma unroll
    for (int j = 0; j < 4; ++j) { const f32x4 gg = ((const f32x4*)g)[lane + 64 * j];
        const f32x4 sh0 = ((const f32x4*)shift0)[lane + 64 * j], sc0 = ((const f32x4*)scale0)[lane + 64 * j], sh1 = ((const f32x4*)shift1)[lane + 64 * j], sc1 = ((const f32x4*)scale1)[lane + 64 * j];
        const f32x4 y0 = (v0[j] * r0 * gg) * (sc0 + 1.f) + sh0, y1 = (v1[j] * r1 * gg) * (sc1 + 1.f) + sh1;
        o80[64 * j] = (unsigned long long)pk2(y0.x, y0.y) | ((unsigned long long)pk2(y0.z, y0.w) << 32);
        o81[64 * j] = (unsigned long long)pk2(y1.x, y1.y) | ((unsigned long long)pk2(y1.z, y1.w) << 32); }
}
__device__ __forceinline__ void norm_mod_row2_bf(const u16* xrow0, const u16* xrow1, const float* g, const float* shift, const float* scale, u16* orow0, u16* orow1, int lane) {
    v4u w0[2], w1[2]; float x0[2][8], x1[2][8]; float s0 = 0.f, s1 = 0.f;
#pragma unroll
    for (int j = 0; j < 2; ++j) { w0[j] = *(const v4u*)(xrow0 + 512 * j + 8 * lane); w1[j] = *(const v4u*)(xrow1 + 512 * j + 8 * lane); }
#pragma unroll
    for (int j = 0; j < 2; ++j) { const unsigned a_[4] = {w0[j].x, w0[j].y, w0[j].z, w0[j].w}, b_[4] = {w1[j].x, w1[j].y, w1[j].z, w1[j].w};
#pragma unroll
        for (int e = 0; e < 4; ++e) { x0[j][2 * e] = bf2f((u16)(a_[e] & 0xffffu)); x0[j][2 * e + 1] = bf2f((u16)(a_[e] >> 16)); x1[j][2 * e] = bf2f((u16)(b_[e] & 0xffffu)); x1[j][2 * e + 1] = bf2f((u16)(b_[e] >> 16)); }
#pragma unroll
        for (int e = 0; e < 8; ++e) { s0 += x0[j][e] * x0[j][e]; s1 += x1[j][e] * x1[j][e]; } }
#pragma unroll
    for (int o = 1; o < 64; o <<= 1) { s0 += __shfl_xor(s0, o); s1 += __shfl_xor(s1, o); }
    const float r0 = rsqrtf(s0 * (1.f / DM) + EPS), r1 = rsqrtf(s1 * (1.f / DM) + EPS);
#pragma unroll
    for (int j = 0; j < 2; ++j) { const int c0 = 512 * j + 8 * lane; float y0[8], y1[8];
#pragma unroll
        for (int h4 = 0; h4 < 2; ++h4) { const f32x4 gg = *(const f32x4*)(g + c0 + 4 * h4), sh = *(const f32x4*)(shift + c0 + 4 * h4), sc = *(const f32x4*)(scale + c0 + 4 * h4);
#pragma unroll
            for (int e = 0; e < 4; ++e) { y0[4 * h4 + e] = (x0[j][4 * h4 + e] * r0 * gg[e]) * (sc[e] + 1.f) + sh[e]; y1[4 * h4 + e] = (x1[j][4 * h4 + e] * r1 * gg[e]) * (sc[e] + 1.f) + sh[e]; } }
        v4u o0 = {pk2(y0[0], y0[1]), pk2(y0[2], y0[3]), pk2(y0[4], y0[5]), pk2(y0[6], y0[7])}, o1 = {pk2(y1[0], y1[1]), pk2(y1[2], y1[3]), pk2(y1[4], y1[5]), pk2(y1[6], y1[7])};
        *(v4u*)(orow0 + c0) = o0; *(v4u*)(orow1 + c0) = o1; }
}
__device__ __forceinline__ void p_weights(const Args& a, unsigned char* lds, const int mk_wid, const int item_lo, const int item_hi, const int blk_lo, const bool do_rope) {
    const int tid = MK_TID, lane = tid & 63, wave = mk_wid;
    float* scr = (float*)(lds + wave * 16384);
    if ((int)blockIdx.x < blk_lo) return;
    const int gw = ((int)blockIdx.x - blk_lo) * 8 + wave, NGW = ((int)gridDim.x - blk_lo) * 8;
    unsigned char* ws = a.ws;
    constexpr int I_IN = 16 * 216, I_SQ = 16 * 32, I_FI = 16 * 176, I_FO = 44 * 32;
    constexpr int NITEMS = I_IN + 3 * I_SQ + I_FI + I_FO;
    for (int it = item_lo + gw; it < (item_hi < NITEMS ? item_hi : NITEMS); it += NGW) {
        int r = it;
        if (r < I_IN) { const int kb = r / 216, nb = r % 216, n0 = 32 * nb; const bool zero = n0 >= 6688;
            const int src = n0 < 4608 ? n0 : (n0 < 6656 ? n0 + 32 : n0 - 2048);
            transpose_item(a.in[7], 6688, zero ? 0 : src, 64 * kb, (u16*)(ws + WS_WIN), 1024, n0, zero, scr, lane); continue; }
        r -= I_IN;
        if (r < 3 * I_SQ) { const int which = r / I_SQ, q = r % I_SQ, kb = q / 32, nb = q % 32;
            const float* W = which == 0 ? a.in[15] : (which == 1 ? a.in[16] : a.in[17]);
            u16* WT = (u16*)(ws + (which == 0 ? WS_WAP : (which == 1 ? WS_WGP : WS_WOUT)));
            transpose_item(W, 1024, 32 * nb, 64 * kb, WT, 1024, 32 * nb, false, scr, lane); continue; }
        r -= 3 * I_SQ;
        if (r < I_FI) { const int kb = r / 176, nb = r % 176, n0 = 32 * nb, pn = n0 >> 8, j = n0 & 255;
            const int src = j < 128 ? pn * 128 + j : DFF + pn * 128 + (j - 128);
            transpose_item(a.in[19], 2 * DFF, src, 64 * kb, (u16*)(ws + WS_WFI), 1024, n0, false, scr, lane); continue; }
        r -= I_FI;
        { const int kb = r / 32, nb = r % 32; transpose_item(a.in[20], 1024, 32 * nb, 64 * kb, (u16*)(ws + WS_WFO), DFF, 32 * nb, false, scr, lane); }
    }
    float* rope = (float*)(ws + WS_ROPE);
    if (do_rope) for (int idx = blockIdx.x * 512 + tid; idx < T * 64; idx += gridDim.x * 512) { const int t = idx >> 6, i = idx & 63, j = i & 31;
        const float pos = (float)(i < 32 ? (t >> 6) : (t & 63));
        const float inv = 1.0f / powf(10000.f, (float)(2 * j) / 64.f);
        const float ang = pos * inv;
        rope[2 * idx] = cosf(ang); rope[2 * idx + 1] = sinf(ang); }
}

__device__ __forceinline__ void p_h1rows(const Args& a, const int mk_wid) {
    const int tid = MK_TID, lane = tid & 63, wave = mk_wid;
    const int gw = blockIdx.x * 8 + wave, NGW = gridDim.x * 8;
    unsigned char* ws = a.ws;
    const float* MOD = (const float*)(ws + WS_MOD);
    for (int m0 = gw * 2; m0 < MALL; m0 += NGW * 2) {
        const float* src[2]; const float* mod[2];
#pragma unroll
        for (int e = 0; e < 2; ++e) { const int m = m0 + e, b = m / TA, r = m % TA; const bool isc = r < TC;
            src[e] = isc ? a.in[2] + ((size_t)b * TC + r) * DM : a.in[0] + ((size_t)b * T + (r - TC)) * DM; mod[e] = MOD + (size_t)(isc ? 16 : b) * 6144; }
        norm_mod_row2(src[0], src[1], a.in[6], mod[0], mod[0] + 1024, mod[1], mod[1] + 1024, (u16*)(ws + WS_H1) + (size_t)m0 * DM, (u16*)(ws + WS_H1) + (size_t)(m0 + 1) * DM, lane); }
}

__device__ __forceinline__ void p_lowrank(const Args& a, unsigned char* lds, const int mk_wid) {
    const int tid = MK_TID, lane = tid & 63, r32 = lane & 31, hi = lane >> 5;
    constexpr int WP = 1032, APT = 136;
    u16* wl = (u16*)lds; u16* al = (u16*)(lds + 32 * WP * 2);
    const u16* H1 = (const u16*)(a.ws + WS_H1); const u16* WL = (const u16*)(a.ws + WS_WIN) + (size_t)6656 * 1024; u16* LR = (u16*)(a.ws + WS_LR);
    const int rb0 = (int)gridDim.x >= 256 ? (int)blockIdx.x - ((int)gridDim.x - MALL / 256) : (int)blockIdx.x;
    if (rb0 < 0 || rb0 >= MALL / 256) return;
#pragma unroll
    for (int p = 0; p < 8; ++p) { const int piece = p * 512 + tid, row = piece >> 7, c8 = piece & 127; *(v4u*)(wl + row * WP + c8 * 8) = *(const v4u*)(WL + (size_t)row * 1024 + c8 * 8); }
    for (int rb = rb0; rb < MALL / 256; rb += gridDim.x) {
        const u16* Ab = H1 + (size_t)rb * 256 * 1024;
        v4u st[8];
#pragma unroll
        for (int p = 0; p < 8; ++p) { const int piece = p * 512 + tid, row = piece >> 4, c8 = piece & 15; st[p] = *(const v4u*)(Ab + (size_t)row * 1024 + c8 * 8); }
        att::f32x16 acc = att::f32x16{};
        for (int kc = 0; kc < 8; ++kc) {
            __syncthreads();
#pragma unroll
            for (int p = 0; p < 8; ++p) { const int piece = p * 512 + tid, row = piece >> 4, c8 = piece & 15; *(v4u*)(al + row * APT + c8 * 8) = st[p]; }
            if (kc + 1 < 8) {
#pragma unroll
                for (int p = 0; p < 8; ++p) { const int piece = p * 512 + tid, row = piece >> 4, c8 = piece & 15; st[p] = *(const v4u*)(Ab + (size_t)row * 1024 + (kc + 1) * 128 + c8 * 8); } }
            __syncthreads();
            const u16* ap = al + (mk_wid * 32 + r32) * APT + 8 * hi; const u16* bp = wl + r32 * WP + kc * 128 + 8 * hi;
#pragma unroll
            for (int kb = 0; kb < 8; ++kb) acc = __builtin_amdgcn_mfma_f32_32x32x16_bf16(*(const att::bf16x8*)(ap + kb * 16), *(const att::bf16x8*)(bp + kb * 16), acc, 0, 0, 0);
        }
#pragma unroll
        for (int r = 0; r < 16; ++r) LR[(size_t)(rb * 256 + mk_wid * 32 + att::crow(r, hi)) * 32 + r32] = f2bf(acc[r]);
    }
    __syncthreads();
}
__device__ __forceinline__ void p_kprep(const Args& a, const int mk_wid) {
    const int tid = MK_TID, lane = tid & 63, wave = mk_wid;
    const int gw = blockIdx.x * 8 + wave, NGW = gridDim.x * 8;
    u16* Kb = (u16*)(a.ws + WS_K); const float* rope = (const float*)(a.ws + WS_ROPE); const float* kg = a.in[9];
    const int head = lane >> 5, l = lane & 31;
    const f32x4 g = *(const f32x4*)(kg + 4 * l);
    for (int m0 = gw * 6; m0 < MALL; m0 += NGW * 6) {
        v2u w[6]; f32x4 cs[6]; float f[6][4], s[6];
#pragma unroll
        for (int e = 0; e < 6; ++e) { const int m = m0 + e, r = m % TA; w[e] = *(const v2u*)(Kb + (size_t)m * 256 + head * 128 + 4 * l);
            cs[e] = (r >= TC) ? *(const f32x4*)(rope + ((size_t)(r - TC) * 64 + 2 * l) * 2) : (f32x4){1.f, 0.f, 1.f, 0.f}; }
#pragma unroll
        for (int e = 0; e < 6; ++e) { f[e][0] = bf2f((u16)(w[e].x & 0xffffu)); f[e][1] = bf2f((u16)(w[e].x >> 16)); f[e][2] = bf2f((u16)(w[e].y & 0xffffu)); f[e][3] = bf2f((u16)(w[e].y >> 16));
            s[e] = (f[e][0] * f[e][0] + f[e][1] * f[e][1]) + (f[e][2] * f[e][2] + f[e][3] * f[e][3]); }
#pragma unroll
        for (int o = 1; o < 32; o <<= 1) {
#pragma unroll
            for (int e = 0; e < 6; ++e) s[e] += __shfl_xor(s[e], o); }
#pragma unroll
        for (int e = 0; e < 6; ++e) { const float rinv = rsqrtf(s[e] * (1.f / 128.f) + EPS);
            const float f0 = f[e][0] * rinv * g.x, f1 = f[e][1] * rinv * g.y, f2 = f[e][2] * rinv * g.z, f3 = f[e][3] * rinv * g.w;
            v2u o; o.x = pk2(f0 * cs[e].x - f1 * cs[e].y, f0 * cs[e].y + f1 * cs[e].x); o.y = pk2(f2 * cs[e].z - f3 * cs[e].w, f2 * cs[e].w + f3 * cs[e].z);
            *(v2u*)(Kb + (size_t)(m0 + e) * 256 + head * 128 + 4 * l) = o; } }
}
__device__ __forceinline__ void p_glapost(const Args& a, const int mk_wid) {
    const int tid = MK_TID, lane = tid & 63, wave = mk_wid;
    const int gw = blockIdx.x * 8 + wave, NGW = gridDim.x * 8;
    const u16* OF = (const u16*)(a.ws + WS_OF); const u16* OB = (const u16*)(a.ws + WS_OB); u16* GG = (u16*)(a.ws + WS_GG);
    const f32x4 g = *(const f32x4*)(a.in[14] + 4 * lane);
    for (int it0 = gw * 4; it0 < MLAT * 4; it0 += NGW * 4) {
        v2u wf[4], wb[4], wg[4]; float o_[4][4], ss[4];
#pragma unroll
        for (int e = 0; e < 4; ++e) { const size_t off = (size_t)(it0 + e) * 256 + 4 * lane; wf[e] = __builtin_nontemporal_load((const v2u*)(OF + off)); wb[e] = __builtin_nontemporal_load((const v2u*)(OB + off)); wg[e] = __builtin_nontemporal_load((const v2u*)(GG + off)); }
#pragma unroll
        for (int e = 0; e < 4; ++e) {
            o_[e][0] = bf2f((u16)(wf[e].x & 0xffffu)) + bf2f((u16)(wb[e].x & 0xffffu)); o_[e][1] = bf2f((u16)(wf[e].x >> 16)) + bf2f((u16)(wb[e].x >> 16));
            o_[e][2] = bf2f((u16)(wf[e].y & 0xffffu)) + bf2f((u16)(wb[e].y & 0xffffu)); o_[e][3] = bf2f((u16)(wf[e].y >> 16)) + bf2f((u16)(wb[e].y >> 16));
            ss[e] = (o_[e][0] * o_[e][0] + o_[e][1] * o_[e][1]) + (o_[e][2] * o_[e][2] + o_[e][3] * o_[e][3]); }
#pragma unroll
        for (int o = 1; o < 64; o <<= 1) {
#pragma unroll
            for (int e = 0; e < 4; ++e) ss[e] += __shfl_xor(ss[e], o); }
#pragma unroll
        for (int e = 0; e < 4; ++e) { const float rinv = rsqrtf(ss[e] * (1.f / 256.f) + EPS);
            const float g0 = bf2f((u16)(wg[e].x & 0xffffu)), g1 = bf2f((u16)(wg[e].x >> 16)), g2 = bf2f((u16)(wg[e].y & 0xffffu)), g3 = bf2f((u16)(wg[e].y >> 16));
            v2u o; o.x = pk2(o_[e][0] * rinv * g.x * (g0 * sigmoidf_(g0)), o_[e][1] * rinv * g.y * (g1 * sigmoidf_(g1)));
            o.y = pk2(o_[e][2] * rinv * g.z * (g2 * sigmoidf_(g2)), o_[e][3] * rinv * g.w * (g3 * sigmoidf_(g3)));
            *(v2u*)(GG + (size_t)(it0 + e) * 256 + 4 * lane) = o; } }
}
__device__ __forceinline__ void p_h2(const Args& a, const int mk_wid) {
    const int tid = MK_TID, lane = tid & 63, wave = mk_wid;
    const int gw = blockIdx.x * 8 + wave, NGW = gridDim.x * 8;
    const float* MOD = (const float*)(a.ws + WS_MOD);
    const u16* X1 = (const u16*)(a.ws + WS_X1);
    for (int m0 = gw * 2; m0 < MLAT; m0 += NGW * 2) { const float* mod = MOD + (size_t)(m0 / T) * 6144;
        norm_mod_row2_bf(X1 + (size_t)m0 * DM, X1 + (size_t)(m0 + 1) * DM, a.in[18], mod + 3 * 1024, mod + 4 * 1024,
                         (u16*)(a.ws + WS_H2) + (size_t)m0 * DM, (u16*)(a.ws + WS_H2) + (size_t)(m0 + 1) * DM, lane); }
}
namespace gla {
using att::bf16x8; using att::s16x4; using att::f32x16; using att::crow; using att::v_st; using att::v_rd_base; using att::v_rd_off; using att::tr_read;
constexpr int QP = 136, AP = 72;
constexpr int L_QE = 0, L_KE = 17408, L_KD = 34816, L_V = 51200, L_AM = 83968, L_LAS = 93184, L_LR = 125952, L_GS = 128000, L_DL = 130048, L_END = 130560;
static_assert(L_END <= LDS_BYTES - 64, "GLA LDS map");
#define GLA_PK(L, H) (bf16x8){L[0], L[1], L[2], L[3], H[0], H[1], H[2], H[3]}
#define GLA_SBAR() __builtin_amdgcn_sched_barrier(0)
#define OPAQUE_TID(name) int name = MK_TID; asm volatile("" : "+v"(name))

__device__ __forceinline__ void scan_unit(const int unit, const Args& a, unsigned char* lds, const int mk_wid) {
    const int wid = mk_wid;
    const int dir = unit & 1, h = (unit >> 1) & 3, b = unit >> 3;
    const int vt = wid;
    const u16* GQ = (const u16*)(a.ws + WS_GQ); const u16* GK = (const u16*)(a.ws + WS_GK); const u16* GV = (const u16*)(a.ws + WS_GV); const u16* LR = (const u16*)(a.ws + WS_LR);
    u16* OUT = (u16*)(a.ws + (dir ? WS_OB : WS_OF));
    bf16x8 upf; float biasc;
    { const int l_ = MK_TID & 63, r32 = l_ & 31, hi = l_ >> 5; const float* up = a.in[dir ? 12 : 10] + (size_t)(8 * hi) * 512 + h * 128 + (wid & 3) * 32 + r32;
      v4u w; w.x = pk2(up[0], up[512]); w.y = pk2(up[2 * 512], up[3 * 512]); w.z = pk2(up[4 * 512], up[5 * 512]); w.w = pk2(up[6 * 512], up[7 * 512]);
      upf = __builtin_bit_cast(bf16x8, w); biasc = a.in[dir ? 13 : 11][h * 128 + (wid & 3) * 32 + r32]; }
    u16* qe = (u16*)(lds + L_QE); u16* ke = (u16*)(lds + L_KE); u16* am = (u16*)(lds + L_AM);
    float* las = (float*)(lds + L_LAS); float* gs = (float*)(lds + L_GS); float* dl = (float*)(lds + L_DL);
    const int ldsb = (int)(uintptr_t)lds;
    u16* ot = (u16*)(lds + L_LAS);
    int pend_cc = -1;
#define GLA_FLUSH() do { if (pend_cc >= 0) { OPAQUE_TID(tf_); const size_t rl0_ = (size_t)b * T + (size_t)(pend_cc - 4) * 64; \
      _Pragma("unroll") for (int p = 0; p < 4; ++p) { const int idx_ = p * 512 + tf_, i_ = idx_ >> 5, c16_ = idx_ & 31; \
          *(v4u*)(OUT + (rl0_ + (dir ? 63 - i_ : i_)) * 1024 + h * 256 + c16_ * 8) = *(const v4u*)(ot + i_ * 256 + c16_ * 8); } } } while (0)
    f32x16 S[4]; S[0] = f32x16{}; S[1] = f32x16{}; S[2] = f32x16{}; S[3] = f32x16{};
    bf16x8 qraw[2], kraw[2], vraw[4]; bf16x8 lraw = bf16x8{};
#define GLA_CHUNK(s) (dir ? ((s) < 4 ? 3 - (s) : 39 - (s)) : (s))
#define GLA_LOAD(s) do { OPAQUE_TID(t_); const int cc_ = GLA_CHUNK(s); const size_t rowb_ = (size_t)b * TA + (size_t)cc_ * 64; \
      _Pragma("unroll") for (int p = 0; p < 2; ++p) { const int i_ = p * 32 + (t_ >> 4); const size_t row_ = rowb_ + (dir ? 63 - i_ : i_); \
          kraw[p] = *(const bf16x8*)(GK + row_ * 512 + h * 128 + (t_ & 15) * 8); \
          qraw[p] = (cc_ >= 4) ? *(const bf16x8*)(GQ + row_ * 512 + h * 128 + (t_ & 15) * 8) : bf16x8{}; } \
      _Pragma("unroll") for (int p = 0; p < 4; ++p) { const int i_ = p * 16 + (t_ >> 5); const size_t row_ = rowb_ + (dir ? 63 - i_ : i_); \
          vraw[p] = *(const bf16x8*)(GV + row_ * 1024 + h * 256 + (t_ & 31) * 8); } \
      if (t_ < 128) { const int i_ = t_ >> 1; const size_t row_ = rowb_ + (dir ? 63 - i_ : i_); lraw = *(const bf16x8*)(LR + row_ * 32 + dir * 16 + (t_ & 1) * 8); } } while (0)
    GLA_LOAD(0);
    for (int step = 0; step < 36; ++step) {
        const int cc = GLA_CHUNK(step); const bool lat = cc >= 4;
        GLA_FLUSH();
        { OPAQUE_TID(t_);
#pragma unroll
          for (int p = 0; p < 2; ++p) { const int i_ = p * 32 + (t_ >> 4), c_ = (t_ & 15) * 8; *(bf16x8*)(qe + i_ * QP + c_) = qraw[p]; *(bf16x8*)(ke + i_ * QP + c_) = kraw[p]; }
#pragma unroll
          for (int p = 0; p < 4; ++p) { const int i_ = p * 16 + (t_ >> 5), c8 = t_ & 31; *(bf16x8*)(lds + L_V + (c8 >> 4) * 16384 + v_st(i_, (c8 & 15) * 8)) = vraw[p]; }
          if (t_ < 128) *(bf16x8*)(lds + L_LR + (t_ >> 1) * 32 + (t_ & 1) * 16) = lraw; }
        __syncthreads();
        { OPAQUE_TID(t_); const int lane = t_ & 63, r32 = lane & 31, hi = lane >> 5; const int tt = wid >> 2, ct = wid & 3;
          const bf16x8 af = *(const bf16x8*)(lds + L_LR + (tt * 32 + r32) * 32 + hi * 16);
          const f32x16 z = __builtin_amdgcn_mfma_f32_32x32x16_bf16(af, upf, f32x16{}, 0, 0, 0);
          float* lw = las + (tt * 32 + 4 * hi) * 128 + ct * 32 + r32;
#pragma unroll
          for (int r = 0; r < 16; ++r) { const float zz = z[r] + biasc;
              lw[crow(r, 0) * 128] = (fminf(zz, 0.f) - __builtin_amdgcn_logf(1.f + __builtin_amdgcn_exp2f(-1.4426950408889634f * fabsf(zz))) * 0.6931471805599453f) * (1.f / 16.f); } }
        __syncthreads();
        { OPAQUE_TID(t_); const int c = t_ & 127, g = t_ >> 7;
          float bl[16]; float run = 0.f;
          { const float* lp = las + (g * 16) * 128 + c;
#pragma unroll
            for (int ii = 0; ii < 16; ++ii) { run += lp[ii * 128]; bl[ii] = run; } }
          gs[g * 128 + c] = run;
          __syncthreads();
          const float g0 = gs[c], g1 = gs[128 + c], g2 = gs[256 + c], g3 = gs[384 + c];
          const float off = (g > 0 ? g0 : 0.f) + (g > 1 ? g1 : 0.f) + (g > 2 ? g2 : 0.f);
          const float btot = (g0 + g1) + (g2 + g3);
          const float dlc = __builtin_amdgcn_exp2f(btot * 1.4426950408889634f);
          if (g == 0) dl[c] = dlc;
          u16* qcol = qe + (g * 16) * QP + c; u16* kcol = ke + (g * 16) * QP + c; unsigned char* kdb = lds + L_KD + v_st(g * 16, c);
#pragma unroll
          for (int ii = 0; ii < 16; ++ii) { const float bb = bl[ii] + off;
              const float qf = bf2f(qcol[ii * QP]), kf = bf2f(kcol[ii * QP]);
              const float e = __builtin_amdgcn_exp2f(bb * 1.4426950408889634f), ker = kf * __builtin_amdgcn_rcpf(e);
              qcol[ii * QP] = f2bf(qf * (0.088388347648318440f * e));
              kcol[ii * QP] = f2bf(ker);
              *(u16*)(kdb + v_st(ii, 0)) = f2bf(ker * dlc); } }
        if (step + 1 < 36) GLA_LOAD(step + 1);
        __syncthreads();
        if (lat) {
            if (wid < 4) { OPAQUE_TID(t_); const int r32 = t_ & 31, hi = (t_ >> 5) & 1;
                const int jt = wid >> 1, it = wid & 1; f32x16 ct = f32x16{};
                const u16* kp = ke + (jt * 32 + r32) * QP + hi * 8; const u16* qp = qe + (it * 32 + r32) * QP + hi * 8;
#pragma unroll
                for (int kb = 0; kb < 8; ++kb) ct = __builtin_amdgcn_mfma_f32_32x32x16_bf16(*(const bf16x8*)(kp + kb * 16), *(const bf16x8*)(qp + kb * 16), ct, 0, 0, 0);
                const int i = it * 32 + r32;
#pragma unroll
                for (int rg = 0; rg < 4; ++rg) { const int j0 = jt * 32 + 8 * rg + 4 * hi;
                    const float x0 = (j0 + 0 <= i) ? ct[4 * rg + 0] : 0.f, x1 = (j0 + 1 <= i) ? ct[4 * rg + 1] : 0.f, x2 = (j0 + 2 <= i) ? ct[4 * rg + 2] : 0.f, x3 = (j0 + 3 <= i) ? ct[4 * rg + 3] : 0.f;
                    v2u w; w.x = pk2(x0, x1); w.y = pk2(x2, x3); *(v2u*)(am + i * AP + j0) = w; } }
            __syncthreads();
        }
        { OPAQUE_TID(t_); const int lane = t_ & 63, r32 = lane & 31, hi = lane >> 5;
          const int vb = ldsb + L_V + (vt >> 2) * 16384 + v_rd_base(lane) + (vt & 3) * 512;
          s16x4 vl0, vh0, vl1, vh1, vl2, vh2, vl3, vh3;
#define GLA_LOADV() do { vl0 = tr_read<v_rd_off(0, 0, 0)>(vb); vh0 = tr_read<v_rd_off(0, 0, 1)>(vb); vl1 = tr_read<v_rd_off(0, 1, 0)>(vb); vh1 = tr_read<v_rd_off(0, 1, 1)>(vb); \
              vl2 = tr_read<v_rd_off(0, 2, 0)>(vb); vh2 = tr_read<v_rd_off(0, 2, 1)>(vb); vl3 = tr_read<v_rd_off(0, 3, 0)>(vb); vh3 = tr_read<v_rd_off(0, 3, 1)>(vb); } while (0)
          if (!lat) GLA_LOADV();
          if (lat) {
              f32x16 o0 = f32x16{}, o1 = f32x16{};
#pragma unroll
              for (int ct = 0; ct < 4; ++ct)
#pragma unroll
                for (int kb = 0; kb < 2; ++kb) { const int cb = ct * 32 + kb * 16;
                    v4u sw; sw.x = pk2(S[ct][8 * kb + 0], S[ct][8 * kb + 1]); sw.y = pk2(S[ct][8 * kb + 2], S[ct][8 * kb + 3]); sw.z = pk2(S[ct][8 * kb + 4], S[ct][8 * kb + 5]); sw.w = pk2(S[ct][8 * kb + 6], S[ct][8 * kb + 7]);
                    const bf16x8 sb = __builtin_bit_cast(bf16x8, sw);
                    { const u16* p0 = qe + r32 * QP + cb + 4 * hi; const v2u lo = *(const v2u*)p0, hh = *(const v2u*)(p0 + 8); v4u aw = {lo.x, lo.y, hh.x, hh.y};
                      o0 = __builtin_amdgcn_mfma_f32_32x32x16_bf16(__builtin_bit_cast(bf16x8, aw), sb, o0, 0, 0, 0); }
                    { const u16* p1 = qe + (32 + r32) * QP + cb + 4 * hi; const v2u lo = *(const v2u*)p1, hh = *(const v2u*)(p1 + 8); v4u aw = {lo.x, lo.y, hh.x, hh.y};
                      o1 = __builtin_amdgcn_mfma_f32_32x32x16_bf16(__builtin_bit_cast(bf16x8, aw), sb, o1, 0, 0, 0); } }
              GLA_LOADV();
              asm volatile("s_waitcnt lgkmcnt(0)" ::: "memory"); GLA_SBAR();
              { const u16* a0 = am + r32 * AP + hi * 8; const u16* a1 = am + (32 + r32) * AP + hi * 8;
                o0 = __builtin_amdgcn_mfma_f32_32x32x16_bf16(*(const bf16x8*)(a0), GLA_PK(vl0, vh0), o0, 0, 0, 0);
                o0 = __builtin_amdgcn_mfma_f32_32x32x16_bf16(*(const bf16x8*)(a0 + 16), GLA_PK(vl1, vh1), o0, 0, 0, 0);
                o1 = __builtin_amdgcn_mfma_f32_32x32x16_bf16(*(const bf16x8*)(a1), GLA_PK(vl0, vh0), o1, 0, 0, 0);
                o1 = __builtin_amdgcn_mfma_f32_32x32x16_bf16(*(const bf16x8*)(a1 + 16), GLA_PK(vl1, vh1), o1, 0, 0, 0);
                o1 = __builtin_amdgcn_mfma_f32_32x32x16_bf16(*(const bf16x8*)(a1 + 32), GLA_PK(vl2, vh2), o1, 0, 0, 0);
                o1 = __builtin_amdgcn_mfma_f32_32x32x16_bf16(*(const bf16x8*)(a1 + 48), GLA_PK(vl3, vh3), o1, 0, 0, 0); }
              { u16* ow = ot + (4 * hi) * 256 + vt * 32 + r32;
#pragma unroll
                for (int r = 0; r < 16; ++r) { const int i0 = crow(r, 0); ow[i0 * 256] = f2bf(o0[r]); ow[(i0 + 32) * 256] = f2bf(o1[r]); } }
          }
#pragma unroll
          for (int ct = 0; ct < 4; ++ct) { const int kb_ = ldsb + L_KD + v_rd_base(lane) + ct * 512;
              const s16x4 al0 = tr_read<v_rd_off(0, 0, 0)>(kb_), ah0 = tr_read<v_rd_off(0, 0, 1)>(kb_), al1 = tr_read<v_rd_off(0, 1, 0)>(kb_), ah1 = tr_read<v_rd_off(0, 1, 1)>(kb_);
              const s16x4 al2 = tr_read<v_rd_off(0, 2, 0)>(kb_), ah2 = tr_read<v_rd_off(0, 2, 1)>(kb_), al3 = tr_read<v_rd_off(0, 3, 0)>(kb_), ah3 = tr_read<v_rd_off(0, 3, 1)>(kb_);
              const float* dp = dl + ct * 32 + 4 * hi;
#pragma unroll
              for (int rg = 0; rg < 4; ++rg) { const f32x4 d4 = *(const f32x4*)(dp + 8 * rg);
                  S[ct][4 * rg + 0] *= d4.x; S[ct][4 * rg + 1] *= d4.y; S[ct][4 * rg + 2] *= d4.z; S[ct][4 * rg + 3] *= d4.w; }
              asm volatile("s_waitcnt lgkmcnt(0)" ::: "memory"); GLA_SBAR();
              S[ct] = __builtin_amdgcn_mfma_f32_32x32x16_bf16(GLA_PK(al0, ah0), GLA_PK(vl0, vh0), S[ct], 0, 0, 0);
              S[ct] = __builtin_amdgcn_mfma_f32_32x32x16_bf16(GLA_PK(al1, ah1), GLA_PK(vl1, vh1), S[ct], 0, 0, 0);
              S[ct] = __builtin_amdgcn_mfma_f32_32x32x16_bf16(GLA_PK(al2, ah2), GLA_PK(vl2, vh2), S[ct], 0, 0, 0);
              S[ct] = __builtin_amdgcn_mfma_f32_32x32x16_bf16(GLA_PK(al3, ah3), GLA_PK(vl3, vh3), S[ct], 0, 0, 0); } }
        __syncthreads();
        pend_cc = lat ? cc : -1;
    }
    GLA_FLUSH();
    __syncthreads();
#undef GLA_FLUSH
#undef GLA_LOADV
#undef GLA_CHUNK
#undef GLA_LOAD
}
}
#define XB_TMO      128
#define XB_XCNT(j)  (256  + 64 * (j))
#define XB_XSUB(j)  (1280 + 64 * (j))
#define XB_XGEN(j)  (2304 + 64 * (j))
#define XB_TOP      3328
#define XB_TOPGEN   3392
#define XCD_BAR_WORDS 3456
#define XB_SPIN_CAP (1u << 18)

__device__ __forceinline__ unsigned xb_ld(unsigned* p)              { return __hip_atomic_load(p, __ATOMIC_RELAXED, __HIP_MEMORY_SCOPE_AGENT); }
__device__ __forceinline__ unsigned xb_add(unsigned* p, unsigned v) { return __hip_atomic_fetch_add(p, v, __ATOMIC_RELAXED, __HIP_MEMORY_SCOPE_AGENT); }
__device__ __forceinline__ unsigned xb_xcc_id() { return (unsigned)__builtin_amdgcn_s_getreg((3 << 11) | 20) & 0xFu; }
#define XB_SPIN(cond, bar) do { unsigned _sp = 0; while (cond) { __builtin_amdgcn_s_sleep(1); \
    if ((++_sp & 255u) == 0u) { if (xb_ld(&(bar)[XB_TMO])) break; if (_sp > XB_SPIN_CAP) { atomicAdd(&(bar)[XB_TMO], 1u); break; } } } } while (0)

struct XcdBarrier {
    unsigned* bar; unsigned x;
    volatile LAS unsigned* st;
};

__device__ __forceinline__ XcdBarrier xcd_barrier_post(unsigned* bar, volatile LAS unsigned* st, const bool tid0) {
    XcdBarrier b; b.bar = bar; b.x = xb_xcc_id(); b.st = st;
    if (tid0) (void)xb_add(&bar[XB_XCNT(b.x)], 1u);
    return b;
}
__device__ __forceinline__ void xcd_barrier_complete(unsigned* bar, unsigned x, unsigned& nloc, unsigned& nx) {
    const unsigned G = gridDim.x * gridDim.y * gridDim.z;
    unsigned sum, cnt, mine, sp = 0u;
    for (;;) {
        sum = 0u; cnt = 0u; mine = 0u;
#pragma unroll
        for (unsigned j = 0; j < 16; ++j) { const unsigned c = xb_ld(&bar[XB_XCNT(j)]); sum += c; cnt += (c > 0u) ? 1u : 0u; mine = (j == x) ? c : mine; }
        if (sum == G) break;
        __builtin_amdgcn_s_sleep(1);
        if ((++sp & 255u) == 0u) { if (xb_ld(&bar[XB_TMO])) break; if (sp > XB_SPIN_CAP) { atomicAdd(&bar[XB_TMO], 1u); break; } }
    }
    nloc = mine > 0u ? mine : 1u; nx = cnt > 0u ? cnt : 1u;
}

__device__ __forceinline__ void xcd_barrier(const XcdBarrier& b, const bool tid0) {
    asm volatile("s_waitcnt vmcnt(0)" ::: "memory");
    __syncthreads();
    if (tid0) {
        unsigned* bar = b.bar; const unsigned bx_ = (unsigned)__builtin_amdgcn_readfirstlane((int)xb_xcc_id());
        __builtin_amdgcn_s_waitcnt(0);
        unsigned nloc = b.st[0], nx = b.st[1];
        if (nloc == 0u) { xcd_barrier_complete(bar, bx_, nloc, nx); b.st[0] = nloc; b.st[1] = nx; }
        const unsigned old = xb_add(&bar[XB_XSUB(bx_)], 1u);
        const unsigned gen = old / nloc;
        if (old + 1u == (gen + 1u) * nloc) {
            __builtin_amdgcn_fence(__ATOMIC_RELEASE, "agent");
            asm volatile("s_waitcnt vmcnt(0)" ::: "memory");
            const unsigned og = xb_add(&bar[XB_TOP], 1u);
            const unsigned tg = og / nx;
            if (og + 1u == (tg + 1u) * nx) xb_add(&bar[XB_TOPGEN], 1u);
            else XB_SPIN(xb_ld(&bar[XB_TOPGEN]) == tg, bar);
            __builtin_amdgcn_fence(__ATOMIC_ACQUIRE, "agent");
            xb_add(&bar[XB_XGEN(bx_)], 1u);
            asm volatile("s_waitcnt vmcnt(0)" ::: "memory");
        } else {
            XB_SPIN(xb_ld(&bar[XB_XGEN(bx_)]) == gen, bar);
            __builtin_amdgcn_fence(__ATOMIC_ACQUIRE, "agent");
            asm volatile("s_waitcnt vmcnt(0)" ::: "memory");
        }
    }
    __syncthreads();
}
#ifndef MK_PER_PHASE
#define MK_PER_PHASE 0
#endif
__global__ void __launch_bounds__(512) mk_fwd(Args a) {
    extern __shared__ __attribute__((aligned(16))) unsigned char lds[];
    cg::grid_group grid = cg::this_grid();
    unsigned char* ws = a.ws;
    LAS unsigned char* lds3 = (LAS unsigned char*)lds;
    const int G = gridDim.x, bx = blockIdx.x;
    const int mk_wid = __builtin_amdgcn_readfirstlane(threadIdx.x >> 6);
#ifndef PHMASK
#define PHMASK 0x7ff
#endif
#define IN(k) (((PHMASK >> (k)) & 1) && a.ph_lo <= (k) && (k) < a.ph_hi)
    unsigned* bar_words = (unsigned*)(ws + 4096);
    volatile LAS unsigned* bar_st = (volatile LAS unsigned*)(lds3 + (LDS_BYTES - 64));
    { const int t0_ = MK_TID; if (t0_ < 2) bar_st[t0_] = 0u; }
    if (IN(0) && bx == 0) { for (int i = MK_TID; i < XCD_BAR_WORDS; i += 512) __hip_atomic_store(bar_words + i, 0u, __ATOMIC_RELAXED, __HIP_MEMORY_SCOPE_AGENT); }
#define SEAM(k) do { if (IN(k) && IN((k) + 1)) { if ((k) == 0) { grid.sync(); (void)xcd_barrier_post(bar_words, bar_st, MK_TID == 0); } else { unsigned long long bp_ = (unsigned long long)(a.ws + 4096); asm volatile("" : "+s"(bp_)); XcdBarrier xb_; xb_.bar = (unsigned*)bp_; xb_.x = 0; xb_.st = bar_st; xcd_barrier(xb_, MK_TID == 0); } } } while (0)
    if (IN(0)) p_adaln(a, lds, mk_wid);
    SEAM(0);
    if (IN(1)) { p_weights(a, lds, mk_wid, 0, (G == 256) ? WI_IN : WI_ALL, 0, true); p_h1rows(a, mk_wid); }
    SEAM(1);
    if (IN(2)) {
        pg8::Gemm g{(const pg8::bf16_t*)(ws + WS_H1), (const pg8::bf16_t*)(ws + WS_WIN), MALL, NIN, DM}; InProjOrder S; S.init(G, bx);
        EpiInProj E{ws, (u16*)a.out};
        p_lowrank(a, lds, mk_wid);
        __syncthreads();
        pg8::gemm_phase<EpiInProj, InProjOrder, true, true>(lds3, g, S, E, mk_wid);
        if (G == 256) p_weights(a, lds, mk_wid, WI_IN, WI_PROJ, 128, false);
    }
    SEAM(2);
    if (IN(3)) p_kprep(a, mk_wid);
    SEAM(3);
    if (IN(4)) {
        const att::bf16* Qp = (const att::bf16*)(ws + WS_Q); const att::bf16* Kp = (const att::bf16*)(ws + WS_K); const att::bf16* Vp = (const att::bf16*)(ws + WS_V);
        const float* rope = (const float*)(ws + WS_ROPE);
        const bool full = (G == 256);
        if (full) { if (bx < 128) gla::scan_unit(bx, a, lds, mk_wid); }
        else { for (int u = bx; u < 128; u += G) gla::scan_unit(u, a, lds, mk_wid); }
        __syncthreads();
        const int xj = bx >> 3, xx = bx & 7;
        const int nun = full ? (xj < 16 ? 3 : 5) : 0;
        for (int i = 0; ; ++i) {
            int bk, w;
            if (full) { if (i >= nun) break; const int idx = (xj < 16) ? 80 + i * 16 + xj : i * 16 + (xj - 16); bk = (idx >> 5) * 8 + xx; w = idx & 31; }
            else { const int u = i * G + bx; if (u >= 1024) break; bk = u >> 5; w = u & 31; }
            const int b = bk >> 1, kvh = bk & 1, hq = kvh * 4 + (w >> 3), qb = w & 7;
            const size_t qoff = ((size_t)b * T + (size_t)qb * 256) * 1024 + hq * 128;
            const size_t koff = (size_t)b * TA * 256 + kvh * 128;
            att::attn_unit(Qp + qoff, Kp + koff, Vp + koff, (att::bf16*)(ws + WS_Q) + qoff, TA, (char*)lds, rope + (size_t)qb * 256 * 128, a.in[8], mk_wid);
        }
        if (full) p_weights(a, lds, mk_wid, WI_PROJ, WI_ALL, 128, false);
    }
    SEAM(4);
    if (IN(5)) {
        pg8::StaticOrder S; S.init(MLAT, DM, G, bx, 2);
        { pg8::Gemm g{(const pg8::bf16_t*)(ws + WS_Q), (const pg8::bf16_t*)(ws + WS_WAP), MLAT, DM, DM};
          EpiMerge<0> E{(const u16*)a.out, (u16*)(ws + WS_T1), (u16*)(ws + WS_MRG)};
          pg8::gemm_phase<EpiMerge<0>, pg8::StaticOrder, true, true>(lds3, g, S, E, mk_wid); }
        p_glapost(a, mk_wid);
    }
    SEAM(5);
    if (IN(6)) {
        pg8::StaticOrder S; S.init(MLAT, DM, G, bx, 2);
        pg8::Gemm g{(const pg8::bf16_t*)(ws + WS_GG), (const pg8::bf16_t*)(ws + WS_WGP), MLAT, DM, DM};
        EpiMerge<1> E{(const u16*)a.out, (u16*)(ws + WS_T1), (u16*)(ws + WS_MRG)};
        pg8::gemm_phase<EpiMerge<1>, pg8::StaticOrder, true, true>(lds3, g, S, E, mk_wid);
    }
    SEAM(6);
    if (IN(7)) {
        pg8::Gemm g{(const pg8::bf16_t*)(ws + WS_MRG), (const pg8::bf16_t*)(ws + WS_WOUT), MLAT, DM, DM}; pg8::StaticOrder S; S.init(MLAT, DM, G, bx, 2);
        EpiGateResB<false> E{(const void*)a.in[0], (void*)(ws + WS_X1), (const float*)(ws + WS_MOD) + 2 * 1024};
        pg8::gemm_phase<EpiGateResB<false>, pg8::StaticOrder, true, true>(lds3, g, S, E, mk_wid);
    }
    SEAM(7);
    if (IN(8)) p_h2(a, mk_wid);
    SEAM(8);
    if (IN(9)) {
        pg8::Gemm g{(const pg8::bf16_t*)(ws + WS_H2), (const pg8::bf16_t*)(ws + WS_WFI), MLAT, 2 * DFF, DM}; pg8::StaticOrder S; S.init(MLAT, 2 * DFF, G, bx);
        EpiSwiglu E{(u16*)(ws + WS_ACT)};
        pg8::gemm_phase<EpiSwiglu, pg8::StaticOrder, true, true>(lds3, g, S, E, mk_wid);
    }
    SEAM(9);
    if (IN(10)) {
        pg8::Gemm g{(const pg8::bf16_t*)(ws + WS_ACT), (const pg8::bf16_t*)(ws + WS_WFO), MLAT, DM, DFF}; pg8::StaticOrder S; S.init(MLAT, DM, G, bx, 2);
        EpiGateResB<true> E{(const void*)(ws + WS_X1), (void*)a.out, (const float*)(ws + WS_MOD) + 5 * 1024};
        pg8::gemm_phase<EpiGateResB<true>, pg8::StaticOrder, true, true>(lds3, g, S, E, mk_wid);
    }
#undef IN
#undef SEAM
}

extern "C" void kernel_launch(void* const* d_in, const int* in_sizes, int n_in, void* d_out, int out_size, void* d_ws, size_t ws_size, hipStream_t stream) {
    static int grid = 0;
    if (grid == 0) {
        if (n_in != 21 || in_sizes[0] != MLAT * DM || out_size != MLAT * DM || ws_size < WS_END) {
            fprintf(stderr, "kernel_launch: unexpected shapes: n_in %d in0 %d out %d ws %zu (need >= %zu)\n", n_in, n_in > 0 ? in_sizes[0] : -1, out_size, ws_size, (size_t)WS_END); grid = -1; return; }
        int dev = 0, cus = 0, per_cu = 0;
        if (hipGetDevice(&dev) != hipSuccess || hipDeviceGetAttribute(&cus, hipDeviceAttributeMultiprocessorCount, dev) != hipSuccess) { grid = -1; return; }
        if (hipFuncSetAttribute((const void*)mk_fwd, hipFuncAttributeMaxDynamicSharedMemorySize, LDS_BYTES) != hipSuccess) { fprintf(stderr, "kernel_launch: hipFuncSetAttribute failed\n"); grid = -1; return; }
        if (hipOccupancyMaxActiveBlocksPerMultiprocessor(&per_cu, (const void*)mk_fwd, 512, LDS_BYTES) != hipSuccess || per_cu < 1) { fprintf(stderr, "kernel_launch: occupancy query says %d blocks per CU\n", per_cu); grid = -1; return; }
        grid = cus;
    }
    if (grid < 0) return;
    Args a{};
    for (int i = 0; i < 21; ++i) a.in[i] = (const float*)d_in[i];
    a.out = (float*)d_out; a.ws = (unsigned char*)d_ws;
#if MK_PER_PHASE
    for (int ph = 0; ph < NPH; ++ph) { a.ph_lo = ph; a.ph_hi = ph + 1; hipLaunchKernelGGL(mk_fwd, dim3(grid), dim3(512), LDS_BYTES, stream, a); }
#else
    a.ph_lo = 0; a.ph_hi = NPH;
    void* args[] = {&a};
    const hipError_t e = hipLaunchCooperativeKernel((const void*)mk_fwd, dim3(grid), dim3(512), args, LDS_BYTES, stream);
    if (e != hipSuccess) fprintf(stderr, "kernel_launch: cooperative launch failed: %s (grid %d)\n", hipGetErrorString(e), grid);
#endif
}
```

```cpp
#include <hip/hip_runtime.h>
#include <hip/hip_bf16.h>
#include <hip/hip_cooperative_groups.h>
#include <cstdio>
#include <cstdint>
namespace cg = cooperative_groups;
__device__ __forceinline__ int mk_lane_() { int l; asm volatile("v_mbcnt_lo_u32_b32 %0, -1, 0\n\tv_mbcnt_hi_u32_b32 %0, -1, %0" : "=v"(l)); return l; }
#define MK_LANE() mk_lane_()
#define MK_TID (mk_wid * 64 + MK_LANE())
namespace pg8 {
#define PG8_LAS __attribute__((address_space(3)))
typedef unsigned short bf16_t;
typedef short bf16x8 __attribute__((ext_vector_type(8)));
typedef float f32x4 __attribute__((ext_vector_type(4)));
typedef unsigned u32x4 __attribute__((ext_vector_type(4)));
constexpr int BM = 256, BK = 64, HALF = 128, HTB = HALF * BK * 2  , STAGE_BYTES = 8 * HTB, NXCD = 8, WGM = 4  ;

__host__ __device__ __forceinline__ int lds_byte(int r, int c) { const int st = (r >> 4) * 2 + (c >> 5), rr = r & 15, cc = c & 31, ob = rr * 64 + cc * 2; return st * 1024 + (ob ^ (((ob >> 9) & 1) << 5)); }
__host__ __device__ __forceinline__ void stage_rc(int b, int& R, int& C) { const int st = b / 1024, sb = b % 1024, swz = sb ^ (((sb >> 9) & 1) << 5); R = (st >> 1) * 16 + swz / 64; C = (st & 1) * 32 + (swz % 64) / 2; }
__host__ __device__ __forceinline__ int perm32(int rho) { const int n = rho >> 4, i = rho & 15; return 8 * (i >> 2) + 4 * n + (i & 3); }

struct Unit { int pm, pn; };
struct Gemm { const bf16_t* A; const bf16_t* Bt; int M, N, K; };

struct StaticOrder {
    int nM, nN, nwg, G, c, wgm;
    __host__ __device__ void init(int M, int N, int G_, int c_, int wgm_ = WGM) { nM = M / BM; nN = N / BM; nwg = nM * nN; G = G_; c = c_; wgm = wgm_; }
    __host__ __device__ bool next(int i, Unit& u) const {
        const long L = (long)i * G + c; if (L >= nwg) return false;
        int wgid = (int)L; { const int q = nwg / NXCD, r = nwg % NXCD, xcd = wgid % NXCD, off = wgid / NXCD; wgid = (xcd < r ? xcd * (q + 1) : r * (q + 1) + (xcd - r) * q) + off; }
        const int nig = wgm * nN, gid = wgid / nig, fm = gid * wgm, gsz = (nM - fm) < wgm ? (nM - fm) : wgm;
        u.pm = fm + ((wgid % nig) % gsz); u.pn = (wgid % nig) / gsz; return true;
    }
    __device__ __forceinline__ void a_ready(const Unit&) const {}
    __device__ __forceinline__ void done(const Unit&) const {}
};

__device__ __forceinline__ unsigned cvt_pk_bf16(float lo, float hi) { unsigned r; asm volatile("v_cvt_pk_bf16_f32 %0, %1, %2" : "=v"(r) : "v"(lo), "v"(hi)); return r; }
typedef float f32x2 __attribute__((ext_vector_type(2)));
template <class Epi, class Sched, bool ALIGN_EPI = false, bool SP2 = false>
__device__ __forceinline__ void gemm_phase(PG8_LAS unsigned char* lds, const Gemm g, const Sched& S, const Epi& E, const int mk_wid) {
    const int tid = MK_TID, wid = mk_wid, lane = tid & 63, wr = wid >> 2, wc = wid & 3, fr = lane & 15, fq = lane >> 4;
    const int K = g.K, nt = K / BK;
    unsigned voffA[2], voffB[2];
#pragma unroll
    for (int i = 0; i < 2; ++i) { int R, C; stage_rc(tid * 16 + i * 8192, R, C); const int Rb = Epi::PERM ? ((R & ~31) + perm32(R & 31)) : R;
        voffA[i] = (unsigned)(R * K + C) * 2u; voffB[i] = (unsigned)(Rb * K + C) * 2u; }
    const size_t kstep = (size_t)(BK * 2);
    const size_t hstep = (size_t)HALF * K * 2;
    const size_t tstep = 2 * hstep;
    const unsigned ldsw = (unsigned)wid * 1024u;
    const int aoff = lds_byte(wr * 64 + fr, fq * 8), boff = lds_byte(wc * 32 + fr, fq * 8);
#define PG8_SA(b, h) (((b) * 2 + (h)) * HTB)
#define PG8_SB(b, h) ((4 + (b) * 2 + (h)) * HTB)
#define PG8_STAGE(bufoff, gbase, voff) do { _Pragma("unroll") for (int _i = 0; _i < 2; ++_i) \
        __builtin_amdgcn_global_load_lds((const unsigned*)((const char*)(gbase) + (voff)[_i]), (PG8_LAS unsigned*)(lds + (bufoff) + ldsw + _i * 8192), 16, 0, 0); } while (0)
#define PG8_LDA(dst, b, h) do { _Pragma("unroll") for (int m = 0; m < 4; ++m) _Pragma("unroll") for (int k = 0; k < 2; ++k) dst[m][k] = *(const PG8_LAS bf16x8*)(lds + PG8_SA(b, h) + aoff + m * 2048 + k * 1024); } while (0)
#define PG8_LDB(dst, b, h) do { _Pragma("unroll") for (int n = 0; n < 2; ++n) _Pragma("unroll") for (int k = 0; k < 2; ++k) dst[n][k] = *(const PG8_LAS bf16x8*)(lds + PG8_SB(b, h) + boff + n * 2048 + k * 1024); } while (0)
#define PG8_MMA(ai, bj, At, Bt) do { __builtin_amdgcn_s_setprio(1); _Pragma("unroll") for (int m = 0; m < 4; ++m) _Pragma("unroll") for (int n = 0; n < 2; ++n) _Pragma("unroll") for (int k = 0; k < 2; ++k) \
        acc[ai][bj][m][n] = __builtin_amdgcn_mfma_f32_16x16x32_bf16(Bt[n][k], At[m][k], acc[ai][bj][m][n], 0, 0, 0); __builtin_amdgcn_s_setprio(0); } while (0)
#define PG8_WAIT_V(n) asm volatile("s_waitcnt vmcnt(" #n ")" ::: "memory")
#define PG8_WAIT_L(n) asm volatile("s_waitcnt lgkmcnt(" #n ")" ::: "memory")
#define PG8_BAR __builtin_amdgcn_s_barrier()
#define PG8_SCHED __builtin_amdgcn_sched_barrier(0)
    Unit cur, nxt; int ui = 0;
    if (!S.next(0, cur)) return;
    f32x4 acc[2][2][4][2];
#pragma unroll
    for (int a = 0; a < 2; ++a)
#pragma unroll
        for (int b = 0; b < 2; ++b)
#pragma unroll
            for (int m = 0; m < 4; ++m)
#pragma unroll
                for (int n = 0; n < 2; ++n) acc[a][b][m][n] = (f32x4){0.f, 0.f, 0.f, 0.f};
    bf16x8 At[4][2], B0[2][2], B1[2][2];
    const char* cA = (const char*)g.A + (size_t)cur.pm * tstep; const char* cB = (const char*)g.Bt + (size_t)cur.pn * tstep;
    S.a_ready(cur);
    if constexpr (SP2) {
        PG8_STAGE(PG8_SB(0, 0), cB, voffB); PG8_STAGE(PG8_SB(0, 1), cB + hstep, voffB); PG8_STAGE(PG8_SA(0, 0), cA, voffA); PG8_STAGE(PG8_SA(0, 1), cA + hstep, voffA);
        if (wr == 1) PG8_BAR;
        PG8_WAIT_V(2); PG8_BAR;
        PG8_STAGE(PG8_SB(1, 0), cB + kstep, voffB); PG8_STAGE(PG8_SA(1, 0), cA + kstep, voffA); PG8_STAGE(PG8_SB(1, 1), cB + hstep + kstep, voffB);
        PG8_WAIT_V(6); PG8_BAR;
    } else {
        PG8_STAGE(PG8_SB(0, 0), cB, voffB); PG8_STAGE(PG8_SA(0, 0), cA, voffA); PG8_STAGE(PG8_SB(0, 1), cB + hstep, voffB); PG8_STAGE(PG8_SA(0, 1), cA + hstep, voffA);
        if (wr == 1) PG8_BAR;
        PG8_WAIT_V(4); PG8_BAR;
        PG8_STAGE(PG8_SB(1, 0), cB + kstep, voffB); PG8_STAGE(PG8_SA(1, 0), cA + kstep, voffA); PG8_STAGE(PG8_SB(1, 1), cB + hstep + kstep, voffB);
        PG8_WAIT_V(6); PG8_BAR;
    }
    for (;;) {
        const bool has_next = S.next(ui + 1, nxt);
        const char* nA = has_next ? (const char*)g.A + (size_t)nxt.pm * tstep : cA; const char* nB = has_next ? (const char*)g.Bt + (size_t)nxt.pn * tstep : cB;
        for (int t = 0; t < nt; t += 2) {
            const bool last = (t == nt - 2);
            const char* a1 = cA + (size_t)(t + 1) * kstep;
            const char* a2 = last ? nA : cA + (size_t)(t + 2) * kstep; const char* b2 = last ? nB : cB + (size_t)(t + 2) * kstep;
            const char* a3 = a2 + kstep; const char* b3 = b2 + kstep;
            if (last && has_next) S.a_ready(nxt);
            if constexpr (SP2) {
            PG8_LDB(B0, 0, 0); PG8_LDB(B1, 0, 1); PG8_SCHED; PG8_LDA(At, 0, 0); PG8_STAGE(PG8_SA(1, 1), a1 + hstep, voffA);
            PG8_WAIT_V(8); PG8_WAIT_L(0); PG8_BAR; PG8_MMA(0, 0, At, B0); PG8_MMA(0, 1, At, B1); PG8_BAR; PG8_SCHED;
            PG8_LDA(At, 0, 1); PG8_STAGE(PG8_SB(0, 0), b2, voffB); PG8_STAGE(PG8_SB(0, 1), b2 + hstep, voffB); PG8_STAGE(PG8_SA(0, 0), a2, voffA);
            PG8_WAIT_V(8); PG8_WAIT_L(0); PG8_BAR; PG8_MMA(1, 0, At, B0); PG8_MMA(1, 1, At, B1); PG8_BAR; PG8_SCHED;
            PG8_LDB(B0, 1, 0); PG8_LDB(B1, 1, 1); PG8_SCHED; PG8_LDA(At, 1, 0); PG8_STAGE(PG8_SA(0, 1), a2 + hstep, voffA);
            PG8_WAIT_V(8); PG8_WAIT_L(0); PG8_BAR; PG8_MMA(0, 0, At, B0); PG8_MMA(0, 1, At, B1); PG8_BAR; PG8_SCHED;
            PG8_LDA(At, 1, 1); PG8_STAGE(PG8_SB(1, 0), b3, voffB); PG8_STAGE(PG8_SB(1, 1), b3 + hstep, voffB); PG8_STAGE(PG8_SA(1, 0), a3, voffA);
            PG8_WAIT_V(8); PG8_WAIT_L(0); PG8_BAR; PG8_MMA(1, 0, At, B0); PG8_MMA(1, 1, At, B1); PG8_BAR; PG8_SCHED;
            } else {
            PG8_LDB(B0, 0, 0); PG8_SCHED; PG8_LDA(At, 0, 0); PG8_STAGE(PG8_SA(1, 1), a1 + hstep, voffA);
            PG8_WAIT_L(8); PG8_BAR; PG8_WAIT_L(0); PG8_MMA(0, 0, At, B0); PG8_BAR; PG8_SCHED;
            PG8_LDB(B1, 0, 1); PG8_STAGE(PG8_SB(0, 0), b2, voffB);
            PG8_BAR; PG8_WAIT_L(0); PG8_MMA(0, 1, At, B1); PG8_BAR;
            PG8_LDA(At, 0, 1); PG8_STAGE(PG8_SA(0, 0), a2, voffA);
            PG8_BAR; PG8_WAIT_L(0); PG8_MMA(1, 0, At, B0); PG8_BAR; PG8_SCHED;
            PG8_STAGE(PG8_SB(0, 1), b2 + hstep, voffB);
            PG8_WAIT_V(6); PG8_BAR; PG8_MMA(1, 1, At, B1); PG8_BAR;
            PG8_LDB(B0, 1, 0); PG8_SCHED; PG8_LDA(At, 1, 0); PG8_STAGE(PG8_SA(0, 1), a2 + hstep, voffA);
            PG8_WAIT_L(8); PG8_BAR; PG8_WAIT_L(0); PG8_MMA(0, 0, At, B0); PG8_BAR; PG8_SCHED;
            PG8_LDB(B1, 1, 1); PG8_STAGE(PG8_SB(1, 0), b3, voffB);
            PG8_BAR; PG8_WAIT_L(0); PG8_MMA(0, 1, At, B1); PG8_BAR;
            PG8_LDA(At, 1, 1); PG8_STAGE(PG8_SA(1, 0), a3, voffA);
            PG8_BAR; PG8_WAIT_L(0); PG8_MMA(1, 0, At, B0); PG8_BAR; PG8_SCHED;
            PG8_STAGE(PG8_SB(1, 1), b3 + hstep, voffB);
            PG8_WAIT_V(6); PG8_BAR; PG8_MMA(1, 1, At, B1); PG8_BAR;
            }
        }
        if constexpr (ALIGN_EPI) { if (wr == 0) PG8_BAR; }
        if constexpr (!Epi::AFTER_DRAIN) { E(acc, cur, wr, wc, fr, fq); S.done(cur); }
        if (!has_next) break;
#pragma unroll
        for (int a = 0; a < 2; ++a)
#pragma unroll
            for (int b = 0; b < 2; ++b)
#pragma unroll
                for (int m = 0; m < 4; ++m)
#pragma unroll
                    for (int n = 0; n < 2; ++n) acc[a][b][m][n] = (f32x4){0.f, 0.f, 0.f, 0.f};
        cur = nxt; cA = nA; cB = nB; ++ui;
        if constexpr (ALIGN_EPI) { if (wr == 1) PG8_BAR; }
    }
    PG8_WAIT_V(0);
    if constexpr (!ALIGN_EPI) { if (wr == 0) PG8_BAR; }
    PG8_BAR;
    if constexpr (Epi::AFTER_DRAIN) { E.fused(acc, cur, wr, wc, fr, fq, lds, wid, lane); S.done(cur); }
#undef PG8_SA
#undef PG8_SB
#undef PG8_STAGE
#undef PG8_LDA
#undef PG8_LDB
#undef PG8_MMA
#undef PG8_WAIT_V
#undef PG8_WAIT_L
#undef PG8_BAR
#undef PG8_SCHED
}
}
namespace att {
using bf16 = __hip_bfloat16;
constexpr int   D = 128, NW = 8, QBLK = 32, KVBLK = 64;
constexpr float SCALE = 0.088388347648318440f;
constexpr float THR = 8.f;
constexpr int LDQ = 1024, LDK = 256, LDO = 1024;
constexpr size_t SHM_V = KVBLK * D * 2, SHM_K = KVBLK * D * 2, SHM_ATTN = 2 * SHM_V + 2 * SHM_K + NW * 64 * 4;
using bf16x8 = __attribute__((ext_vector_type(8))) short;
using s16x4  = __attribute__((ext_vector_type(4))) short;
using f32x16 = __attribute__((ext_vector_type(16))) float;
using f32x8  = __attribute__((ext_vector_type(8))) float;
using u32x4  = __attribute__((ext_vector_type(4))) unsigned;
#define KSWZ(row, colB) ((row) * 256 + ((colB) ^ (((row) & 7) << 4)))
#define SBAR() __builtin_amdgcn_sched_barrier(0)
__device__ __forceinline__ int crow(int r, int hi) { return (r & 3) + 8 * (r >> 2) + 4 * hi; }
__device__ __forceinline__ unsigned cvtpk(float lo, float hi) {
  unsigned r; asm volatile("v_cvt_pk_bf16_f32 %0, %1, %2" : "=v"(r) : "v"(lo), "v"(hi)); return r;
}
template <typename TIn> struct Stage;
template <> struct Stage<bf16>  { using T = bf16x8;
  __device__ static __forceinline__ T ld8(const bf16* p) { return *reinterpret_cast<const bf16x8*>(p); }
  __device__ static __forceinline__ bf16x8 tobf(T x) { return x; } };
template <> struct Stage<float> { using T = f32x8;
  __device__ static __forceinline__ T ld8(const float* p) { return *reinterpret_cast<const f32x8*>(p); }
  __device__ static __forceinline__ bf16x8 tobf(T x) {
    u32x4 w = {cvtpk(x[0], x[1]), cvtpk(x[2], x[3]), cvtpk(x[4], x[5]), cvtpk(x[6], x[7])}; return *reinterpret_cast<bf16x8*>(&w); } };

__device__ __forceinline__ void partialSM(f32x16& p0, f32x16& p1, float& m_reg, float& mn, float& alpha) {
  constexpr float C = SCALE * 1.4426950408889634f;
  float pmax = p0[0]; for (int r = 1; r < 16; ++r) pmax = fmaxf(pmax, p0[r]); for (int r = 0; r < 16; ++r) pmax = fmaxf(pmax, p1[r]);
  { auto rr = __builtin_amdgcn_permlane32_swap(__float_as_uint(pmax), __float_as_uint(pmax), false, false);
    pmax = fmaxf(__uint_as_float(rr[0]), __uint_as_float(rr[1])); }
  if (__builtin_expect(__all(pmax - m_reg <= THR / SCALE), 1)) { mn = m_reg; alpha = 1.f; }
  else { mn = fmaxf(m_reg, pmax); alpha = __builtin_amdgcn_exp2f((m_reg - mn) * C); m_reg = mn; }
  float mnC = -mn * C;
  for (int r = 0; r < 16; ++r) p0[r] = fmaf(p0[r], C, mnC); for (int r = 0; r < 16; ++r) p1[r] = fmaf(p1[r], C, mnC);
  for (int r = 0; r < 16; ++r) p0[r] = __builtin_amdgcn_exp2f(p0[r]);
}
__device__ __forceinline__ void finishSM(f32x16& p0, f32x16& p1, float alpha, float& l_reg, bf16x8& pa0, bf16x8& pa1, bf16x8& pa2, bf16x8& pa3) {
  for (int r = 0; r < 16; ++r) p1[r] = __builtin_amdgcn_exp2f(p1[r]);
  float ps = 0; for (int r = 0; r < 16; ++r) ps += p0[r]; for (int r = 0; r < 16; ++r) ps += p1[r];
  { auto rr = __builtin_amdgcn_permlane32_swap(__float_as_uint(ps), __float_as_uint(ps), false, false);
    ps = __uint_as_float(rr[0]) + __uint_as_float(rr[1]); }
  l_reg = l_reg * alpha + ps;
#define PK4(P, BASE, OUT) do { unsigned a0 = cvtpk(P[BASE + 0], P[BASE + 1]), a1 = cvtpk(P[BASE + 2], P[BASE + 3]);   \
    unsigned b0 = cvtpk(P[BASE + 4], P[BASE + 5]), b1 = cvtpk(P[BASE + 6], P[BASE + 7]);                              \
    auto r0 = __builtin_amdgcn_permlane32_swap(a0, b0, false, false); auto r1 = __builtin_amdgcn_permlane32_swap(a1, b1, false, false); \
    u32x4 w = {r0[0], r1[0], r0[1], r1[1]}; OUT = *reinterpret_cast<bf16x8*>(&w); } while (0)
  PK4(p0, 0, pa0); PK4(p0, 8, pa1); PK4(p1, 0, pa2); PK4(p1, 8, pa3);
#undef PK4
}
__device__ __forceinline__ void qkt(f32x16& p0, f32x16& p1, const bf16* Ks, const bf16x8* qr, int r32, int hi) {
  p0 = f32x16{}; p1 = f32x16{};
  for (int d0 = 0; d0 < 8; ++d0) { int cb = (d0 * 16 + hi * 8) * 2;
    bf16x8 b0 = *reinterpret_cast<const bf16x8*>((const char*)Ks + KSWZ(r32, cb));
    bf16x8 b1 = *reinterpret_cast<const bf16x8*>((const char*)Ks + KSWZ(32 + r32, cb));
    p0 = __builtin_amdgcn_mfma_f32_32x32x16_bf16(b0, qr[d0], p0, 0, 0, 0);
    p1 = __builtin_amdgcn_mfma_f32_32x32x16_bf16(b1, qr[d0], p1, 0, 0, 0); }
}
__device__ __forceinline__ int v_st(int k, int c) { const int kk = (k & ~0xC) | ((k & 4) << 1) | ((k & 8) >> 1); return ((kk >> 3) * 4 + (c >> 5)) * 512 + ((kk & 7) * 32 + (c & 31)) * 2; }
__device__ __forceinline__ int v_rd_base(int lane) { return ((lane & 3) << 3) | (((lane >> 2) & 3) << 6) | (((lane >> 4) & 1) << 5) | (((lane >> 5) & 1) << 8); }
constexpr int v_rd_off(int d0, int ks, int half) { return d0 * 512 + ks * 4096 + half * 2048; }
template <int OFF> __device__ __forceinline__ s16x4 tr_read(int vb) {
  s16x4 r; asm volatile("ds_read_b64_tr_b16 %0, %1 offset:%2" : "=&v"(r) : "v"(vb), "i"(OFF) : "memory"); return r;
}
template <int D0> __device__ __forceinline__ void pv_one(f32x16& od, int vb, bf16x8 pa0, bf16x8 pa1, bf16x8 pa2, bf16x8 pa3) {
  const s16x4 l0 = tr_read<v_rd_off(D0, 0, 0)>(vb), h0 = tr_read<v_rd_off(D0, 0, 1)>(vb), l1 = tr_read<v_rd_off(D0, 1, 0)>(vb), h1 = tr_read<v_rd_off(D0, 1, 1)>(vb);
  const s16x4 l2 = tr_read<v_rd_off(D0, 2, 0)>(vb), h2 = tr_read<v_rd_off(D0, 2, 1)>(vb), l3 = tr_read<v_rd_off(D0, 3, 0)>(vb), h3 = tr_read<v_rd_off(D0, 3, 1)>(vb);
  asm volatile("s_waitcnt lgkmcnt(0)" ::: "memory"); SBAR();
#define PK(L, H) (bf16x8){L[0], L[1], L[2], L[3], H[0], H[1], H[2], H[3]}
  od = __builtin_amdgcn_mfma_f32_32x32x16_bf16(pa0, PK(l0, h0), od, 0, 0, 0);
  od = __builtin_amdgcn_mfma_f32_32x32x16_bf16(pa1, PK(l1, h1), od, 0, 0, 0);
  od = __builtin_amdgcn_mfma_f32_32x32x16_bf16(pa2, PK(l2, h2), od, 0, 0, 0);
  od = __builtin_amdgcn_mfma_f32_32x32x16_bf16(pa3, PK(l3, h3), od, 0, 0, 0);
#undef PK
}
__device__ __forceinline__ void pv_d0(f32x16* o, int vb, bf16x8 pa0, bf16x8 pa1, bf16x8 pa2, bf16x8 pa3) {
  pv_one<0>(o[0], vb, pa0, pa1, pa2, pa3); pv_one<1>(o[1], vb, pa0, pa1, pa2, pa3); pv_one<2>(o[2], vb, pa0, pa1, pa2, pa3); pv_one<3>(o[3], vb, pa0, pa1, pa2, pa3);
}
__device__ __forceinline__ float bf2f(short s) { return __uint_as_float(((unsigned)(unsigned short)s) << 16); }
__device__ __forceinline__ void attn_unit(const bf16* Qb, const bf16* __restrict__ Kh, const bf16* __restrict__ Vh, bf16* Ob, int seq, char* lds,
                                          const float* __restrict__ rope, const float* __restrict__ qg, const int mk_wid) {
  using St = Stage<bf16>;
  int tid = MK_TID; asm volatile("" : "+v"(tid));
  const int wid = mk_wid, lane = tid & 63, r32 = lane & 31, hi = lane >> 5;
  bf16* V_lds = (bf16*)lds; bf16* K_lds = (bf16*)(lds + 2 * SHM_V);
  float* ws = (float*)(lds + 2 * SHM_V + 2 * SHM_K) + wid * 64; float* li_l = ws; float* al_l = ws + 32;
  float m_reg = -1e30f, l_reg = 0; f32x16 o[4] = {}; bf16x8 qr[8];
  const int sr = tid >> 4, sc = (tid & 15) * 8, vst0 = v_st(sr, sc), vst1 = v_st(32 + sr, sc);
  const int vb0 = (int)(uintptr_t)V_lds + v_rd_base(lane);
  struct { typename St::T vs0, vs1, ks0, ks1; } sr_[2];
#define SLOAD(i, k0) do { sr_[i].vs0 = St::ld8(&Vh[(long)((k0) + sr) * LDK + sc]); sr_[i].vs1 = St::ld8(&Vh[(long)((k0) + 32 + sr) * LDK + sc]); \
    sr_[i].ks0 = St::ld8(&Kh[(long)((k0) + sr) * LDK + sc]); sr_[i].ks1 = St::ld8(&Kh[(long)((k0) + 32 + sr) * LDK + sc]); } while (0)
#define SWRITE(b, i) do { *(bf16x8*)((char*)V_lds + (b) * SHM_V + vst0) = St::tobf(sr_[i].vs0);          \
    *(bf16x8*)((char*)V_lds + (b) * SHM_V + vst1) = St::tobf(sr_[i].vs1); int kc = sc * 2;               \
    *(bf16x8*)((char*)K_lds + (b) * SHM_K + KSWZ(sr, kc)) = St::tobf(sr_[i].ks0);                       \
    *(bf16x8*)((char*)K_lds + (b) * SHM_K + KSWZ(32 + sr, kc)) = St::tobf(sr_[i].ks1); } while (0)
#define SWAIT() do { asm volatile("s_waitcnt vmcnt(4)" ::: "memory"); } while (0)
#define RESC(a) do { if (__any((a) < 1.f)) { if (hi == 0) al_l[r32] = (a); asm volatile("s_waitcnt lgkmcnt(0)" ::: "memory"); \
    for (int d = 0; d < 4; ++d) for (int r = 0; r < 16; ++r) o[d][r] *= al_l[crow(r, hi)]; } } while (0)
  constexpr int SE = 0, SO = 1;
  {
    int tp = MK_TID; asm volatile("" : "+v"(tp)); const int r32 = tp & 31, hi = (tp >> 5) & 1;
    const bf16* Qw = Qb + (long)(wid * QBLK + r32) * LDQ + hi * 8;
    const float* rp = rope + ((long)(wid * QBLK + r32) * 64 + hi * 4) * 2;
    bf16x8 rw[8]; float4 gA[8], gB[8], cA[8], cB[8];
#pragma unroll
    for (int d0 = 0; d0 < 8; ++d0) { rw[d0] = *reinterpret_cast<const bf16x8*>(Qw + d0 * 16);
      gA[d0] = *reinterpret_cast<const float4*>(qg + d0 * 16 + hi * 8); gB[d0] = *reinterpret_cast<const float4*>(qg + d0 * 16 + hi * 8 + 4);
      cA[d0] = *reinterpret_cast<const float4*>(rp + d0 * 16); cB[d0] = *reinterpret_cast<const float4*>(rp + d0 * 16 + 4); }
    float ss = 0.f;
#pragma unroll
    for (int d0 = 0; d0 < 8; ++d0)
#pragma unroll
      for (int e = 0; e < 8; ++e) { const float f = bf2f(rw[d0][e]); ss += f * f; }
    { auto rr = __builtin_amdgcn_permlane32_swap(__float_as_uint(ss), __float_as_uint(ss), false, false); ss = __uint_as_float(rr[0]) + __uint_as_float(rr[1]); }
    const float rinv = rsqrtf(ss * (1.f / 128.f) + 1e-6f);
#pragma unroll
    for (int d0 = 0; d0 < 8; ++d0) {
      const float4 g0 = gA[d0], g1 = gB[d0], cs0 = cA[d0], cs1 = cB[d0];
      const float x0 = bf2f(rw[d0][0]) * rinv * g0.x, x1 = bf2f(rw[d0][1]) * rinv * g0.y, x2 = bf2f(rw[d0][2]) * rinv * g0.z, x3 = bf2f(rw[d0][3]) * rinv * g0.w;
      const float x4 = bf2f(rw[d0][4]) * rinv * g1.x, x5 = bf2f(rw[d0][5]) * rinv * g1.y, x6 = bf2f(rw[d0][6]) * rinv * g1.z, x7 = bf2f(rw[d0][7]) * rinv * g1.w;
      u32x4 w = {cvtpk(x0 * cs0.x - x1 * cs0.y, x0 * cs0.y + x1 * cs0.x), cvtpk(x2 * cs0.z - x3 * cs0.w, x2 * cs0.w + x3 * cs0.z),
                 cvtpk(x4 * cs1.x - x5 * cs1.y, x4 * cs1.y + x5 * cs1.x), cvtpk(x6 * cs1.z - x7 * cs1.w, x6 * cs1.w + x7 * cs1.z)};
      qr[d0] = *reinterpret_cast<bf16x8*>(&w);
    }
  }
  f32x16 pA0, pA1, pB0, pB1; float mnA, mnB, alA, alB; bf16x8 pa0, pa1, pa2, pa3; const int NT = seq / KVBLK;
  SLOAD(SE, 0); asm volatile("s_waitcnt vmcnt(0)" ::: "memory"); SWRITE(0, SE); __syncthreads();
  qkt(pA0, pA1, K_lds, qr, r32, hi); partialSM(pA0, pA1, m_reg, mnA, alA);
  SLOAD(SO, KVBLK); if (2 < NT) SLOAD(SE, 2 * KVBLK);
  SWAIT(); SWRITE(1, SO); __syncthreads();
  for (int j = 1; j + 1 < NT; j += 2) {
    SBAR(); qkt(pB0, pB1, (bf16*)((char*)K_lds + SHM_K), qr, r32, hi);
    finishSM(pA0, pA1, alA, l_reg, pa0, pa1, pa2, pa3); SBAR();
    SLOAD(SO, (j + 2) * KVBLK); SBAR();
    pv_d0(o, vb0, pa0, pa1, pa2, pa3); partialSM(pB0, pB1, m_reg, mnB, alB);
    __syncthreads(); SWAIT(); SWRITE(0, SE);
    RESC(alB); __syncthreads();
    SBAR(); qkt(pA0, pA1, K_lds, qr, r32, hi);
    finishSM(pB0, pB1, alB, l_reg, pa0, pa1, pa2, pa3); SBAR();
    if (j + 3 < NT) SLOAD(SE, (j + 3) * KVBLK); SBAR();
    pv_d0(o, vb0 + (int)SHM_V, pa0, pa1, pa2, pa3); partialSM(pA0, pA1, m_reg, mnA, alA);
    __syncthreads(); SWAIT(); SWRITE(1, SO);
    RESC(alA); __syncthreads();
  }
  SBAR(); qkt(pB0, pB1, (bf16*)((char*)K_lds + SHM_K), qr, r32, hi);
  finishSM(pA0, pA1, alA, l_reg, pa0, pa1, pa2, pa3); SBAR();
  pv_d0(o, vb0, pa0, pa1, pa2, pa3); partialSM(pB0, pB1, m_reg, mnB, alB);
  __syncthreads(); RESC(alB);
  finishSM(pB0, pB1, alB, l_reg, pa0, pa1, pa2, pa3); SBAR();
  pv_d0(o, vb0 + (int)SHM_V, pa0, pa1, pa2, pa3);
  if (hi == 0) li_l[r32] = l_reg; asm volatile("s_waitcnt lgkmcnt(0)" ::: "memory");
  float rli[16];
#pragma unroll
  for (int r = 0; r < 16; ++r) rli[r] = __builtin_amdgcn_rcpf(li_l[crow(r, hi)]);
  __syncthreads();
  { int te = MK_TID; asm volatile("" : "+v"(te)); const int lane = te & 63, r32 = lane & 31, hi = lane >> 5;
    unsigned short* stg = (unsigned short*)(lds + wid * 8192);
#pragma unroll
    for (int r = 0; r < 16; ++r) { const int orow = crow(r, hi);
#pragma unroll
      for (int d0 = 0; d0 < 4; ++d0) stg[orow * 128 + d0 * 32 + r32] = (unsigned short)(cvtpk(o[d0][r] * rli[r], 0.f) & 0xffffu); }
    asm volatile("s_waitcnt lgkmcnt(0)" ::: "memory");
    bf16* Ow = Ob + (long)(wid * QBLK) * LDO;
#pragma unroll
    for (int i = 0; i < 8; ++i) { const int row = i * 4 + (lane >> 4), ch = lane & 15; const u32x4 v = *(const u32x4*)(stg + row * 128 + ch * 8); *(u32x4*)(Ow + (long)row * LDO + ch * 8) = v; } }
  __syncthreads();
#undef SLOAD
#undef SWRITE
#undef SWAIT
#undef RESC
}
}
constexpr int NB = 16, T = 2048, TC = 256, TA = T + TC, DM = 1024;
constexpr int MLAT = NB * T, MALL = NB * TA;
constexpr int NIN = 6912;
constexpr int DFF = 2816;
constexpr float EPS = 1e-6f;
constexpr size_t MiB = 1u << 20;
constexpr size_t WS_MOD = 1 * MiB, WS_ROPE = 2 * MiB, WS_WIN = 4 * MiB, WS_WAP = 18 * MiB, WS_WGP = 20 * MiB, WS_WOUT = 22 * MiB, WS_WFI = 24 * MiB, WS_WFO = 36 * MiB,
                 WS_H1 = 42 * MiB, WS_Q = 114 * MiB, WS_K = 178 * MiB, WS_V = 196 * MiB, WS_GQ = 214 * MiB, WS_GK = 250 * MiB, WS_GV = 286 * MiB, WS_GG = 358 * MiB,
                 WS_LR = 422 * MiB, WS_OB = 426 * MiB, WS_END = 490 * MiB;
constexpr size_t WS_OF = WS_H1, WS_T1 = WS_GQ  , WS_H2 = WS_H1, WS_MRG = WS_GV, WS_ACT = WS_Q, WS_X1 = WS_OB  ;
constexpr int LDS_BYTES = 147456;
constexpr int NPH = 11;
constexpr int WI_IN = 16 * 216, WI_PROJ = WI_IN + 3 * 16 * 32, WI_ALL = WI_PROJ + 16 * 176 + 44 * 32;

typedef unsigned short u16;
typedef unsigned v4u __attribute__((ext_vector_type(4)));
typedef unsigned v2u __attribute__((ext_vector_type(2)));
typedef float f32x4 __attribute__((ext_vector_type(4)));
#define LAS __attribute__((address_space(3)))

struct Args { const float* in[21]; float* out; unsigned char* ws; int ph_lo, ph_hi; };

__device__ __forceinline__ float bf2f(u16 u) { return __uint_as_float((unsigned)u << 16); }
typedef float f32x2_t __attribute__((ext_vector_type(2))); typedef __bf16 bf16x2_t __attribute__((ext_vector_type(2)));
__device__ __forceinline__ unsigned pk2(float lo, float hi) { f32x2_t v = {lo, hi}; bf16x2_t b = __builtin_convertvector(v, bf16x2_t); return __builtin_bit_cast(unsigned, b); }
__device__ __forceinline__ u16 f2bf(float f) { return (u16)(pk2(f, 0.f) & 0xffffu); }
__device__ __forceinline__ float wave_sum(float v) {
#pragma unroll
    for (int o = 1; o < 64; o <<= 1) v += __shfl_xor(v, o);
    return v;
}
__device__ __forceinline__ float sigmoidf_(float x) { return __builtin_amdgcn_rcpf(1.f + __expf(-x)); }

struct EpiInProj {
    static constexpr bool PERM = true, AFTER_DRAIN = false;
    unsigned char* ws; u16* MG;
    __device__ __forceinline__ void operator()(const pg8::f32x4 (&acc)[2][2][4][2], const pg8::Unit& u, int wr, int wc, int fr, int fq) const {
        const int b = u.pm / 9, j = u.pm % 9, pn = u.pn; const bool isctx = (j == 0);
        const long rall = (long)u.pm * 256, rlat = (long)b * T + (j - 1) * 256;
        u16* base; int ld, colt; long row0;
        if (pn < 4)       { if (isctx) return; base = (u16*)(ws + WS_Q);  ld = 1024; colt = pn * 256;        row0 = rlat; }
        else if (pn == 4) {                    base = (u16*)(ws + WS_K);  ld = 256;  colt = 0;               row0 = rall; }
        else if (pn == 5) {                    base = (u16*)(ws + WS_V);  ld = 256;  colt = 0;               row0 = rall; }
        else if (pn < 8)  { if (isctx) return; base = (u16*)(ws + WS_GQ); ld = 512;  colt = (pn - 6) * 256;  row0 = rall; }
        else if (pn < 10) {                    base = (u16*)(ws + WS_GK); ld = 512;  colt = (pn - 8) * 256;  row0 = rall; }
        else if (pn < 14) {                    base = (u16*)(ws + WS_GV); ld = 1024; colt = (pn - 10) * 256; row0 = rall; }
        else if (pn < 18) { if (isctx) return; base = (u16*)(ws + WS_GG); ld = 1024; colt = (pn - 14) * 256; row0 = rlat; }
        else if (pn < 26) { if (isctx) return; base = MG;                 ld = 2048; colt = (pn - 18) * 256; row0 = rlat; }
        else              {                    base = (u16*)(ws + WS_LR); ld = 32;   colt = 0;               row0 = rall; }
        const bool lr = (pn == 26);
        if (lr && wc != 0) return;
        const int col0 = colt + wc * 32 + 8 * fq;
#pragma unroll
        for (int ai = 0; ai < 2; ++ai)
#pragma unroll
            for (int m = 0; m < 4; ++m) { u16* rowp = base + (size_t)(row0 + ai * 128 + wr * 64 + m * 16 + fr) * ld + col0;
#pragma unroll
                for (int bj = 0; bj < 2; ++bj) { if (lr && bj) continue;
                    const pg8::f32x4 v0 = acc[ai][bj][m][0], v1 = acc[ai][bj][m][1];
                    v4u w; w.x = pk2(v0[0], v0[1]); w.y = pk2(v0[2], v0[3]); w.z = pk2(v1[0], v1[1]); w.w = pk2(v1[2], v1[3]);
                    *(v4u*)(rowp + bj * 128) = w; } }
    }
};
struct InProjOrder {
    pg8::StaticOrder so; int G, c;
    __device__ void init(int G_, int c_) { so.init(128 * 256, 26 * 256, G_, c_); G = G_; c = c_; }
    __device__ bool next(int i, pg8::Unit& u) const {
        if (so.next(i, u)) { u.pm = (u.pm >> 3) * 9 + 1 + (u.pm & 7); return true; }
        const long q = (long)i * G + c - 3328; if (q < 0 || q >= 128) return false;
        const int b = (int)(q >> 3), t = (int)(q & 7);
        u.pm = b * 9; u.pn = t == 0 ? 4 : (t == 1 ? 5 : (t < 4 ? 6 + t : 6 + t)); return true;
    }
    __device__ __forceinline__ void a_ready(const pg8::Unit&) const {}
    __device__ __forceinline__ void done(const pg8::Unit&) const {}
};
template <int MODE> struct EpiMerge {
    static constexpr bool PERM = true, AFTER_DRAIN = false;
    const u16* MG; u16* T1; u16* MRG;
    __device__ __forceinline__ void operator()(const pg8::f32x4 (&acc)[2][2][4][2], const pg8::Unit& u, int wr, int wc, int fr, int fq) const {
        const int col0 = u.pn * 256 + wc * 32 + 8 * fq;
#pragma unroll
        for (int ai = 0; ai < 2; ++ai) {
            v4u gwv[4][2], twv[4][2];
#pragma unroll
            for (int m = 0; m < 4; ++m) { const size_t row = (size_t)u.pm * 256 + ai * 128 + wr * 64 + m * 16 + fr;
#pragma unroll
                for (int bj = 0; bj < 2; ++bj) { const int col = col0 + bj * 128;
                    gwv[m][bj] = __builtin_nontemporal_load((const v4u*)(MG + row * 2048 + MODE * 1024 + col));
                    twv[m][bj] = (MODE == 1) ? __builtin_nontemporal_load((const v4u*)(T1 + row * 1024 + col)) : (v4u){0u, 0u, 0u, 0u}; } }
#pragma unroll
            for (int m = 0; m < 4; ++m) { const size_t row = (size_t)u.pm * 256 + ai * 128 + wr * 64 + m * 16 + fr;
#pragma unroll
                for (int bj = 0; bj < 2; ++bj) { const int col = col0 + bj * 128;
                    const pg8::f32x4 v0 = acc[ai][bj][m][0], v1 = acc[ai][bj][m][1];
                    const float r[8] = {v0[0], v0[1], v0[2], v0[3], v1[0], v1[1], v1[2], v1[3]};
                    const unsigned gws[4] = {gwv[m][bj].x, gwv[m][bj].y, gwv[m][bj].z, gwv[m][bj].w};
                    const unsigned tws[4] = {twv[m][bj].x, twv[m][bj].y, twv[m][bj].z, twv[m][bj].w};
                    unsigned ow[4];
#pragma unroll
                    for (int e = 0; e < 4; ++e) {
                        float a0 = sigmoidf_(bf2f((u16)(gws[e] & 0xffffu))) * r[2 * e], a1 = sigmoidf_(bf2f((u16)(gws[e] >> 16))) * r[2 * e + 1];
                        if (MODE == 1) { a0 += bf2f((u16)(tws[e] & 0xffffu)); a1 += bf2f((u16)(tws[e] >> 16)); }
                        ow[e] = pk2(a0, a1); }
                    v4u w = {ow[0], ow[1], ow[2], ow[3]};
                    *(v4u*)((MODE == 0 ? T1 : MRG) + row * 1024 + col) = w; } }
        }
    }
};
struct EpiGateRes {
    static constexpr bool PERM = true, AFTER_DRAIN = false;
    const float* base; float* out; const float* gate;
    __device__ __forceinline__ void operator()(const pg8::f32x4 (&acc)[2][2][4][2], const pg8::Unit& u, int wr, int wc, int fr, int fq) const {
        const int col0 = u.pn * 256 + wc * 32 + 8 * fq; const int b = (u.pm * 256) / T;
        pg8::f32x4 gv[2][2];
#pragma unroll
        for (int bj = 0; bj < 2; ++bj)
#pragma unroll
            for (int n = 0; n < 2; ++n) gv[bj][n] = *(const pg8::f32x4*)(gate + (size_t)b * 6144 + col0 + bj * 128 + n * 4);
#pragma unroll
        for (int ai = 0; ai < 2; ++ai)
#pragma unroll
            for (int m = 0; m < 4; ++m) { const size_t off = ((size_t)u.pm * 256 + ai * 128 + wr * 64 + m * 16 + fr) * DM + col0;
#pragma unroll
                for (int bj = 0; bj < 2; ++bj)
#pragma unroll
                    for (int n = 0; n < 2; ++n) { const pg8::f32x4 bs = *(const pg8::f32x4*)(base + off + bj * 128 + n * 4);
                        *(pg8::f32x4*)(out + off + bj * 128 + n * 4) = bs + gv[bj][n] * acc[ai][bj][m][n]; } }
    }
};
template <bool IN_BF16> struct EpiGateResB {
    static constexpr bool PERM = true, AFTER_DRAIN = false;
    const void* base; void* out; const float* gate;
    __device__ __forceinline__ void operator()(const pg8::f32x4 (&acc)[2][2][4][2], const pg8::Unit& u, int wr, int wc, int fr, int fq) const {
        const int col0 = u.pn * 256 + wc * 32 + 8 * fq; const int b = (u.pm * 256) / T;
        pg8::f32x4 gv[2][2];
#pragma unroll
        for (int bj = 0; bj < 2; ++bj)
#pragma unroll
            for (int n = 0; n < 2; ++n) gv[bj][n] = *(const pg8::f32x4*)(gate + (size_t)b * 6144 + col0 + bj * 128 + n * 4);
#pragma unroll
        for (int ai = 0; ai < 2; ++ai) {
            pg8::f32x4 bs[4][2][2]; v4u bw[4][2];
#pragma unroll
            for (int m = 0; m < 4; ++m) { const size_t off = ((size_t)u.pm * 256 + ai * 128 + wr * 64 + m * 16 + fr) * DM + col0;
#pragma unroll
                for (int bj = 0; bj < 2; ++bj) {
                    if (IN_BF16) bw[m][bj] = __builtin_nontemporal_load((const v4u*)((const u16*)base + off + bj * 128));
                    else { bs[m][bj][0] = __builtin_nontemporal_load((const pg8::f32x4*)((const float*)base + off + bj * 128)); bs[m][bj][1] = __builtin_nontemporal_load((const pg8::f32x4*)((const float*)base + off + bj * 128 + 4)); } } }
#pragma unroll
            for (int m = 0; m < 4; ++m) { const size_t off = ((size_t)u.pm * 256 + ai * 128 + wr * 64 + m * 16 + fr) * DM + col0;
#pragma unroll
                for (int bj = 0; bj < 2; ++bj) {
                    pg8::f32x4 b0, b1;
                    if (IN_BF16) { const v4u w = bw[m][bj];
                        b0 = (pg8::f32x4){bf2f((u16)(w.x & 0xffffu)), bf2f((u16)(w.x >> 16)), bf2f((u16)(w.y & 0xffffu)), bf2f((u16)(w.y >> 16))};
                        b1 = (pg8::f32x4){bf2f((u16)(w.z & 0xffffu)), bf2f((u16)(w.z >> 16)), bf2f((u16)(w.w & 0xffffu)), bf2f((u16)(w.w >> 16))}; }
                    else { b0 = bs[m][bj][0]; b1 = bs[m][bj][1]; }
                    const pg8::f32x4 o0 = b0 + gv[bj][0] * acc[ai][bj][m][0], o1 = b1 + gv[bj][1] * acc[ai][bj][m][1];
                    if (IN_BF16) { *(pg8::f32x4*)((float*)out + off + bj * 128) = o0; *(pg8::f32x4*)((float*)out + off + bj * 128 + 4) = o1; }
                    else { v4u w; w.x = pk2(o0[0], o0[1]); w.y = pk2(o0[2], o0[3]); w.z = pk2(o1[0], o1[1]); w.w = pk2(o1[2], o1[3]); *(v4u*)((u16*)out + off + bj * 128) = w; } } }
        }
    }
};
struct EpiSwiglu {
    static constexpr bool PERM = true, AFTER_DRAIN = false;
    u16* ACT;
    __device__ __forceinline__ void operator()(const pg8::f32x4 (&acc)[2][2][4][2], const pg8::Unit& u, int wr, int wc, int fr, int fq) const {
        const int col0 = u.pn * 128 + wc * 32 + 8 * fq;
#pragma unroll
        for (int ai = 0; ai < 2; ++ai)
#pragma unroll
            for (int m = 0; m < 4; ++m) { const size_t row = (size_t)u.pm * 256 + ai * 128 + wr * 64 + m * 16 + fr;
                unsigned ow[4];
#pragma unroll
                for (int n = 0; n < 2; ++n) { const pg8::f32x4 av = acc[ai][0][m][n], bv = acc[ai][1][m][n];
                    float s[4];
#pragma unroll
                    for (int e = 0; e < 4; ++e) s[e] = av[e] * sigmoidf_(av[e]) * bv[e];
                    ow[2 * n] = pk2(s[0], s[1]); ow[2 * n + 1] = pk2(s[2], s[3]); }
                v4u w = {ow[0], ow[1], ow[2], ow[3]};
                *(v4u*)(ACT + row * DFF + col0) = w; }
    }
};
__device__ __forceinline__ void p_adaln(const Args& a, unsigned char* lds, const int mk_wid) {
    float* sl = (float*)lds;
    float* part = (float*)(lds + 17 * 1024 * 4);
    const int tid = MK_TID;
    const float* c = a.in[1]; const float* cctx = a.in[3]; const float* W = a.in[4]; const float* bada = a.in[5];
    float* MOD = (float*)(a.ws + WS_MOD);
    for (int i = tid; i < 17 * 1024; i += 512) { const float v = (i < 16 * 1024) ? c[i] : cctx[i - 16 * 1024]; sl[i] = v / (1.f + expf(-v)); }
    __syncthreads();
    for (int w = blockIdx.x; w < 192; w += gridDim.x) {
        const int col = w * 32 + (tid & 31), kg = tid >> 5;
        float acc[17];
#pragma unroll
        for (int v = 0; v < 17; ++v) acc[v] = 0.f;
        for (int kk = 0; kk < 64; kk += 16) { const int k = kg * 64 + kk; float wv[16];
#pragma unroll
            for (int j = 0; j < 16; ++j) wv[j] = __builtin_nontemporal_load(W + (size_t)(k + j) * 6144 + col);
#pragma unroll
            for (int v = 0; v < 17; ++v)
#pragma unroll
                for (int j4 = 0; j4 < 4; ++j4) { const f32x4 s4 = *(const f32x4*)(sl + v * 1024 + k + 4 * j4);
                    acc[v] += (s4.x * wv[4 * j4] + s4.y * wv[4 * j4 + 1]) + (s4.z * wv[4 * j4 + 2] + s4.w * wv[4 * j4 + 3]); } }
#pragma unroll
        for (int v = 0; v < 17; ++v) part[(kg * 17 + v) * 32 + (tid & 31)] = acc[v];
        __syncthreads();
        for (int i = tid; i < 17 * 32; i += 512) { const int v = i >> 5, cl = i & 31; float s = bada[w * 32 + cl];
            for (int g = 0; g < 16; ++g) s += part[(g * 17 + v) * 32 + cl];
            MOD[v * 6144 + w * 32 + cl] = s; }
        __syncthreads();
    }
}

__device__ __forceinline__ void transpose_item(const float* W, int ldw, int src_n0, int k0, u16* WT, int K, int dst_n0, bool zero, float* scr, int lane) {
    { const int kr = lane >> 3, n4 = (lane & 7) * 4; f32x4 v[8];
#pragma unroll
      for (int i = 0; i < 8; ++i) v[i] = zero ? (f32x4){0.f, 0.f, 0.f, 0.f} : __builtin_nontemporal_load((const f32x4*)(W + (size_t)(k0 + 8 * i + kr) * ldw + src_n0 + n4));
#pragma unroll
      for (int i = 0; i < 8; ++i) { float* d = scr + (8 * i + kr) * 33 + n4; d[0] = v[i].x; d[1] = v[i].y; d[2] = v[i].z; d[3] = v[i].w; } }
    asm volatile("s_waitcnt lgkmcnt(0)" ::: "memory");
    const int c = lane & 7;
#pragma unroll
    for (int j = 0; j < 4; ++j) { const int n = (lane >> 3) + 8 * j; const float* s = scr + (8 * c) * 33 + n;
        v4u o; o.x = pk2(s[0 * 33], s[1 * 33]); o.y = pk2(s[2 * 33], s[3 * 33]); o.z = pk2(s[4 * 33], s[5 * 33]); o.w = pk2(s[6 * 33], s[7 * 33]);
        *(v4u*)(WT + (size_t)(dst_n0 + n) * K + k0 + 8 * c) = o; }
    asm volatile("s_waitcnt lgkmcnt(0)" ::: "memory");
}
__device__ __forceinline__ void norm_mod_row2(const float* xrow0, const float* xrow1, const float* g, const float* shift0, const float* scale0, const float* shift1, const float* scale1, u16* orow0, u16* orow1, int lane) {
    const f32x4* xr0 = (const f32x4*)xrow0 + lane; const f32x4* xr1 = (const f32x4*)xrow1 + lane;
    f32x4 v0[4], v1[4]; float s0 = 0.f, s1 = 0.f;
#pragma unroll
    for (int j = 0; j < 4; ++j) { v0[j] = __builtin_nontemporal_load(xr0 + 64 * j); v1[j] = __builtin_nontemporal_load(xr1 + 64 * j); }
#pragma unroll
    for (int j = 0; j < 4; ++j) { s0 += (v0[j].x * v0[j].x + v0[j].y * v0[j].y) + (v0[j].z * v0[j].z + v0[j].w * v0[j].w); s1 += (v1[j].x * v1[j].x + v1[j].y * v1[j].y) + (v1[j].z * v1[j].z + v1[j].w * v1[j].w); }
#pragma unroll
    for (int o = 1; o < 64; o <<= 1) { s0 += __shfl_xor(s0, o); s1 += __shfl_xor(s1, o); }
    const float r0 = rsqrtf(s0 * (1.f / DM) + EPS), r1 = rsqrtf(s1 * (1.f / DM) + EPS);
    unsigned long long* o80 = (unsigned long long*)orow0 + lane; unsigned long long* o81 = (unsigned long long*)orow1 + lane;
#pragma unroll
    for (int j = 0; j < 4; ++j) { const f32x4 gg = ((const f32x4*)g)[lane + 64 * j];
        const f32x4 sh0 = ((const f32x4*)shift0)[lane + 64 * j], sc0 = ((const f32x4*)scale0)[lane + 64 * j], sh1 = ((const f32x4*)shift1)[lane + 64 * j], sc1 = ((const f32x4*)scale1)[lane + 64 * j];
        const f32x4 y0 = (v0[j] * r0 * gg) * (sc0 + 1.f) + sh0, y1 = (v1[j] * r1 * gg) * (sc1 + 1.f) + sh1;
        o80[64 * j] = (unsigned long long)pk2(y0.x, y0.y) | ((unsigned long long)pk2(y0.z, y0.w) << 32);
        o81[64 * j] = (unsigned long long)pk2(y1.x, y1.y) | ((unsigned long long)pk2(y1.z, y1.w) << 32); }
}
__device__ __forceinline__ void norm_mod_row2_bf(const u16* xrow0, const u16* xrow1, const float* g, const float* shift, const float* scale, u16* orow0, u16* orow1, int lane) {
    v4u w0[2], w1[2]; float x0[2][8], x1[2][8]; float s0 = 0.f, s1 = 0.f;
#pragma unroll
    for (int j = 0; j < 2; ++j) { w0[j] = *(const v4u*)(xrow0 + 512 * j + 8 * lane); w1[j] = *(const v4u*)(xrow1 + 512 * j + 8 * lane); }
#pragma unroll
    for (int j = 0; j < 2; ++j) { const unsigned a_[4] = {w0[j].x, w0[j].y, w0[j].z, w0[j].w}, b_[4] = {w1[j].x, w1[j].y, w1[j].z, w1[j].w};
#pragma unroll
        for (int e = 0; e < 4; ++e) { x0[j][2 * e] = bf2f((u16)(a_[e] & 0xffffu)); x0[j][2 * e + 1] = bf2f((u16)(a_[e] >> 16)); x1[j][2 * e] = bf2f((u16)(b_[e] & 0xffffu)); x1[j][2 * e + 1] = bf2f((u16)(b_[e] >> 16)); }
#pragma unroll
        for (int e = 0; e < 8; ++e) { s0 += x0[j][e] * x0[j][e]; s1 += x1[j][e] * x1[j][e]; } }
#pragma unroll
    for (int o = 1; o < 64; o <<= 1) { s0 += __shfl_xor(s0, o); s1 += __shfl_xor(s1, o); }
    const float r0 = rsqrtf(s0 * (1.f / DM) + EPS), r1 = rsqrtf(s1 * (1.f / DM) + EPS);
#pragma unroll
    for (int j = 0; j < 2; ++j) { const int c0 = 512 * j + 8 * lane; float y0[8], y1[8];
#pragma unroll
        for (int h4 = 0; h4 < 2; ++h4) { const f32x4 gg = *(const f32x4*)(g + c0 + 4 * h4), sh = *(const f32x4*)(shift + c0 + 4 * h4), sc = *(const f32x4*)(scale + c0 + 4 * h4);
#pragma unroll
            for (int e = 0; e < 4; ++e) { y0[4 * h4 + e] = (x0[j][4 * h4 + e] * r0 * gg[e]) * (sc[e] + 1.f) + sh[e]; y1[4 * h4 + e] = (x1[j][4 * h4 + e] * r1 * gg[e]) * (sc[e] + 1.f) + sh[e]; } }
        v4u o0 = {pk2(y0[0], y0[1]), pk2(y0[2], y0[3]), pk2(y0[4], y0[5]), pk2(y0[6], y0[7])}, o1 = {pk2(y1[0], y1[1]), pk2(y1[2], y1[3]), pk2(y1[4], y1[5]), pk2(y1[6], y1[7])};
        *(v4u*)(orow0 + c0) = o0; *(v4u*)(orow1 + c0) = o1; }
}
__device__ __forceinline__ void p_weights(const Args& a, unsigned char* lds, const int mk_wid, const int item_lo, const int item_hi, const int blk_lo, const bool do_rope) {
    const int tid = MK_TID, lane = tid & 63, wave = mk_wid;
    float* scr = (float*)(lds + wave * 16384);
    if ((int)blockIdx.x < blk_lo) return;
    const int gw = ((int)blockIdx.x - blk_lo) * 8 + wave, NGW = ((int)gridDim.x - blk_lo) * 8;
    unsigned char* ws = a.ws;
    constexpr int I_IN = 16 * 216, I_SQ = 16 * 32, I_FI = 16 * 176, I_FO = 44 * 32;
    constexpr int NITEMS = I_IN + 3 * I_SQ + I_FI + I_FO;
    for (int it = item_lo + gw; it < (item_hi < NITEMS ? item_hi : NITEMS); it += NGW) {
        int r = it;
        if (r < I_IN) { const int kb = r / 216, nb = r % 216, n0 = 32 * nb; const bool zero = n0 >= 6688;
            const int src = n0 < 4608 ? n0 : (n0 < 6656 ? n0 + 32 : n0 - 2048);
            transpose_item(a.in[7], 6688, zero ? 0 : src, 64 * kb, (u16*)(ws + WS_WIN), 1024, n0, zero, scr, lane); continue; }
        r -= I_IN;
        if (r < 3 * I_SQ) { const int which = r / I_SQ, q = r % I_SQ, kb = q / 32, nb = q % 32;
            const float* W = which == 0 ? a.in[15] : (which == 1 ? a.in[16] : a.in[17]);
            u16* WT = (u16*)(ws + (which == 0 ? WS_WAP : (which == 1 ? WS_WGP : WS_WOUT)));
            transpose_item(W, 1024, 32 * nb, 64 * kb, WT, 1024, 32 * nb, false, scr, lane); continue; }
        r -= 3 * I_SQ;
        if (r < I_FI) { const int kb = r / 176, nb = r % 176, n0 = 32 * nb, pn = n0 >> 8, j = n0 & 255;
            const int src = j < 128 ? pn * 128 + j : DFF + pn * 128 + (j - 128);
            transpose_item(a.in[19], 2 * DFF, src, 64 * kb, (u16*)(ws + WS_WFI), 1024, n0, false, scr, lane); continue; }
        r -= I_FI;
        { const int kb = r / 32, nb = r % 32; transpose_item(a.in[20], 1024, 32 * nb, 64 * kb, (u16*)(ws + WS_WFO), DFF, 32 * nb, false, scr, lane); }
    }
    float* rope = (float*)(ws + WS_ROPE);
    if (do_rope) for (int idx = blockIdx.x * 512 + tid; idx < T * 64; idx += gridDim.x * 512) { const int t = idx >> 6, i = idx & 63, j = i & 31;
        const float pos = (float)(i < 32 ? (t >> 6) : (t & 63));
        const float inv = 1.0f / powf(10000.f, (float)(2 * j) / 64.f);
        const float ang = pos * inv;
        rope[2 * idx] = cosf(ang); rope[2 * idx + 1] = sinf(ang); }
}

__device__ __forceinline__ void p_h1rows(const Args& a, const int mk_wid) {
    const int tid = MK_TID, lane = tid & 63, wave = mk_wid;
    const int gw = blockIdx.x * 8 + wave, NGW = gridDim.x * 8;
    unsigned char* ws = a.ws;
    const float* MOD = (const float*)(ws + WS_MOD);
    for (int m0 = gw * 2; m0 < MALL; m0 += NGW * 2) {
        const float* src[2]; const float* mod[2];
#pragma unroll
        for (int e = 0; e < 2; ++e) { const int m = m0 + e, b = m / TA, r = m % TA; const bool isc = r < TC;
            src[e] = isc ? a.in[2] + ((size_t)b * TC + r) * DM : a.in[0] + ((size_t)b * T + (r - TC)) * DM; mod[e] = MOD + (size_t)(isc ? 16 : b) * 6144; }
        norm_mod_row2(src[0], src[1], a.in[6], mod[0], mod[0] + 1024, mod[1], mod[1] + 1024, (u16*)(ws + WS_H1) + (size_t)m0 * DM, (u16*)(ws + WS_H1) + (size_t)(m0 + 1) * DM, lane); }
}

__device__ __forceinline__ void p_lowrank(const Args& a, unsigned char* lds, const int mk_wid) {
    const int tid = MK_TID, lane = tid & 63, r32 = lane & 31, hi = lane >> 5;
    constexpr int WP = 1032, APT = 136;
    u16* wl = (u16*)lds; u16* al = (u16*)(lds + 32 * WP * 2);
    const u16* H1 = (const u16*)(a.ws + WS_H1); const u16* WL = (const u16*)(a.ws + WS_WIN) + (size_t)6656 * 1024; u16* LR = (u16*)(a.ws + WS_LR);
    const int rb0 = (int)gridDim.x >= 256 ? (int)blockIdx.x - ((int)gridDim.x - MALL / 256) : (int)blockIdx.x;
    if (rb0 < 0 || rb0 >= MALL / 256) return;
#pragma unroll
    for (int p = 0; p < 8; ++p) { const int piece = p * 512 + tid, row = piece >> 7, c8 = piece & 127; *(v4u*)(wl + row * WP + c8 * 8) = *(const v4u*)(WL + (size_t)row * 1024 + c8 * 8); }
    for (int rb = rb0; rb < MALL / 256; rb += gridDim.x) {
        const u16* Ab = H1 + (size_t)rb * 256 * 1024;
        v4u st[8];
#pragma unroll
        for (int p = 0; p < 8; ++p) { const int piece = p * 512 + tid, row = piece >> 4, c8 = piece & 15; st[p] = *(const v4u*)(Ab + (size_t)row * 1024 + c8 * 8); }
        att::f32x16 acc = att::f32x16{};
        for (int kc = 0; kc < 8; ++kc) {
            __syncthreads();
#pragma unroll
            for (int p = 0; p < 8; ++p) { const int piece = p * 512 + tid, row = piece >> 4, c8 = piece & 15; *(v4u*)(al + row * APT + c8 * 8) = st[p]; }
            if (kc + 1 < 8) {
#pragma unroll
                for (int p = 0; p < 8; ++p) { const int piece = p * 512 + tid, row = piece >> 4, c8 = piece & 15; st[p] = *(const v4u*)(Ab + (size_t)row * 1024 + (kc + 1) * 128 + c8 * 8); } }
            __syncthreads();
            const u16* ap = al + (mk_wid * 32 + r32) * APT + 8 * hi; const u16* bp = wl + r32 * WP + kc * 128 + 8 * hi;
#pragma unroll
            for (int kb = 0; kb < 8; ++kb) acc = __builtin_amdgcn_mfma_f32_32x32x16_bf16(*(const att::bf16x8*)(ap + kb * 16), *(const att::bf16x8*)(bp + kb * 16), acc, 0, 0, 0);
        }
#pragma unroll
        for (int r = 0; r < 16; ++r) LR[(size_t)(rb * 256 + mk_wid * 32 + att::crow(r, hi)) * 32 + r32] = f2bf(acc[r]);
    }
    __syncthreads();
}
__device__ __forceinline__ void p_kprep(const Args& a, const int mk_wid) {
    const int tid = MK_TID, lane = tid & 63, wave = mk_wid;
    const int gw = blockIdx.x * 8 + wave, NGW = gridDim.x * 8;
    u16* Kb = (u16*)(a.ws + WS_K); const float* rope = (const float*)(a.ws + WS_ROPE); const float* kg = a.in[9];
    const int head = lane >> 5, l = lane & 31;
    const f32x4 g = *(const f32x4*)(kg + 4 * l);
    for (int m0 = gw * 6; m0 < MALL; m0 += NGW * 6) {
        v2u w[6]; f32x4 cs[6]; float f[6][4], s[6];
#pragma unroll
        for (int e = 0; e < 6; ++e) { const int m = m0 + e, r = m % TA; w[e] = *(const v2u*)(Kb + (size_t)m * 256 + head * 128 + 4 * l);
            cs[e] = (r >= TC) ? *(const f32x4*)(rope + ((size_t)(r - TC) * 64 + 2 * l) * 2) : (f32x4){1.f, 0.f, 1.f, 0.f}; }
#pragma unroll
        for (int e = 0; e < 6; ++e) { f[e][0] = bf2f((u16)(w[e].x & 0xffffu)); f[e][1] = bf2f((u16)(w[e].x >> 16)); f[e][2] = bf2f((u16)(w[e].y & 0xffffu)); f[e][3] = bf2f((u16)(w[e].y >> 16));
            s[e] = (f[e][0] * f[e][0] + f[e][1] * f[e][1]) + (f[e][2] * f[e][2] + f[e][3] * f[e][3]); }
#pragma unroll
        for (int o = 1; o < 32; o <<= 1) {
#pragma unroll
            for (int e = 0; e < 6; ++e) s[e] += __shfl_xor(s[e], o); }
#pragma unroll
        for (int e = 0; e < 6; ++e) { const float rinv = rsqrtf(s[e] * (1.f / 128.f) + EPS);
            const float f0 = f[e][0] * rinv * g.x, f1 = f[e][1] * rinv * g.y, f2 = f[e][2] * rinv * g.z, f3 = f[e][3] * rinv * g.w;
            v2u o; o.x = pk2(f0 * cs[e].x - f1 * cs[e].y, f0 * cs[e].y + f1 * cs[e].x); o.y = pk2(f2 * cs[e].z - f3 * cs[e].w, f2 * cs[e].w + f3 * cs[e].z);
            *(v2u*)(Kb + (size_t)(m0 + e) * 256 + head * 128 + 4 * l) = o; } }
}
__device__ __forceinline__ void p_glapost(const Args& a, const int mk_wid) {
    const int tid = MK_TID, lane = tid & 63, wave = mk_wid;
    const int gw = blockIdx.x * 8 + wave, NGW = gridDim.x * 8;
    const u16* OF = (const u16*)(a.ws + WS_OF); const u16* OB = (const u16*)(a.ws + WS_OB); u16* GG = (u16*)(a.ws + WS_GG);
    const f32x4 g = *(const f32x4*)(a.in[14] + 4 * lane);
    for (int it0 = gw * 4; it0 < MLAT * 4; it0 += NGW * 4) {
        v2u wf[4], wb[4], wg[4]; float o_[4][4], ss[4];
#pragma unroll
        for (int e = 0; e < 4; ++e) { const size_t off = (size_t)(it0 + e) * 256 + 4 * lane; wf[e] = __builtin_nontemporal_load((const v2u*)(OF + off)); wb[e] = __builtin_nontemporal_load((const v2u*)(OB + off)); wg[e] = __builtin_nontemporal_load((const v2u*)(GG + off)); }
#pragma unroll
        for (int e = 0; e < 4; ++e) {
            o_[e][0] = bf2f((u16)(wf[e].x & 0xffffu)) + bf2f((u16)(wb[e].x & 0xffffu)); o_[e][1] = bf2f((u16)(wf[e].x >> 16)) + bf2f((u16)(wb[e].x >> 16));
            o_[e][2] = bf2f((u16)(wf[e].y & 0xffffu)) + bf2f((u16)(wb[e].y & 0xffffu)); o_[e][3] = bf2f((u16)(wf[e].y >> 16)) + bf2f((u16)(wb[e].y >> 16));
            ss[e] = (o_[e][0] * o_[e][0] + o_[e][1] * o_[e][1]) + (o_[e][2] * o_[e][2] + o_[e][3] * o_[e][3]); }
#pragma unroll
        for (int o = 1; o < 64; o <<= 1) {
#pragma unroll
            for (int e = 0; e < 4; ++e) ss[e] += __shfl_xor(ss[e], o); }
#pragma unroll
        for (int e = 0; e < 4; ++e) { const float rinv = rsqrtf(ss[e] * (1.f / 256.f) + EPS);
            const float g0 = bf2f((u16)(wg[e].x & 0xffffu)), g1 = bf2f((u16)(wg[e].x >> 16)), g2 = bf2f((u16)(wg[e].y & 0xffffu)), g3 = bf2f((u16)(wg[e].y >> 16));
            v2u o; o.x = pk2(o_[e][0] * rinv * g.x * (g0 * sigmoidf_(g0)), o_[e][1] * rinv * g.y * (g1 * sigmoidf_(g1)));
            o.y = pk2(o_[e][2] * rinv * g.z * (g2 * sigmoidf_(g2)), o_[e][3] * rinv * g.w * (g3 * sigmoidf_(g3)));
            *(v2u*)(GG + (size_t)(it0 + e) * 256 + 4 * lane) = o; } }
}
__device__ __forceinline__ void p_h2(const Args& a, const int mk_wid) {
    const int tid = MK_TID, lane = tid & 63, wave = mk_wid;
    const int gw = blockIdx.x * 8 + wave, NGW = gridDim.x * 8;
    const float* MOD = (const float*)(a.ws + WS_MOD);
    const u16* X1 = (const u16*)(a.ws + WS_X1);
    for (int m0 = gw * 2; m0 < MLAT; m0 += NGW * 2) { const float* mod = MOD + (size_t)(m0 / T) * 6144;
        norm_mod_row2_bf(X1 + (size_t)m0 * DM, X1 + (size_t)(m0 + 1) * DM, a.in[18], mod + 3 * 1024, mod + 4 * 1024,
                         (u16*)(a.ws + WS_H2) + (size_t)m0 * DM, (u16*)(a.ws + WS_H2) + (size_t)(m0 + 1) * DM, lane); }
}
namespace gla {
using att::bf16x8; using att::s16x4; using att::f32x16; using att::crow; using att::v_st; using att::v_rd_base; using att::v_rd_off; using att::tr_read;
constexpr int QP = 136, AP = 72;
constexpr int L_QE = 0, L_KE = 17408, L_KD = 34816, L_V = 51200, L_AM = 83968, L_LAS = 93184, L_LR = 125952, L_GS = 128000, L_DL = 130048, L_END = 130560;
static_assert(L_END <= LDS_BYTES - 64, "GLA LDS map");
#define GLA_PK(L, H) (bf16x8){L[0], L[1], L[2], L[3], H[0], H[1], H[2], H[3]}
#define GLA_SBAR() __builtin_amdgcn_sched_barrier(0)
#define OPAQUE_TID(name) int name = MK_TID; asm volatile("" : "+v"(name))

__device__ __forceinline__ void scan_unit(const int unit, const Args& a, unsigned char* lds, const int mk_wid) {
    const int wid = mk_wid;
    const int dir = unit & 1, h = (unit >> 1) & 3, b = unit >> 3;
    const int vt = wid;
    const u16* GQ = (const u16*)(a.ws + WS_GQ); const u16* GK = (const u16*)(a.ws + WS_GK); const u16* GV = (const u16*)(a.ws + WS_GV); const u16* LR = (const u16*)(a.ws + WS_LR);
    u16* OUT = (u16*)(a.ws + (dir ? WS_OB : WS_OF));
    bf16x8 upf; float biasc;
    { const int l_ = MK_TID & 63, r32 = l_ & 31, hi = l_ >> 5; const float* up = a.in[dir ? 12 : 10] + (size_t)(8 * hi) * 512 + h * 128 + (wid & 3) * 32 + r32;
      v4u w; w.x = pk2(up[0], up[512]); w.y = pk2(up[2 * 512], up[3 * 512]); w.z = pk2(up[4 * 512], up[5 * 512]); w.w = pk2(up[6 * 512], up[7 * 512]);
      upf = __builtin_bit_cast(bf16x8, w); biasc = a.in[dir ? 13 : 11][h * 128 + (wid & 3) * 32 + r32]; }
    u16* qe = (u16*)(lds + L_QE); u16* ke = (u16*)(lds + L_KE); u16* am = (u16*)(lds + L_AM);
    float* las = (float*)(lds + L_LAS); float* gs = (float*)(lds + L_GS); float* dl = (float*)(lds + L_DL);
    const int ldsb = (int)(uintptr_t)lds;
    u16* ot = (u16*)(lds + L_LAS);
    int pend_cc = -1;
#define GLA_FLUSH() do { if (pend_cc >= 0) { OPAQUE_TID(tf_); const size_t rl0_ = (size_t)b * T + (size_t)(pend_cc - 4) * 64; \
      _Pragma("unroll") for (int p = 0; p < 4; ++p) { const int idx_ = p * 512 + tf_, i_ = idx_ >> 5, c16_ = idx_ & 31; \
          *(v4u*)(OUT + (rl0_ + (dir ? 63 - i_ : i_)) * 1024 + h * 256 + c16_ * 8) = *(const v4u*)(ot + i_ * 256 + c16_ * 8); } } } while (0)
    f32x16 S[4]; S[0] = f32x16{}; S[1] = f32x16{}; S[2] = f32x16{}; S[3] = f32x16{};
    bf16x8 qraw[2], kraw[2], vraw[4]; bf16x8 lraw = bf16x8{};
#define GLA_CHUNK(s) (dir ? ((s) < 4 ? 3 - (s) : 39 - (s)) : (s))
#define GLA_LOAD(s) do { OPAQUE_TID(t_); const int cc_ = GLA_CHUNK(s); const size_t rowb_ = (size_t)b * TA + (size_t)cc_ * 64; \
      _Pragma("unroll") for (int p = 0; p < 2; ++p) { const int i_ = p * 32 + (t_ >> 4); const size_t row_ = rowb_ + (dir ? 63 - i_ : i_); \
          kraw[p] = *(const bf16x8*)(GK + row_ * 512 + h * 128 + (t_ & 15) * 8); \
          qraw[p] = (cc_ >= 4) ? *(const bf16x8*)(GQ + row_ * 512 + h * 128 + (t_ & 15) * 8) : bf16x8{}; } \
      _Pragma("unroll") for (int p = 0; p < 4; ++p) { const int i_ = p * 16 + (t_ >> 5); const size_t row_ = rowb_ + (dir ? 63 - i_ : i_); \
          vraw[p] = *(const bf16x8*)(GV + row_ * 1024 + h * 256 + (t_ & 31) * 8); } \
      if (t_ < 128) { const int i_ = t_ >> 1; const size_t row_ = rowb_ + (dir ? 63 - i_ : i_); lraw = *(const bf16x8*)(LR + row_ * 32 + dir * 16 + (t_ & 1) * 8); } } while (0)
    GLA_LOAD(0);
    for (int step = 0; step < 36; ++step) {
        const int cc = GLA_CHUNK(step); const bool lat = cc >= 4;
        GLA_FLUSH();
        { OPAQUE_TID(t_);
#pragma unroll
          for (int p = 0; p < 2; ++p) { const int i_ = p * 32 + (t_ >> 4), c_ = (t_ & 15) * 8; *(bf16x8*)(qe + i_ * QP + c_) = qraw[p]; *(bf16x8*)(ke + i_ * QP + c_) = kraw[p]; }
#pragma unroll
          for (int p = 0; p < 4; ++p) { const int i_ = p * 16 + (t_ >> 5), c8 = t_ & 31; *(bf16x8*)(lds + L_V + (c8 >> 4) * 16384 + v_st(i_, (c8 & 15) * 8)) = vraw[p]; }
          if (t_ < 128) *(bf16x8*)(lds + L_LR + (t_ >> 1) * 32 + (t_ & 1) * 16) = lraw; }
        __syncthreads();
        { OPAQUE_TID(t_); const int lane = t_ & 63, r32 = lane & 31, hi = lane >> 5; const int tt = wid >> 2, ct = wid & 3;
          const bf16x8 af = *(const bf16x8*)(lds + L_LR + (tt * 32 + r32) * 32 + hi * 16);
          const f32x16 z = __builtin_amdgcn_mfma_f32_32x32x16_bf16(af, upf, f32x16{}, 0, 0, 0);
          float* lw = las + (tt * 32 + 4 * hi) * 128 + ct * 32 + r32;
#pragma unroll
          for (int r = 0; r < 16; ++r) { const float zz = z[r] + biasc;
              lw[crow(r, 0) * 128] = (fminf(zz, 0.f) - __builtin_amdgcn_logf(1.f + __builtin_amdgcn_exp2f(-1.4426950408889634f * fabsf(zz))) * 0.6931471805599453f) * (1.f / 16.f); } }
        __syncthreads();
        { OPAQUE_TID(t_); const int c = t_ & 127, g = t_ >> 7;
          float bl[16]; float run = 0.f;
          { const float* lp = las + (g * 16) * 128 + c;
#pragma unroll
            for (int ii = 0; ii < 16; ++ii) { run += lp[ii * 128]; bl[ii] = run; } }
          gs[g * 128 + c] = run;
          __syncthreads();
          const float g0 = gs[c], g1 = gs[128 + c], g2 = gs[256 + c], g3 = gs[384 + c];
          const float off = (g > 0 ? g0 : 0.f) + (g > 1 ? g1 : 0.f) + (g > 2 ? g2 : 0.f);
          const float btot = (g0 + g1) + (g2 + g3);
          const float dlc = __builtin_amdgcn_exp2f(btot * 1.4426950408889634f);
          if (g == 0) dl[c] = dlc;
          u16* qcol = qe + (g * 16) * QP + c; u16* kcol = ke + (g * 16) * QP + c; unsigned char* kdb = lds + L_KD + v_st(g * 16, c);
#pragma unroll
          for (int ii = 0; ii < 16; ++ii) { const float bb = bl[ii] + off;
              const float qf = bf2f(qcol[ii * QP]), kf = bf2f(kcol[ii * QP]);
              const float e = __builtin_amdgcn_exp2f(bb * 1.4426950408889634f), ker = kf * __builtin_amdgcn_rcpf(e);
              qcol[ii * QP] = f2bf(qf * (0.088388347648318440f * e));
              kcol[ii * QP] = f2bf(ker);
              *(u16*)(kdb + v_st(ii, 0)) = f2bf(ker * dlc); } }
        if (step + 1 < 36) GLA_LOAD(step + 1);
        __syncthreads();
        if (lat) {
            if (wid < 4) { OPAQUE_TID(t_); const int r32 = t_ & 31, hi = (t_ >> 5) & 1;
                const int jt = wid >> 1, it = wid & 1; f32x16 ct = f32x16{};
                const u16* kp = ke + (jt * 32 + r32) * QP + hi * 8; const u16* qp = qe + (it * 32 + r32) * QP + hi * 8;
#pragma unroll
                for (int kb = 0; kb < 8; ++kb) ct = __builtin_amdgcn_mfma_f32_32x32x16_bf16(*(const bf16x8*)(kp + kb * 16), *(const bf16x8*)(qp + kb * 16), ct, 0, 0, 0);
                const int i = it * 32 + r32;
#pragma unroll
                for (int rg = 0; rg < 4; ++rg) { const int j0 = jt * 32 + 8 * rg + 4 * hi;
                    const float x0 = (j0 + 0 <= i) ? ct[4 * rg + 0] : 0.f, x1 = (j0 + 1 <= i) ? ct[4 * rg + 1] : 0.f, x2 = (j0 + 2 <= i) ? ct[4 * rg + 2] : 0.f, x3 = (j0 + 3 <= i) ? ct[4 * rg + 3] : 0.f;
                    v2u w; w.x = pk2(x0, x1); w.y = pk2(x2, x3); *(v2u*)(am + i * AP + j0) = w; } }
            __syncthreads();
        }
        { OPAQUE_TID(t_); const int lane = t_ & 63, r32 = lane & 31, hi = lane >> 5;
          const int vb = ldsb + L_V + (vt >> 2) * 16384 + v_rd_base(lane) + (vt & 3) * 512;
          s16x4 vl0, vh0, vl1, vh1, vl2, vh2, vl3, vh3;
#define GLA_LOADV() do { vl0 = tr_read<v_rd_off(0, 0, 0)>(vb); vh0 = tr_read<v_rd_off(0, 0, 1)>(vb); vl1 = tr_read<v_rd_off(0, 1, 0)>(vb); vh1 = tr_read<v_rd_off(0, 1, 1)>(vb); \
              vl2 = tr_read<v_rd_off(0, 2, 0)>(vb); vh2 = tr_read<v_rd_off(0, 2, 1)>(vb); vl3 = tr_read<v_rd_off(0, 3, 0)>(vb); vh3 = tr_read<v_rd_off(0, 3, 1)>(vb); } while (0)
          if (!lat) GLA_LOADV();
          if (lat) {
              f32x16 o0 = f32x16{}, o1 = f32x16{};
#pragma unroll
              for (int ct = 0; ct < 4; ++ct)
#pragma unroll
                for (int kb = 0; kb < 2; ++kb) { const int cb = ct * 32 + kb * 16;
                    v4u sw; sw.x = pk2(S[ct][8 * kb + 0], S[ct][8 * kb + 1]); sw.y = pk2(S[ct][8 * kb + 2], S[ct][8 * kb + 3]); sw.z = pk2(S[ct][8 * kb + 4], S[ct][8 * kb + 5]); sw.w = pk2(S[ct][8 * kb + 6], S[ct][8 * kb + 7]);
                    const bf16x8 sb = __builtin_bit_cast(bf16x8, sw);
                    { const u16* p0 = qe + r32 * QP + cb + 4 * hi; const v2u lo = *(const v2u*)p0, hh = *(const v2u*)(p0 + 8); v4u aw = {lo.x, lo.y, hh.x, hh.y};
                      o0 = __builtin_amdgcn_mfma_f32_32x32x16_bf16(__builtin_bit_cast(bf16x8, aw), sb, o0, 0, 0, 0); }
                    { const u16* p1 = qe + (32 + r32) * QP + cb + 4 * hi; const v2u lo = *(const v2u*)p1, hh = *(const v2u*)(p1 + 8); v4u aw = {lo.x, lo.y, hh.x, hh.y};
                      o1 = __builtin_amdgcn_mfma_f32_32x32x16_bf16(__builtin_bit_cast(bf16x8, aw), sb, o1, 0, 0, 0); } }
              GLA_LOADV();
              asm volatile("s_waitcnt lgkmcnt(0)" ::: "memory"); GLA_SBAR();
              { const u16* a0 = am + r32 * AP + hi * 8; const u16* a1 = am + (32 + r32) * AP + hi * 8;
                o0 = __builtin_amdgcn_mfma_f32_32x32x16_bf16(*(const bf16x8*)(a0), GLA_PK(vl0, vh0), o0, 0, 0, 0);
                o0 = __builtin_amdgcn_mfma_f32_32x32x16_bf16(*(const bf16x8*)(a0 + 16), GLA_PK(vl1, vh1), o0, 0, 0, 0);
                o1 = __builtin_amdgcn_mfma_f32_32x32x16_bf16(*(const bf16x8*)(a1), GLA_PK(vl0, vh0), o1, 0, 0, 0);
                o1 = __builtin_amdgcn_mfma_f32_32x32x16_bf16(*(const bf16x8*)(a1 + 16), GLA_PK(vl1, vh1), o1, 0, 0, 0);
                o1 = __builtin_amdgcn_mfma_f32_32x32x16_bf16(*(const bf16x8*)(a1 + 32), GLA_PK(vl2, vh2), o1, 0, 0, 0);
                o1 = __builtin_amdgcn_mfma_f32_32x32x16_bf16(*(const bf16x8*)(a1 + 48), GLA_PK(vl3, vh3), o1, 0, 0, 0); }
              { u16* ow = ot + (4 * hi) * 256 + vt * 32 + r32;
#pragma unroll
                for (int r = 0; r < 16; ++r) { const int i0 = crow(r, 0); ow[i0 * 256] = f2bf(o0[r]); ow[(i0 + 32) * 256] = f2bf(o1[r]); } }
          }
#pragma unroll
          for (int ct = 0; ct < 4; ++ct) { const int kb_ = ldsb + L_KD + v_rd_base(lane) + ct * 512;
              const s16x4 al0 = tr_read<v_rd_off(0, 0, 0)>(kb_), ah0 = tr_read<v_rd_off(0, 0, 1)>(kb_), al1 = tr_read<v_rd_off(0, 1, 0)>(kb_), ah1 = tr_read<v_rd_off(0, 1, 1)>(kb_);
              const s16x4 al2 = tr_read<v_rd_off(0, 2, 0)>(kb_), ah2 = tr_read<v_rd_off(0, 2, 1)>(kb_), al3 = tr_read<v_rd_off(0, 3, 0)>(kb_), ah3 = tr_read<v_rd_off(0, 3, 1)>(kb_);
              const float* dp = dl + ct * 32 + 4 * hi;
#pragma unroll
              for (int rg = 0; rg < 4; ++rg) { const f32x4 d4 = *(const f32x4*)(dp + 8 * rg);
                  S[ct][4 * rg + 0] *= d4.x; S[ct][4 * rg + 1] *= d4.y; S[ct][4 * rg + 2] *= d4.z; S[ct][4 * rg + 3] *= d4.w; }
              asm volatile("s_waitcnt lgkmcnt(0)" ::: "memory"); GLA_SBAR();
              S[ct] = __builtin_amdgcn_mfma_f32_32x32x16_bf16(GLA_PK(al0, ah0), GLA_PK(vl0, vh0), S[ct], 0, 0, 0);
              S[ct] = __builtin_amdgcn_mfma_f32_32x32x16_bf16(GLA_PK(al1, ah1), GLA_PK(vl1, vh1), S[ct], 0, 0, 0);
              S[ct] = __builtin_amdgcn_mfma_f32_32x32x16_bf16(GLA_PK(al2, ah2), GLA_PK(vl2, vh2), S[ct], 0, 0, 0);
              S[ct] = __builtin_amdgcn_mfma_f32_32x32x16_bf16(GLA_PK(al3, ah3), GLA_PK(vl3, vh3), S[ct], 0, 0, 0); } }
        __syncthreads();
        pend_cc = lat ? cc : -1;
    }
    GLA_FLUSH();
    __syncthreads();
#undef GLA_FLUSH
#undef GLA_LOADV
#undef GLA_CHUNK
#undef GLA_LOAD
}
}
#define XB_TMO      128
#define XB_XCNT(j)  (256  + 64 * (j))
#define XB_XSUB(j)  (1280 + 64 * (j))
#define XB_XGEN(j)  (2304 + 64 * (j))
#define XB_TOP      3328
#define XB_TOPGEN   3392
#define XCD_BAR_WORDS 3456
#define XB_SPIN_CAP (1u << 18)

__device__ __forceinline__ unsigned xb_ld(unsigned* p)              { return __hip_atomic_load(p, __ATOMIC_RELAXED, __HIP_MEMORY_SCOPE_AGENT); }
__device__ __forceinline__ unsigned xb_add(unsigned* p, unsigned v) { return __hip_atomic_fetch_add(p, v, __ATOMIC_RELAXED, __HIP_MEMORY_SCOPE_AGENT); }
__device__ __forceinline__ unsigned xb_xcc_id() { return (unsigned)__builtin_amdgcn_s_getreg((3 << 11) | 20) & 0xFu; }
#define XB_SPIN(cond, bar) do { unsigned _sp = 0; while (cond) { __builtin_amdgcn_s_sleep(1); \
    if ((++_sp & 255u) == 0u) { if (xb_ld(&(bar)[XB_TMO])) break; if (_sp > XB_SPIN_CAP) { atomicAdd(&(bar)[XB_TMO], 1u); break; } } } } while (0)

struct XcdBarrier {
    unsigned* bar; unsigned x;
    volatile LAS unsigned* st;
};

__device__ __forceinline__ XcdBarrier xcd_barrier_post(unsigned* bar, volatile LAS unsigned* st, const bool tid0) {
    XcdBarrier b; b.bar = bar; b.x = xb_xcc_id(); b.st = st;
    if (tid0) (void)xb_add(&bar[XB_XCNT(b.x)], 1u);
    return b;
}
__device__ __forceinline__ void xcd_barrier_complete(unsigned* bar, unsigned x, unsigned& nloc, unsigned& nx) {
    const unsigned G = gridDim.x * gridDim.y * gridDim.z;
    unsigned sum, cnt, mine, sp = 0u;
    for (;;) {
        sum = 0u; cnt = 0u; mine = 0u;
#pragma unroll
        for (unsigned j = 0; j < 16; ++j) { const unsigned c = xb_ld(&bar[XB_XCNT(j)]); sum += c; cnt += (c > 0u) ? 1u : 0u; mine = (j == x) ? c : mine; }
        if (sum == G) break;
        __builtin_amdgcn_s_sleep(1);
        if ((++sp & 255u) == 0u) { if (xb_ld(&bar[XB_TMO])) break; if (sp > XB_SPIN_CAP) { atomicAdd(&bar[XB_TMO], 1u); break; } }
    }
    nloc = mine > 0u ? mine : 1u; nx = cnt > 0u ? cnt : 1u;
}

__device__ __forceinline__ void xcd_barrier(const XcdBarrier& b, const bool tid0) {
    asm volatile("s_waitcnt vmcnt(0)" ::: "memory");
    __syncthreads();
    if (tid0) {
        unsigned* bar = b.bar; const unsigned bx_ = (unsigned)__builtin_amdgcn_readfirstlane((int)xb_xcc_id());
        __builtin_amdgcn_s_waitcnt(0);
        unsigned nloc = b.st[0], nx = b.st[1];
        if (nloc == 0u) { xcd_barrier_complete(bar, bx_, nloc, nx); b.st[0] = nloc; b.st[1] = nx; }
        const unsigned old = xb_add(&bar[XB_XSUB(bx_)], 1u);
        const unsigned gen = old / nloc;
        if (old + 1u == (gen + 1u) * nloc) {
            __builtin_amdgcn_fence(__ATOMIC_RELEASE, "agent");
            asm volatile("s_waitcnt vmcnt(0)" ::: "memory");
            const unsigned og = xb_add(&bar[XB_TOP], 1u);
            const unsigned tg = og / nx;
            if (og + 1u == (tg + 1u) * nx) xb_add(&bar[XB_TOPGEN], 1u);
            else XB_SPIN(xb_ld(&bar[XB_TOPGEN]) == tg, bar);
            __builtin_amdgcn_fence(__ATOMIC_ACQUIRE, "agent");
            xb_add(&bar[XB_XGEN(bx_)], 1u);
            asm volatile("s_waitcnt vmcnt(0)" ::: "memory");
        } else {
            XB_SPIN(xb_ld(&bar[XB_XGEN(bx_)]) == gen, bar);
            __builtin_amdgcn_fence(__ATOMIC_ACQUIRE, "agent");
            asm volatile("s_waitcnt vmcnt(0)" ::: "memory");
        }
    }
    __syncthreads();
}
#ifndef MK_PER_PHASE
#define MK_PER_PHASE 0
#endif
__global__ void __launch_bounds__(512) mk_fwd(Args a) {
    extern __shared__ __attribute__((aligned(16))) unsigned char lds[];
    cg::grid_group grid = cg::this_grid();
    unsigned char* ws = a.ws;
    LAS unsigned char* lds3 = (LAS unsigned char*)lds;
    const int G = gridDim.x, bx = blockIdx.x;
    const int mk_wid = __builtin_amdgcn_readfirstlane(threadIdx.x >> 6);
#ifndef PHMASK
#define PHMASK 0x7ff
#endif
#define IN(k) (((PHMASK >> (k)) & 1) && a.ph_lo <= (k) && (k) < a.ph_hi)
    unsigned* bar_words = (unsigned*)(ws + 4096);
    volatile LAS unsigned* bar_st = (volatile LAS unsigned*)(lds3 + (LDS_BYTES - 64));
    { const int t0_ = MK_TID; if (t0_ < 2) bar_st[t0_] = 0u; }
    if (IN(0) && bx == 0) { for (int i = MK_TID; i < XCD_BAR_WORDS; i += 512) __hip_atomic_store(bar_words + i, 0u, __ATOMIC_RELAXED, __HIP_MEMORY_SCOPE_AGENT); }
#define SEAM(k) do { if (IN(k) && IN((k) + 1)) { if ((k) == 0) { grid.sync(); (void)xcd_barrier_post(bar_words, bar_st, MK_TID == 0); } else { unsigned long long bp_ = (unsigned long long)(a.ws + 4096); asm volatile("" : "+s"(bp_)); XcdBarrier xb_; xb_.bar = (unsigned*)bp_; xb_.x = 0; xb_.st = bar_st; xcd_barrier(xb_, MK_TID == 0); } } } while (0)
    if (IN(0)) p_adaln(a, lds, mk_wid);
    SEAM(0);
    if (IN(1)) { p_weights(a, lds, mk_wid, 0, (G == 256) ? WI_IN : WI_ALL, 0, true); p_h1rows(a, mk_wid); }
    SEAM(1);
    if (IN(2)) {
        pg8::Gemm g{(const pg8::bf16_t*)(ws + WS_H1), (const pg8::bf16_t*)(ws + WS_WIN), MALL, NIN, DM}; InProjOrder S; S.init(G, bx);
        EpiInProj E{ws, (u16*)a.out};
        p_lowrank(a, lds, mk_wid);
        __syncthreads();
        pg8::gemm_phase<EpiInProj, InProjOrder, true, true>(lds3, g, S, E, mk_wid);
        if (G == 256) p_weights(a, lds, mk_wid, WI_IN, WI_PROJ, 128, false);
    }
    SEAM(2);
    if (IN(3)) p_kprep(a, mk_wid);
    SEAM(3);
    if (IN(4)) {
        const att::bf16* Qp = (const att::bf16*)(ws + WS_Q); const att::bf16* Kp = (const att::bf16*)(ws + WS_K); const att::bf16* Vp = (const att::bf16*)(ws + WS_V);
        const float* rope = (const float*)(ws + WS_ROPE);
        const bool full = (G == 256);
        if (full) { if (bx < 128) gla::scan_unit(bx, a, lds, mk_wid); }
        else { for (int u = bx; u < 128; u += G) gla::scan_unit(u, a, lds, mk_wid); }
        __syncthreads();
        const int xj = bx >> 3, xx = bx & 7;
        const int nun = full ? (xj < 16 ? 3 : 5) : 0;
        for (int i = 0; ; ++i) {
            int bk, w;
            if (full) { if (i >= nun) break; const int idx = (xj < 16) ? 80 + i * 16 + xj : i * 16 + (xj - 16); bk = (idx >> 5) * 8 + xx; w = idx & 31; }
            else { const int u = i * G + bx; if (u >= 1024) break; bk = u >> 5; w = u & 31; }
            const int b = bk >> 1, kvh = bk & 1, hq = kvh * 4 + (w >> 3), qb = w & 7;
            const size_t qoff = ((size_t)b * T + (size_t)qb * 256) * 1024 + hq * 128;
            const size_t koff = (size_t)b * TA * 256 + kvh * 128;
            att::attn_unit(Qp + qoff, Kp + koff, Vp + koff, (att::bf16*)(ws + WS_Q) + qoff, TA, (char*)lds, rope + (size_t)qb * 256 * 128, a.in[8], mk_wid);
        }
        if (full) p_weights(a, lds, mk_wid, WI_PROJ, WI_ALL, 128, false);
    }
    SEAM(4);
    if (IN(5)) {
        pg8::StaticOrder S; S.init(MLAT, DM, G, bx, 2);
        { pg8::Gemm g{(const pg8::bf16_t*)(ws + WS_Q), (const pg8::bf16_t*)(ws + WS_WAP), MLAT, DM, DM};
          EpiMerge<0> E{(const u16*)a.out, (u16*)(ws + WS_T1), (u16*)(ws + WS_MRG)};
          pg8::gemm_phase<EpiMerge<0>, pg8::StaticOrder, true, true>(lds3, g, S, E, mk_wid); }
        p_glapost(a, mk_wid);
    }
    SEAM(5);
    if (IN(6)) {
        pg8::StaticOrder S; S.init(MLAT, DM, G, bx, 2);
        pg8::Gemm g{(const pg8::bf16_t*)(ws + WS_GG), (const pg8::bf16_t*)(ws + WS_WGP), MLAT, DM, DM};
        EpiMerge<1> E{(const u16*)a.out, (u16*)(ws + WS_T1), (u16*)(ws + WS_MRG)};
        pg8::gemm_phase<EpiMerge<1>, pg8::StaticOrder, true, true>(lds3, g, S, E, mk_wid);
    }
    SEAM(6);
    if (IN(7)) {
        pg8::Gemm g{(const pg8::bf16_t*)(ws + WS_MRG), (const pg8::bf16_t*)(ws + WS_WOUT), MLAT, DM, DM}; pg8::StaticOrder S; S.init(MLAT, DM, G, bx, 2);
        EpiGateResB<false> E{(const void*)a.in[0], (void*)(ws + WS_X1), (const float*)(ws + WS_MOD) + 2 * 1024};
        pg8::gemm_phase<EpiGateResB<false>, pg8::StaticOrder, true, true>(lds3, g, S, E, mk_wid);
    }
    SEAM(7);
    if (IN(8)) p_h2(a, mk_wid);
    SEAM(8);
    if (IN(9)) {
        pg8::Gemm g{(const pg8::bf16_t*)(ws + WS_H2), (const pg8::bf16_t*)(ws + WS_WFI), MLAT, 2 * DFF, DM}; pg8::StaticOrder S; S.init(MLAT, 2 * DFF, G, bx);
        EpiSwiglu E{(u16*)(ws + WS_ACT)};
        pg8::gemm_phase<EpiSwiglu, pg8::StaticOrder, true, true>(lds3, g, S, E, mk_wid);
    }
    SEAM(9);
    if (IN(10)) {
        pg8::Gemm g{(const pg8::bf16_t*)(ws + WS_ACT), (const pg8::bf16_t*)(ws + WS_WFO), MLAT, DM, DFF}; pg8::StaticOrder S; S.init(MLAT, DM, G, bx, 2);
        EpiGateResB<true> E{(const void*)(ws + WS_X1), (void*)a.out, (const float*)(ws + WS_MOD) + 5 * 1024};
        pg8::gemm_phase<EpiGateResB<true>, pg8::StaticOrder, true, true>(lds3, g, S, E, mk_wid);
    }
#undef IN
#undef SEAM
}

extern "C" void kernel_launch(void* const* d_in, const int* in_sizes, int n_in, void* d_out, int out_size, void* d_ws, size_t ws_size, hipStream_t stream) {
    static int grid = 0;
    if (grid == 0) {
        if (n_in != 21 || in_sizes[0] != MLAT * DM || out_size != MLAT * DM || ws_size < WS_END) {
            fprintf(stderr, "kernel_launch: unexpected shapes: n_in %d in0 %d out %d ws %zu (need >= %zu)\n", n_in, n_in > 0 ? in_sizes[0] : -1, out_size, ws_size, (size_t)WS_END); grid = -1; return; }
        int dev = 0, cus = 0, per_cu = 0;
        if (hipGetDevice(&dev) != hipSuccess || hipDeviceGetAttribute(&cus, hipDeviceAttributeMultiprocessorCount, dev) != hipSuccess) { grid = -1; return; }
        if (hipFuncSetAttribute((const void*)mk_fwd, hipFuncAttributeMaxDynamicSharedMemorySize, LDS_BYTES) != hipSuccess) { fprintf(stderr, "kernel_launch: hipFuncSetAttribute failed\n"); grid = -1; return; }
        if (hipOccupancyMaxActiveBlocksPerMultiprocessor(&per_cu, (const void*)mk_fwd, 512, LDS_BYTES) != hipSuccess || per_cu < 1) { fprintf(stderr, "kernel_launch: occupancy query says %d blocks per CU\n", per_cu); grid = -1; return; }
        grid = cus;
    }
    if (grid < 0) return;
    Args a{};
    for (int i = 0; i < 21; ++i) a.in[i] = (const float*)d_in[i];
    a.out = (float*)d_out; a.ws = (unsigned char*)d_ws;
#if MK_PER_PHASE
    for (int ph = 0; ph < NPH; ++ph) { a.ph_lo = ph; a.ph_hi = ph + 1; hipLaunchKernelGGL(mk_fwd, dim3(grid), dim3(512), LDS_BYTES, stream, a); }
#else
    a.ph_lo = 0; a.ph_hi = NPH;
    void* args[] = {&a};
    const hipError_t e = hipLaunchCooperativeKernel((const void*)mk_fwd, dim3(grid), dim3(512), args, LDS_BYTES, stream);
    if (e != hipSuccess) fprintf(stderr, "kernel_launch: cooperative launch failed: %s (grid %d)\n", hipGetErrorString(e), grid);
#endif
}
```

```cpp
#include <hip/hip_runtime.h>
#include <hip/hip_bf16.h>
#include <hip/hip_cooperative_groups.h>
#include <cstdio>
#include <cstdint>
namespace cg = cooperative_groups;
__device__ __forceinline__ int mk_lane_() { int l; asm volatile("v_mbcnt_lo_u32_b32 %0, -1, 0\n\tv_mbcnt_hi_u32_b32 %0, -1, %0" : "=v"(l)); return l; }
#define MK_LANE() mk_lane_()
#define MK_TID (mk_wid * 64 + MK_LANE())
namespace pg8 {
#define PG8_LAS __attribute__((address_space(3)))
typedef unsigned short bf16_t;
typedef short bf16x8 __attribute__((ext_vector_type(8)));
typedef float f32x4 __attribute__((ext_vector_type(4)));
typedef unsigned u32x4 __attribute__((ext_vector_type(4)));
constexpr int BM = 256, BK = 64, HALF = 128, HTB = HALF * BK * 2  , STAGE_BYTES = 8 * HTB, NXCD = 8, WGM = 4  ;

__host__ __device__ __forceinline__ int lds_byte(int r, int c) { const int st = (r >> 4) * 2 + (c >> 5), rr = r & 15, cc = c & 31, ob = rr * 64 + cc * 2; return st * 1024 + (ob ^ (((ob >> 9) & 1) << 5)); }
__host__ __device__ __forceinline__ void stage_rc(int b, int& R, int& C) { const int st = b / 1024, sb = b % 1024, swz = sb ^ (((sb >> 9) & 1) << 5); R = (st >> 1) * 16 + swz / 64; C = (st & 1) * 32 + (swz % 64) / 2; }
__host__ __device__ __forceinline__ int perm32(int rho) { const int n = rho >> 4, i = rho & 15; return 8 * (i >> 2) + 4 * n + (i & 3); }

struct Unit { int pm, pn; };
struct Gemm { const bf16_t* A; const bf16_t* Bt; int M, N, K; };

struct StaticOrder {
    int nM, nN, nwg, G, c, wgm;
    __host__ __device__ void init(int M, int N, int G_, int c_, int wgm_ = WGM) { nM = M / BM; nN = N / BM; nwg = nM * nN; G = G_; c = c_; wgm = wgm_; }
    __host__ __device__ bool next(int i, Unit& u) const {
        const long L = (long)i * G + c; if (L >= nwg) return false;
        int wgid = (int)L; { const int q = nwg / NXCD, r = nwg % NXCD, xcd = wgid % NXCD, off = wgid / NXCD; wgid = (xcd < r ? xcd * (q + 1) : r * (q + 1) + (xcd - r) * q) + off; }
        const int nig = wgm * nN, gid = wgid / nig, fm = gid * wgm, gsz = (nM - fm) < wgm ? (nM - fm) : wgm;
        u.pm = fm + ((wgid % nig) % gsz); u.pn = (wgid % nig) / gsz; return true;
    }
    __device__ __forceinline__ void a_ready(const Unit&) const {}
    __device__ __forceinline__ void done(const Unit&) const {}
};

__device__ __forceinline__ unsigned cvt_pk_bf16(float lo, float hi) { unsigned r; asm volatile("v_cvt_pk_bf16_f32 %0, %1, %2" : "=v"(r) : "v"(lo), "v"(hi)); return r; }
typedef float f32x2 __attribute__((ext_vector_type(2)));
template <class Epi, class Sched, bool ALIGN_EPI = false, bool SP2 = false>
__device__ __forceinline__ void gemm_phase(PG8_LAS unsigned char* lds, const Gemm g, const Sched& S, const Epi& E, const int mk_wid) {
    const int tid = MK_TID, wid = mk_wid, lane = tid & 63, wr = wid >> 2, wc = wid & 3, fr = lane & 15, fq = lane >> 4;
    const int K = g.K, nt = K / BK;
    unsigned voffA[2], voffB[2];
#pragma unroll
    for (int i = 0; i < 2; ++i) { int R, C; stage_rc(tid * 16 + i * 8192, R, C); const int Rb = Epi::PERM ? ((R & ~31) + perm32(R & 31)) : R;
        voffA[i] = (unsigned)(R * K + C) * 2u; voffB[i] = (unsigned)(Rb * K + C) * 2u; }
    const size_t kstep = (size_t)(BK * 2);
    const size_t hstep = (size_t)HALF * K * 2;
    const size_t tstep = 2 * hstep;
    const unsigned ldsw = (unsigned)wid * 1024u;
    const int aoff = lds_byte(wr * 64 + fr, fq * 8), boff = lds_byte(wc * 32 + fr, fq * 8);
#define PG8_SA(b, h) (((b) * 2 + (h)) * HTB)
#define PG8_SB(b, h) ((4 + (b) * 2 + (h)) * HTB)
#define PG8_STAGE(bufoff, gbase, voff) do { _Pragma("unroll") for (int _i = 0; _i < 2; ++_i) \
        __builtin_amdgcn_global_load_lds((const unsigned*)((const char*)(gbase) + (voff)[_i]), (PG8_LAS unsigned*)(lds + (bufoff) + ldsw + _i * 8192), 16, 0, 0); } while (0)
#define PG8_LDA(dst, b, h) do { _Pragma("unroll") for (int m = 0; m < 4; ++m) _Pragma("unroll") for (int k = 0; k < 2; ++k) dst[m][k] = *(const PG8_LAS bf16x8*)(lds + PG8_SA(b, h) + aoff + m * 2048 + k * 1024); } while (0)
#define PG8_LDB(dst, b, h) do { _Pragma("unroll") for (int n = 0; n < 2; ++n) _Pragma("unroll") for (int k = 0; k < 2; ++k) dst[n][k] = *(const PG8_LAS bf16x8*)(lds + PG8_SB(b, h) + boff + n * 2048 + k * 1024); } while (0)
#define PG8_MMA(ai, bj, At, Bt) do { __builtin_amdgcn_s_setprio(1); _Pragma("unroll") for (int m = 0; m < 4; ++m) _Pragma("unroll") for (int n = 0; n < 2; ++n) _Pragma("unroll") for (int k = 0; k < 2; ++k) \
        acc[ai][bj][m][n] = __builtin_amdgcn_mfma_f32_16x16x32_bf16(Bt[n][k], At[m][k], acc[ai][bj][m][n], 0, 0, 0); __builtin_amdgcn_s_setprio(0); } while (0)
#define PG8_WAIT_V(n) asm volatile("s_waitcnt vmcnt(" #n ")" ::: "memory")
#define PG8_WAIT_L(n) asm volatile("s_waitcnt lgkmcnt(" #n ")" ::: "memory")
#define PG8_BAR __builtin_amdgcn_s_barrier()
#define PG8_SCHED __builtin_amdgcn_sched_barrier(0)
    Unit cur, nxt; int ui = 0;
    if (!S.next(0, cur)) return;
    f32x4 acc[2][2][4][2];
#pragma unroll
    for (int a = 0; a < 2; ++a)
#pragma unroll
        for (int b = 0; b < 2; ++b)
#pragma unroll
            for (int m = 0; m < 4; ++m)
#pragma unroll
                for (int n = 0; n < 2; ++n) acc[a][b][m][n] = (f32x4){0.f, 0.f, 0.f, 0.f};
    bf16x8 At[4][2], B0[2][2], B1[2][2];
    const char* cA = (const char*)g.A + (size_t)cur.pm * tstep; const char* cB = (const char*)g.Bt + (size_t)cur.pn * tstep;
    S.a_ready(cur);
    if constexpr (SP2) {
        PG8_STAGE(PG8_SB(0, 0), cB, voffB); PG8_STAGE(PG8_SB(0, 1), cB + hstep, voffB); PG8_STAGE(PG8_SA(0, 0), cA, voffA); PG8_STAGE(PG8_SA(0, 1), cA + hstep, voffA);
        if (wr == 1) PG8_BAR;
        PG8_WAIT_V(2); PG8_BAR;
        PG8_STAGE(PG8_SB(1, 0), cB + kstep, voffB); PG8_STAGE(PG8_SA(1, 0), cA + kstep, voffA); PG8_STAGE(PG8_SB(1, 1), cB + hstep + kstep, voffB);
        PG8_WAIT_V(6); PG8_BAR;
    } else {
        PG8_STAGE(PG8_SB(0, 0), cB, voffB); PG8_STAGE(PG8_SA(0, 0), cA, voffA); PG8_STAGE(PG8_SB(0, 1), cB + hstep, voffB); PG8_STAGE(PG8_SA(0, 1), cA + hstep, voffA);
        if (wr == 1) PG8_BAR;
        PG8_WAIT_V(4); PG8_BAR;
        PG8_STAGE(PG8_SB(1, 0), cB + kstep, voffB); PG8_STAGE(PG8_SA(1, 0), cA + kstep, voffA); PG8_STAGE(PG8_SB(1, 1), cB + hstep + kstep, voffB);
        PG8_WAIT_V(6); PG8_BAR;
    }
    for (;;) {
        const bool has_next = S.next(ui + 1, nxt);
        const char* nA = has_next ? (const char*)g.A + (size_t)nxt.pm * tstep : cA; const char* nB = has_next ? (const char*)g.Bt + (size_t)nxt.pn * tstep : cB;
        for (int t = 0; t < nt; t += 2) {
            const bool last = (t == nt - 2);
            const char* a1 = cA + (size_t)(t + 1) * kstep;
            const char* a2 = last ? nA : cA + (size_t)(t + 2) * kstep; const char* b2 = last ? nB : cB + (size_t)(t + 2) * kstep;
            const char* a3 = a2 + kstep; const char* b3 = b2 + kstep;
            if (last && has_next) S.a_ready(nxt);
            if constexpr (SP2) {
            PG8_LDB(B0, 0, 0); PG8_LDB(B1, 0, 1); PG8_SCHED; PG8_LDA(At, 0, 0); PG8_STAGE(PG8_SA(1, 1), a1 + hstep, voffA);
            PG8_WAIT_V(8); PG8_WAIT_L(0); PG8_BAR; PG8_MMA(0, 0, At, B0); PG8_MMA(0, 1, At, B1); PG8_BAR; PG8_SCHED;
            PG8_LDA(At, 0, 1); PG8_STAGE(PG8_SB(0, 0), b2, voffB); PG8_STAGE(PG8_SB(0, 1), b2 + hstep, voffB); PG8_STAGE(PG8_SA(0, 0), a2, voffA);
            PG8_WAIT_V(8); PG8_WAIT_L(0); PG8_BAR; PG8_MMA(1, 0, At, B0); PG8_MMA(1, 1, At, B1); PG8_BAR; PG8_SCHED;
            PG8_LDB(B0, 1, 0); PG8_LDB(B1, 1, 1); PG8_SCHED; PG8_LDA(At, 1, 0); PG8_STAGE(PG8_SA(0, 1), a2 + hstep, voffA);
            PG8_WAIT_V(8); PG8_WAIT_L(0); PG8_BAR; PG8_MMA(0, 0, At, B0); PG8_MMA(0, 1, At, B1); PG8_BAR; PG8_SCHED;
            PG8_LDA(At, 1, 1); PG8_STAGE(PG8_SB(1, 0), b3, voffB); PG8_STAGE(PG8_SB(1, 1), b3 + hstep, voffB); PG8_STAGE(PG8_SA(1, 0), a3, voffA);
            PG8_WAIT_V(8); PG8_WAIT_L(0); PG8_BAR; PG8_MMA(1, 0, At, B0); PG8_MMA(1, 1, At, B1); PG8_BAR; PG8_SCHED;
            } else {
            PG8_LDB(B0, 0, 0); PG8_SCHED; PG8_LDA(At, 0, 0); PG8_STAGE(PG8_SA(1, 1), a1 + hstep, voffA);
            PG8_WAIT_L(8); PG8_BAR; PG8_WAIT_L(0); PG8_MMA(0, 0, At, B0); PG8_BAR; PG8_SCHED;
            PG8_LDB(B1, 0, 1); PG8_STAGE(PG8_SB(0, 0), b2, voffB);
            PG8_BAR; PG8_WAIT_L(0); PG8_MMA(0, 1, At, B1); PG8_BAR;
            PG8_LDA(At, 0, 1); PG8_STAGE(PG8_SA(0, 0), a2, voffA);
            PG8_BAR; PG8_WAIT_L(0); PG8_MMA(1, 0, At, B0); PG8_BAR; PG8_SCHED;
            PG8_STAGE(PG8_SB(0, 1), b2 + hstep, voffB);
            PG8_WAIT_V(6); PG8_BAR; PG8_MMA(1, 1, At, B1); PG8_BAR;
            PG8_LDB(B0, 1, 0); PG8_SCHED; PG8_LDA(At, 1, 0); PG8_STAGE(PG8_SA(0, 1), a2 + hstep, voffA);
            PG8_WAIT_L(8); PG8_BAR; PG8_WAIT_L(0); PG8_MMA(0, 0, At, B0); PG8_BAR; PG8_SCHED;
            PG8_LDB(B1, 1, 1); PG8_STAGE(PG8_SB(1, 0), b3, voffB);
            PG8_BAR; PG8_WAIT_L(0); PG8_MMA(0, 1, At, B1); PG8_BAR;
            PG8_LDA(At, 1, 1); PG8_STAGE(PG8_SA(1, 0), a3, voffA);
            PG8_BAR; PG8_WAIT_L(0); PG8_MMA(1, 0, At, B0); PG8_BAR; PG8_SCHED;
            PG8_STAGE(PG8_SB(1, 1), b3 + hstep, voffB);
            PG8_WAIT_V(6); PG8_BAR; PG8_MMA(1, 1, At, B1); PG8_BAR;
            }
        }
        if constexpr (ALIGN_EPI) { if (wr == 0) PG8_BAR; }
        if constexpr (!Epi::AFTER_DRAIN) { E(acc, cur, wr, wc, fr, fq); S.done(cur); }
        if (!has_next) break;
#pragma unroll
        for (int a = 0; a < 2; ++a)
#pragma unroll
            for (int b = 0; b < 2; ++b)
#pragma unroll
                for (int m = 0; m < 4; ++m)
#pragma unroll
                    for (int n = 0; n < 2; ++n) acc[a][b][m][n] = (f32x4){0.f, 0.f, 0.f, 0.f};
        cur = nxt; cA = nA; cB = nB; ++ui;
        if constexpr (ALIGN_EPI) { if (wr == 1) PG8_BAR; }
    }
    PG8_WAIT_V(0);
    if constexpr (!ALIGN_EPI) { if (wr == 0) PG8_BAR; }
    PG8_BAR;
    if constexpr (Epi::AFTER_DRAIN) { E.fused(acc, cur, wr, wc, fr, fq, lds, wid, lane); S.done(cur); }
#undef PG8_SA
#undef PG8_SB
#undef PG8_STAGE
#undef PG8_LDA
#undef PG8_LDB
#undef PG8_MMA
#undef PG8_WAIT_V
#undef PG8_WAIT_L
#undef PG8_BAR
#undef PG8_SCHED
}
}
namespace att {
using bf16 = __hip_bfloat16;
constexpr int   D = 128, NW = 8, QBLK = 32, KVBLK = 64;
constexpr float SCALE = 0.088388347648318440f;
constexpr float THR = 8.f;
constexpr int LDQ = 1024, LDK = 256, LDO = 1024;
constexpr size_t SHM_V = KVBLK * D * 2, SHM_K = KVBLK * D * 2, SHM_ATTN = 2 * SHM_V + 2 * SHM_K + NW * 64 * 4;
using bf16x8 = __attribute__((ext_vector_type(8))) short;
using s16x4  = __attribute__((ext_vector_type(4))) short;
using f32x16 = __attribute__((ext_vector_type(16))) float;
using f32x8  = __attribute__((ext_vector_type(8))) float;
using u32x4  = __attribute__((ext_vector_type(4))) unsigned;
#define KSWZ(row, colB) ((row) * 256 + ((colB) ^ (((row) & 7) << 4)))
#define SBAR() __builtin_amdgcn_sched_barrier(0)
__device__ __forceinline__ int crow(int r, int hi) { return (r & 3) + 8 * (r >> 2) + 4 * hi; }
__device__ __forceinline__ unsigned cvtpk(float lo, float hi) {
  unsigned r; asm volatile("v_cvt_pk_bf16_f32 %0, %1, %2" : "=v"(r) : "v"(lo), "v"(hi)); return r;
}
template <typename TIn> struct Stage;
template <> struct Stage<bf16>  { using T = bf16x8;
  __device__ static __forceinline__ T ld8(const bf16* p) { return *reinterpret_cast<const bf16x8*>(p); }
  __device__ static __forceinline__ bf16x8 tobf(T x) { return x; } };
template <> struct Stage<float> { using T = f32x8;
  __device__ static __forceinline__ T ld8(const float* p) { return *reinterpret_cast<const f32x8*>(p); }
  __device__ static __forceinline__ bf16x8 tobf(T x) {
    u32x4 w = {cvtpk(x[0], x[1]), cvtpk(x[2], x[3]), cvtpk(x[4], x[5]), cvtpk(x[6], x[7])}; return *reinterpret_cast<bf16x8*>(&w); } };

__device__ __forceinline__ void partialSM(f32x16& p0, f32x16& p1, float& m_reg, float& mn, float& alpha) {
  constexpr float C = SCALE * 1.4426950408889634f;
  float pmax = p0[0]; for (int r = 1; r < 16; ++r) pmax = fmaxf(pmax, p0[r]); for (int r = 0; r < 16; ++r) pmax = fmaxf(pmax, p1[r]);
  { auto rr = __builtin_amdgcn_permlane32_swap(__float_as_uint(pmax), __float_as_uint(pmax), false, false);
    pmax = fmaxf(__uint_as_float(rr[0]), __uint_as_float(rr[1])); }
  if (__builtin_expect(__all(pmax - m_reg <= THR / SCALE), 1)) { mn = m_reg; alpha = 1.f; }
  else { mn = fmaxf(m_reg, pmax); alpha = __builtin_amdgcn_exp2f((m_reg - mn) * C); m_reg = mn; }
  float mnC = -mn * C;
  for (int r = 0; r < 16; ++r) p0[r] = fmaf(p0[r], C, mnC); for (int r = 0; r < 16; ++r) p1[r] = fmaf(p1[r], C, mnC);
  for (int r = 0; r < 16; ++r) p0[r] = __builtin_amdgcn_exp2f(p0[r]);
}
__device__ __forceinline__ void finishSM(f32x16& p0, f32x16& p1, float alpha, float& l_reg, bf16x8& pa0, bf16x8& pa1, bf16x8& pa2, bf16x8& pa3) {
  for (int r = 0; r < 16; ++r) p1[r] = __builtin_amdgcn_exp2f(p1[r]);
  float ps = 0; for (int r = 0; r < 16; ++r) ps += p0[r]; for (int r = 0; r < 16; ++r) ps += p1[r];
  { auto rr = __builtin_amdgcn_permlane32_swap(__float_as_uint(ps), __float_as_uint(ps), false, false);
    ps = __uint_as_float(rr[0]) + __uint_as_float(rr[1]); }
  l_reg = l_reg * alpha + ps;
#define PK4(P, BASE, OUT) do { unsigned a0 = cvtpk(P[BASE + 0], P[BASE + 1]), a1 = cvtpk(P[BASE + 2], P[BASE + 3]);   \
    unsigned b0 = cvtpk(P[BASE + 4], P[BASE + 5]), b1 = cvtpk(P[BASE + 6], P[BASE + 7]);                              \
    auto r0 = __builtin_amdgcn_permlane32_swap(a0, b0, false, false); auto r1 = __builtin_amdgcn_permlane32_swap(a1, b1, false, false); \
    u32x4 w = {r0[0], r1[0], r0[1], r1[1]}; OUT = *reinterpret_cast<bf16x8*>(&w); } while (0)
  PK4(p0, 0, pa0); PK4(p0, 8, pa1); PK4(p1, 0, pa2); PK4(p1, 8, pa3);
#undef PK4
}
__device__ __forceinline__ void qkt(f32x16& p0, f32x16& p1, const bf16* Ks, const bf16x8* qr, int r32, int hi) {
  p0 = f32x16{}; p1 = f32x16{};
  for (int d0 = 0; d0 < 8; ++d0) { int cb = (d0 * 16 + hi * 8) * 2;
    bf16x8 b0 = *reinterpret_cast<const bf16x8*>((const char*)Ks + KSWZ(r32, cb));
    bf16x8 b1 = *reinterpret_cast<const bf16x8*>((const char*)Ks + KSWZ(32 + r32, cb));
    p0 = __builtin_amdgcn_mfma_f32_32x32x16_bf16(b0, qr[d0], p0, 0, 0, 0);
    p1 = __builtin_amdgcn_mfma_f32_32x32x16_bf16(b1, qr[d0], p1, 0, 0, 0); }
}
__device__ __forceinline__ int v_st(int k, int c) { const int kk = (k & ~0xC) | ((k & 4) << 1) | ((k & 8) >> 1); return ((kk >> 3) * 4 + (c >> 5)) * 512 + ((kk & 7) * 32 + (c & 31)) * 2; }
__device__ __forceinline__ int v_rd_base(int lane) { return ((lane & 3) << 3) | (((lane >> 2) & 3) << 6) | (((lane >> 4) & 1) << 5) | (((lane >> 5) & 1) << 8); }
constexpr int v_rd_off(int d0, int ks, int half) { return d0 * 512 + ks * 4096 + half * 2048; }
template <int OFF> __device__ __forceinline__ s16x4 tr_read(int vb) {
  s16x4 r; asm volatile("ds_read_b64_tr_b16 %0, %1 offset:%2" : "=&v"(r) : "v"(vb), "i"(OFF) : "memory"); return r;
}
template <int D0> __device__ __forceinline__ void pv_one(f32x16& od, int vb, bf16x8 pa0, bf16x8 pa1, bf16x8 pa2, bf16x8 pa3) {
  const s16x4 l0 = tr_read<v_rd_off(D0, 0, 0)>(vb), h0 = tr_read<v_rd_off(D0, 0, 1)>(vb), l1 = tr_read<v_rd_off(D0, 1, 0)>(vb), h1 = tr_read<v_rd_off(D0, 1, 1)>(vb);
  const s16x4 l2 = tr_read<v_rd_off(D0, 2, 0)>(vb), h2 = tr_read<v_rd_off(D0, 2, 1)>(vb), l3 = tr_read<v_rd_off(D0, 3, 0)>(vb), h3 = tr_read<v_rd_off(D0, 3, 1)>(vb);
  asm volatile("s_waitcnt lgkmcnt(0)" ::: "memory"); SBAR();
#define PK(L, H) (bf16x8){L[0], L[1], L[2], L[3], H[0], H[1], H[2], H[3]}
  od = __builtin_amdgcn_mfma_f32_32x32x16_bf16(pa0, PK(l0, h0), od, 0, 0, 0);
  od = __builtin_amdgcn_mfma_f32_32x32x16_bf16(pa1, PK(l1, h1), od, 0, 0, 0);
  od = __builtin_amdgcn_mfma_f32_32x32x16_bf16(pa2, PK(l2, h2), od, 0, 0, 0);
  od = __builtin_amdgcn_mfma_f32_32x32x16_bf16(pa3, PK(l3, h3), od, 0, 0, 0);
#undef PK
}
__device__ __forceinline__ void pv_d0(f32x16* o, int vb, bf16x8 pa0, bf16x8 pa1, bf16x8 pa2, bf16x8 pa3) {
  pv_one<0>(o[0], vb, pa0, pa1, pa2, pa3); pv_one<1>(o[1], vb, pa0, pa1, pa2, pa3); pv_one<2>(o[2], vb, pa0, pa1, pa2, pa3); pv_one<3>(o[3], vb, pa0, pa1, pa2, pa3);
}
__device__ __forceinline__ float bf2f(short s) { return __uint_as_float(((unsigned)(unsigned short)s) << 16); }
__device__ __forceinline__ void attn_unit(const bf16* Qb, const bf16* __restrict__ Kh, const bf16* __restrict__ Vh, bf16* Ob, int seq, char* lds,
                                          const float* __restrict__ rope, const float* __restrict__ qg, const int mk_wid) {
  using St = Stage<bf16>;
  int tid = MK_TID; asm volatile("" : "+v"(tid));
  const int wid = mk_wid, lane = tid & 63, r32 = lane & 31, hi = lane >> 5;
  bf16* V_lds = (bf16*)lds; bf16* K_lds = (bf16*)(lds + 2 * SHM_V);
  float* ws = (float*)(lds + 2 * SHM_V + 2 * SHM_K) + wid * 64; float* li_l = ws; float* al_l = ws + 32;
  float m_reg = -1e30f, l_reg = 0; f32x16 o[4] = {}; bf16x8 qr[8];
  const int sr = tid >> 4, sc = (tid & 15) * 8, vst0 = v_st(sr, sc), vst1 = v_st(32 + sr, sc);
  const int vb0 = (int)(uintptr_t)V_lds + v_rd_base(lane);
  struct { typename St::T vs0, vs1, ks0, ks1; } sr_[2];
#define SLOAD(i, k0) do { sr_[i].vs0 = St::ld8(&Vh[(long)((k0) + sr) * LDK + sc]); sr_[i].vs1 = St::ld8(&Vh[(long)((k0) + 32 + sr) * LDK + sc]); \
    sr_[i].ks0 = St::ld8(&Kh[(long)((k0) + sr) * LDK + sc]); sr_[i].ks1 = St::ld8(&Kh[(long)((k0) + 32 + sr) * LDK + sc]); } while (0)
#define SWRITE(b, i) do { *(bf16x8*)((char*)V_lds + (b) * SHM_V + vst0) = St::tobf(sr_[i].vs0);          \
    *(bf16x8*)((char*)V_lds + (b) * SHM_V + vst1) = St::tobf(sr_[i].vs1); int kc = sc * 2;               \
    *(bf16x8*)((char*)K_lds + (b) * SHM_K + KSWZ(sr, kc)) = St::tobf(sr_[i].ks0);                       \
    *(bf16x8*)((char*)K_lds + (b) * SHM_K + KSWZ(32 + sr, kc)) = St::tobf(sr_[i].ks1); } while (0)
#define SWAIT() do { asm volatile("s_waitcnt vmcnt(4)" ::: "memory"); } while (0)
#define RESC(a) do { if (__any((a) < 1.f)) { if (hi == 0) al_l[r32] = (a); asm volatile("s_waitcnt lgkmcnt(0)" ::: "memory"); \
    for (int d = 0; d < 4; ++d) for (int r = 0; r < 16; ++r) o[d][r] *= al_l[crow(r, hi)]; } } while (0)
  constexpr int SE = 0, SO = 1;
  {
    int tp = MK_TID; asm volatile("" : "+v"(tp)); const int r32 = tp & 31, hi = (tp >> 5) & 1;
    const bf16* Qw = Qb + (long)(wid * QBLK + r32) * LDQ + hi * 8;
    const float* rp = rope + ((long)(wid * QBLK + r32) * 64 + hi * 4) * 2;
    bf16x8 rw[8]; float4 gA[8], gB[8], cA[8], cB[8];
#pragma unroll
    for (int d0 = 0; d0 < 8; ++d0) { rw[d0] = *reinterpret_cast<const bf16x8*>(Qw + d0 * 16);
      gA[d0] = *reinterpret_cast<const float4*>(qg + d0 * 16 + hi * 8); gB[d0] = *reinterpret_cast<const float4*>(qg + d0 * 16 + hi * 8 + 4);
      cA[d0] = *reinterpret_cast<const float4*>(rp + d0 * 16); cB[d0] = *reinterpret_cast<const float4*>(rp + d0 * 16 + 4); }
    float ss = 0.f;
#pragma unroll
    for (int d0 = 0; d0 < 8; ++d0)
#pragma unroll
      for (int e = 0; e < 8; ++e) { const float f = bf2f(rw[d0][e]); ss += f * f; }
    { auto rr = __builtin_amdgcn_permlane32_swap(__float_as_uint(ss), __float_as_uint(ss), false, false); ss = __uint_as_float(rr[0]) + __uint_as_float(rr[1]); }
    const float rinv = rsqrtf(ss * (1.f / 128.f) + 1e-6f);
#pragma unroll
    for (int d0 = 0; d0 < 8; ++d0) {
      const float4 g0 = gA[d0], g1 = gB[d0], cs0 = cA[d0], cs1 = cB[d0];
      const float x0 = bf2f(rw[d0][0]) * rinv * g0.x, x1 = bf2f(rw[d0][1]) * rinv * g0.y, x2 = bf2f(rw[d0][2]) * rinv * g0.z, x3 = bf2f(rw[d0][3]) * rinv * g0.w;
      const float x4 = bf2f(rw[d0][4]) * rinv * g1.x, x5 = bf2f(rw[d0][5]) * rinv * g1.y, x6 = bf2f(rw[d0][6]) * rinv * g1.z, x7 = bf2f(rw[d0][7]) * rinv * g1.w;
      u32x4 w = {cvtpk(x0 * cs0.x - x1 * cs0.y, x0 * cs0.y + x1 * cs0.x), cvtpk(x2 * cs0.z - x3 * cs0.w, x2 * cs0.w + x3 * cs0.z),
                 cvtpk(x4 * cs1.x - x5 * cs1.y, x4 * cs1.y + x5 * cs1.x), cvtpk(x6 * cs1.z - x7 * cs1.w, x6 * cs1.w + x7 * cs1.z)};
      qr[d0] = *reinterpret_cast<bf16x8*>(&w);
    }
  }
  f32x16 pA0, pA1, pB0, pB1; float mnA, mnB, alA, alB; bf16x8 pa0, pa1, pa2, pa3; const int NT = seq / KVBLK;
  SLOAD(SE, 0); asm volatile("s_waitcnt vmcnt(0)" ::: "memory"); SWRITE(0, SE); __syncthreads();
  qkt(pA0, pA1, K_lds, qr, r32, hi); partialSM(pA0, pA1, m_reg, mnA, alA);
  SLOAD(SO, KVBLK); if (2 < NT) SLOAD(SE, 2 * KVBLK);
  SWAIT(); SWRITE(1, SO); __syncthreads();
  for (int j = 1; j + 1 < NT; j += 2) {
    SBAR(); qkt(pB0, pB1, (bf16*)((char*)K_lds + SHM_K), qr, r32, hi);
    finishSM(pA0, pA1, alA, l_reg, pa0, pa1, pa2, pa3); SBAR();
    SLOAD(SO, (j + 2) * KVBLK); SBAR();
    pv_d0(o, vb0, pa0, pa1, pa2, pa3); partialSM(pB0, pB1, m_reg, mnB, alB);
    __syncthreads(); SWAIT(); SWRITE(0, SE);
    RESC(alB); __syncthreads();
    SBAR(); qkt(pA0, pA1, K_lds, qr, r32, hi);
    finishSM(pB0, pB1, alB, l_reg, pa0, pa1, pa2, pa3); SBAR();
    if (j + 3 < NT) SLOAD(SE, (j + 3) * KVBLK); SBAR();
    pv_d0(o, vb0 + (int)SHM_V, pa0, pa1, pa2, pa3); partialSM(pA0, pA1, m_reg, mnA, alA);
    __syncthreads(); SWAIT(); SWRITE(1, SO);
    RESC(alA); __syncthreads();
  }
  SBAR(); qkt(pB0, pB1, (bf16*)((char*)K_lds + SHM_K), qr, r32, hi);
  finishSM(pA0, pA1, alA, l_reg, pa0, pa1, pa2, pa3); SBAR();
  pv_d0(o, vb0, pa0, pa1, pa2, pa3); partialSM(pB0, pB1, m_reg, mnB, alB);
  __syncthreads(); RESC(alB);
  finishSM(pB0, pB1, alB, l_reg, pa0, pa1, pa2, pa3); SBAR();
  pv_d0(o, vb0 + (int)SHM_V, pa0, pa1, pa2, pa3);
  if (hi == 0) li_l[r32] = l_reg; asm volatile("s_waitcnt lgkmcnt(0)" ::: "memory");
  float rli[16];
#pragma unroll
  for (int r = 0; r < 16; ++r) rli[r] = __builtin_amdgcn_rcpf(li_l[crow(r, hi)]);
  __syncthreads();
  { int te = MK_TID; asm volatile("" : "+v"(te)); const int lane = te & 63, r32 = lane & 31, hi = lane >> 5;
    unsigned short* stg = (unsigned short*)(lds + wid * 8192);
#pragma unroll
    for (int r = 0; r < 16; ++r) { const int orow = crow(r, hi);
#pragma unroll
      for (int d0 = 0; d0 < 4; ++d0) stg[orow * 128 + d0 * 32 + r32] = (unsigned short)(cvtpk(o[d0][r] * rli[r], 0.f) & 0xffffu); }
    asm volatile("s_waitcnt lgkmcnt(0)" ::: "memory");
    bf16* Ow = Ob + (long)(wid * QBLK) * LDO;
#pragma unroll
    for (int i = 0; i < 8; ++i) { const int row = i * 4 + (lane >> 4), ch = lane & 15; const u32x4 v = *(const u32x4*)(stg + row * 128 + ch * 8); *(u32x4*)(Ow + (long)row * LDO + ch * 8) = v; } }
  __syncthreads();
#undef SLOAD
#undef SWRITE
#undef SWAIT
#undef RESC
}
}
constexpr int NB = 16, T = 2048, TC = 256, TA = T + TC, DM = 1024;
constexpr int MLAT = NB * T, MALL = NB * TA;
constexpr int NIN = 6912;
constexpr int DFF = 2816;
constexpr float EPS = 1e-6f;
constexpr size_t MiB = 1u << 20;
constexpr size_t WS_MOD = 1 * MiB, WS_ROPE = 2 * MiB, WS_WIN = 4 * MiB, WS_WAP = 18 * MiB, WS_WGP = 20 * MiB, WS_WOUT = 22 * MiB, WS_WFI = 24 * MiB, WS_WFO = 36 * MiB,
                 WS_H1 = 42 * MiB, WS_Q = 114 * MiB, WS_K = 178 * MiB, WS_V = 196 * MiB, WS_GQ = 214 * MiB, WS_GK = 250 * MiB, WS_GV = 286 * MiB, WS_GG = 358 * MiB,
                 WS_LR = 422 * MiB, WS_OB = 426 * MiB, WS_END = 490 * MiB;
constexpr size_t WS_OF = WS_H1, WS_T1 = WS_GQ  , WS_H2 = WS_H1, WS_MRG = WS_GV, WS_ACT = WS_Q, WS_X1 = WS_OB  ;
constexpr int LDS_BYTES = 147456;
constexpr int NPH = 11;
constexpr int WI_IN = 16 * 216, WI_PROJ = WI_IN + 3 * 16 * 32, WI_ALL = WI_PROJ + 16 * 176 + 44 * 32;

typedef unsigned short u16;
typedef unsigned v4u __attribute__((ext_vector_type(4)));
typedef unsigned v2u __attribute__((ext_vector_type(2)));
typedef float f32x4 __attribute__((ext_vector_type(4)));
#define LAS __attribute__((address_space(3)))

struct Args { const float* in[21]; float* out; unsigned char* ws; int ph_lo, ph_hi; };

__device__ __forceinline__ float bf2f(u16 u) { return __uint_as_float((unsigned)u << 16); }
typedef float f32x2_t __attribute__((ext_vector_type(2))); typedef __bf16 bf16x2_t __attribute__((ext_vector_type(2)));
__device__ __forceinline__ unsigned pk2(float lo, float hi) { f32x2_t v = {lo, hi}; bf16x2_t b = __builtin_convertvector(v, bf16x2_t); return __builtin_bit_cast(unsigned, b); }
__device__ __forceinline__ u16 f2bf(float f) { return (u16)(pk2(f, 0.f) & 0xffffu); }
__device__ __forceinline__ float wave_sum(float v) {
#pragma unroll
    for (int o = 1; o < 64; o <<= 1) v += __shfl_xor(v, o);
    return v;
}
__device__ __forceinline__ float sigmoidf_(float x) { return __builtin_amdgcn_rcpf(1.f + __expf(-x)); }

struct EpiInProj {
    static constexpr bool PERM = true, AFTER_DRAIN = false;
    unsigned char* ws; u16* MG;
    __device__ __forceinline__ void operator()(const pg8::f32x4 (&acc)[2][2][4][2], const pg8::Unit& u, int wr, int wc, int fr, int fq) const {
        const int b = u.pm / 9, j = u.pm % 9, pn = u.pn; const bool isctx = (j == 0);
        const long rall = (long)u.pm * 256, rlat = (long)b * T + (j - 1) * 256;
        u16* base; int ld, colt; long row0;
        if (pn < 4)       { if (isctx) return; base = (u16*)(ws + WS_Q);  ld = 1024; colt = pn * 256;        row0 = rlat; }
        else if (pn == 4) {                    base = (u16*)(ws + WS_K);  ld = 256;  colt = 0;               row0 = rall; }
        else if (pn == 5) {                    base = (u16*)(ws + WS_V);  ld = 256;  colt = 0;               row0 = rall; }
        else if (pn < 8)  { if (isctx) return; base = (u16*)(ws + WS_GQ); ld = 512;  colt = (pn - 6) * 256;  row0 = rall; }
        else if (pn < 10) {                    base = (u16*)(ws + WS_GK); ld = 512;  colt = (pn - 8) * 256;  row0 = rall; }
        else if (pn < 14) {                    base = (u16*)(ws + WS_GV); ld = 1024; colt = (pn - 10) * 256; row0 = rall; }
        else if (pn < 18) { if (isctx) return; base = (u16*)(ws + WS_GG); ld = 1024; colt = (pn - 14) * 256; row0 = rlat; }
        else if (pn < 26) { if (isctx) return; base = MG;                 ld = 2048; colt = (pn - 18) * 256; row0 = rlat; }
        else              {                    base = (u16*)(ws + WS_LR); ld = 32;   colt = 0;               row0 = rall; }
        const bool lr = (pn == 26);
        if (lr && wc != 0) return;
        const int col0 = colt + wc * 32 + 8 * fq;
#pragma unroll
        for (int ai = 0; ai < 2; ++ai)
#pragma unroll
            for (int m = 0; m < 4; ++m) { u16* rowp = base + (size_t)(row0 + ai * 128 + wr * 64 + m * 16 + fr) * ld + col0;
#pragma unroll
                for (int bj = 0; bj < 2; ++bj) { if (lr && bj) continue;
                    const pg8::f32x4 v0 = acc[ai][bj][m][0], v1 = acc[ai][bj][m][1];
                    v4u w; w.x = pk2(v0[0], v0[1]); w.y = pk2(v0[2], v0[3]); w.z = pk2(v1[0], v1[1]); w.w = pk2(v1[2], v1[3]);
                    *(v4u*)(rowp + bj * 128) = w; } }
    }
};
struct InProjOrder {
    pg8::StaticOrder so; int G, c;
    __device__ void init(int G_, int c_) { so.init(128 * 256, 26 * 256, G_, c_); G = G_; c = c_; }
    __device__ bool next(int i, pg8::Unit& u) const {
        if (so.next(i, u)) { u.pm = (u.pm >> 3) * 9 + 1 + (u.pm & 7); return true; }
        const long q = (long)i * G + c - 3328; if (q < 0 || q >= 128) return false;
        const int b = (int)(q >> 3), t = (int)(q & 7);
        u.pm = b * 9; u.pn = t == 0 ? 4 : (t == 1 ? 5 : (t < 4 ? 6 + t : 6 + t)); return true;
    }
    __device__ __forceinline__ void a_ready(const pg8::Unit&) const {}
    __device__ __forceinline__ void done(const pg8::Unit&) const {}
};
template <int MODE> struct EpiMerge {
    static constexpr bool PERM = true, AFTER_DRAIN = false;
    const u16* MG; u16* T1; u16* MRG;
    __device__ __forceinline__ void operator()(const pg8::f32x4 (&acc)[2][2][4][2], const pg8::Unit& u, int wr, int wc, int fr, int fq) const {
        const int col0 = u.pn * 256 + wc * 32 + 8 * fq;
#pragma unroll
        for (int ai = 0; ai < 2; ++ai) {
            v4u gwv[4][2], twv[4][2];
#pragma unroll
            for (int m = 0; m < 4; ++m) { const size_t row = (size_t)u.pm * 256 + ai * 128 + wr * 64 + m * 16 + fr;
#pragma unroll
                for (int bj = 0; bj < 2; ++bj) { const int col = col0 + bj * 128;
                    gwv[m][bj] = __builtin_nontemporal_load((const v4u*)(MG + row * 2048 + MODE * 1024 + col));
                    twv[m][bj] = (MODE == 1) ? __builtin_nontemporal_load((const v4u*)(T1 + row * 1024 + col)) : (v4u){0u, 0u, 0u, 0u}; } }
#pragma unroll
            for (int m = 0; m < 4; ++m) { const size_t row = (size_t)u.pm * 256 + ai * 128 + wr * 64 + m * 16 + fr;
#pragma unroll
                for (int bj = 0; bj < 2; ++bj) { const int col = col0 + bj * 128;
                    const pg8::f32x4 v0 = acc[ai][bj][m][0], v1 = acc[ai][bj][m][1];
                    const float r[8] = {v0[0], v0[1], v0[2], v0[3], v1[0], v1[1], v1[2], v1[3]};
                    const unsigned gws[4] = {gwv[m][bj].x, gwv[m][bj].y, gwv[m][bj].z, gwv[m][bj].w};
                    const unsigned tws[4] = {twv[m][bj].x, twv[m][bj].y, twv[m][bj].z, twv[m][bj].w};
                    unsigned ow[4];
#pragma unroll
                    for (int e = 0; e < 4; ++e) {
                        float a0 = sigmoidf_(bf2f((u16)(gws[e] & 0xffffu))) * r[2 * e], a1 = sigmoidf_(bf2f((u16)(gws[e] >> 16))) * r[2 * e + 1];
                        if (MODE == 1) { a0 += bf2f((u16)(tws[e] & 0xffffu)); a1 += bf2f((u16)(tws[e] >> 16)); }
                        ow[e] = pk2(a0, a1); }
                    v4u w = {ow[0], ow[1], ow[2], ow[3]};
                    *(v4u*)((MODE == 0 ? T1 : MRG) + row * 1024 + col) = w; } }
        }
    }
};
struct EpiGateRes {
    static constexpr bool PERM = true, AFTER_DRAIN = false;
    const float* base; float* out; const float* gate;
    __device__ __forceinline__ void operator()(const pg8::f32x4 (&acc)[2][2][4][2], const pg8::Unit& u, int wr, int wc, int fr, int fq) const {
        const int col0 = u.pn * 256 + wc * 32 + 8 * fq; const int b = (u.pm * 256) / T;
        pg8::f32x4 gv[2][2];
#pragma unroll
        for (int bj = 0; bj < 2; ++bj)
#pragma unroll
            for (int n = 0; n < 2; ++n) gv[bj][n] = *(const pg8::f32x4*)(gate + (size_t)b * 6144 + col0 + bj * 128 + n * 4);
#pragma unroll
        for (int ai = 0; ai < 2; ++ai)
#pragma unroll
            for (int m = 0; m < 4; ++m) { const size_t off = ((size_t)u.pm * 256 + ai * 128 + wr * 64 + m * 16 + fr) * DM + col0;
#pragma unroll
                for (int bj = 0; bj < 2; ++bj)
#pragma unroll
                    for (int n = 0; n < 2; ++n) { const pg8::f32x4 bs = *(const pg8::f32x4*)(base + off + bj * 128 + n * 4);
                        *(pg8::f32x4*)(out + off + bj * 128 + n * 4) = bs + gv[bj][n] * acc[ai][bj][m][n]; } }
    }
};
template <bool IN_BF16> struct EpiGateResB {
    static constexpr bool PERM = true, AFTER_DRAIN = false;
    const void* base; void* out; const float* gate;
    __device__ __forceinline__ void operator()(const pg8::f32x4 (&acc)[2][2][4][2], const pg8::Unit& u, int wr, int wc, int fr, int fq) const {
        const int col0 = u.pn * 256 + wc * 32 + 8 * fq; const int b = (u.pm * 256) / T;
        pg8::f32x4 gv[2][2];
#pragma unroll
        for (int bj = 0; bj < 2; ++bj)
#pragma unroll
            for (int n = 0; n < 2; ++n) gv[bj][n] = *(const pg8::f32x4*)(gate + (size_t)b * 6144 + col0 + bj * 128 + n * 4);
#pragma unroll
        for (int ai = 0; ai < 2; ++ai) {
            pg8::f32x4 bs[4][2][2]; v4u bw[4][2];
#pragma unroll
            for (int m = 0; m < 4; ++m) { const size_t off = ((size_t)u.pm * 256 + ai * 128 + wr * 64 + m * 16 + fr) * DM + col0;
#pragma unroll
                for (int bj = 0; bj < 2; ++bj) {
                    if (IN_BF16) bw[m][bj] = __builtin_nontemporal_load((const v4u*)((const u16*)base + off + bj * 128));
                    else { bs[m][bj][0] = __builtin_nontemporal_load((const pg8::f32x4*)((const float*)base + off + bj * 128)); bs[m][bj][1] = __builtin_nontemporal_load((const pg8::f32x4*)((const float*)base + off + bj * 128 + 4)); } } }
#pragma unroll
            for (int m = 0; m < 4; ++m) { const size_t off = ((size_t)u.pm * 256 + ai * 128 + wr * 64 + m * 16 + fr) * DM + col0;
#pragma unroll
                for (int bj = 0; bj < 2; ++bj) {
                    pg8::f32x4 b0, b1;
                    if (IN_BF16) { const v4u w = bw[m][bj];
                        b0 = (pg8::f32x4){bf2f((u16)(w.x & 0xffffu)), bf2f((u16)(w.x >> 16)), bf2f((u16)(w.y & 0xffffu)), bf2f((u16)(w.y >> 16))};
                        b1 = (pg8::f32x4){bf2f((u16)(w.z & 0xffffu)), bf2f((u16)(w.z >> 16)), bf2f((u16)(w.w & 0xffffu)), bf2f((u16)(w.w >> 16))}; }
                    else { b0 = bs[m][bj][0]; b1 = bs[m][bj][1]; }
                    const pg8::f32x4 o0 = b0 + gv[bj][0] * acc[ai][bj][m][0], o1 = b1 + gv[bj][1] * acc[ai][bj][m][1];
                    if (IN_BF16) { *(pg8::f32x4*)((float*)out + off + bj * 128) = o0; *(pg8::f32x4*)((float*)out + off + bj * 128 + 4) = o1; }
                    else { v4u w; w.x = pk2(o0[0], o0[1]); w.y = pk2(o0[2], o0[3]); w.z = pk2(o1[0], o1[1]); w.w = pk2(o1[2], o1[3]); *(v4u*)((u16*)out + off + bj * 128) = w; } } }
        }
    }
};
struct EpiSwiglu {
    static constexpr bool PERM = true, AFTER_DRAIN = false;
    u16* ACT;
    __device__ __forceinline__ void operator()(const pg8::f32x4 (&acc)[2][2][4][2], const pg8::Unit& u, int wr, int wc, int fr, int fq) const {
        const int col0 = u.pn * 128 + wc * 32 + 8 * fq;
#pragma unroll
        for (int ai = 0; ai < 2; ++ai)
#pragma unroll
            for (int m = 0; m < 4; ++m) { const size_t row = (size_t)u.pm * 256 + ai * 128 + wr * 64 + m * 16 + fr;
                unsigned ow[4];
#pragma unroll
                for (int n = 0; n < 2; ++n) { const pg8::f32x4 av = acc[ai][0][m][n], bv = acc[ai][1][m][n];
                    float s[4];
#pragma unroll
                    for (int e = 0; e < 4; ++e) s[e] = av[e] * sigmoidf_(av[e]) * bv[e];
                    ow[2 * n] = pk2(s[0], s[1]); ow[2 * n + 1] = pk2(s[2], s[3]); }
                v4u w = {ow[0], ow[1], ow[2], ow[3]};
                *(v4u*)(ACT + row * DFF + col0) = w; }
    }
};
__device__ __forceinline__ void p_adaln(const Args& a, unsigned char* lds, const int mk_wid) {
    float* sl = (float*)lds;
    float* part = (float*)(lds + 17 * 1024 * 4);
    const int tid = MK_TID;
    const float* c = a.in[1]; const float* cctx = a.in[3]; const float* W = a.in[4]; const float* bada = a.in[5];
    float* MOD = (float*)(a.ws + WS_MOD);
    for (int i = tid; i < 17 * 1024; i += 512) { const float v = (i < 16 * 1024) ? c[i] : cctx[i - 16 * 1024]; sl[i] = v * __builtin_amdgcn_rcpf(1.f + __expf(-v)); }
    __syncthreads();
    for (int w = blockIdx.x; w < 192; w += gridDim.x) {
        const int col = w * 32 + (tid & 31), kg = tid >> 5;
        float acc[17];
#pragma unroll
        for (int v = 0; v < 17; ++v) acc[v] = 0.f;
        for (int kk = 0; kk < 64; kk += 16) { const int k = kg * 64 + kk; float wv[16];
#pragma unroll
            for (int j = 0; j < 16; ++j) wv[j] = __builtin_nontemporal_load(W + (size_t)(k + j) * 6144 + col);
#pragma unroll
            for (int v = 0; v < 17; ++v)
#pragma unroll
                for (int j4 = 0; j4 < 4; ++j4) { const f32x4 s4 = *(const f32x4*)(sl + v * 1024 + k + 4 * j4);
                    acc[v] += (s4.x * wv[4 * j4] + s4.y * wv[4 * j4 + 1]) + (s4.z * wv[4 * j4 + 2] + s4.w * wv[4 * j4 + 3]); } }
#pragma unroll
        for (int v = 0; v < 17; ++v) part[(kg * 17 + v) * 32 + (tid & 31)] = acc[v];
        __syncthreads();
        for (int i = tid; i < 17 * 32; i += 512) { const int v = i >> 5, cl = i & 31; float s = bada[w * 32 + cl];
            for (int g = 0; g < 16; ++g) s += part[(g * 17 + v) * 32 + cl];
            MOD[v * 6144 + w * 32 + cl] = s; }
        __syncthreads();
    }
}

__device__ __forceinline__ void transpose_item(const float* W, int ldw, int src_n0, int k0, u16* WT, int K, int dst_n0, bool zero, float* scr, int lane) {
    { const int kr = lane >> 3, n4 = (lane & 7) * 4; f32x4 v[8];
#pragma unroll
      for (int i = 0; i < 8; ++i) v[i] = zero ? (f32x4){0.f, 0.f, 0.f, 0.f} : __builtin_nontemporal_load((const f32x4*)(W + (size_t)(k0 + 8 * i + kr) * ldw + src_n0 + n4));
#pragma unroll
      for (int i = 0; i < 8; ++i) { float* d = scr + (8 * i + kr) * 33 + n4; d[0] = v[i].x; d[1] = v[i].y; d[2] = v[i].z; d[3] = v[i].w; } }
    asm volatile("s_waitcnt lgkmcnt(0)" ::: "memory");
    const int c = lane & 7;
#pragma unroll
    for (int j = 0; j < 4; ++j) { const int n = (lane >> 3) + 8 * j; const float* s = scr + (8 * c) * 33 + n;
        v4u o; o.x = pk2(s[0 * 33], s[1 * 33]); o.y = pk2(s[2 * 33], s[3 * 33]); o.z = pk2(s[4 * 33], s[5 * 33]); o.w = pk2(s[6 * 33], s[7 * 33]);
        *(v4u*)(WT + (size_t)(dst_n0 + n) * K + k0 + 8 * c) = o; }
    asm volatile("s_waitcnt lgkmcnt(0)" ::: "memory");
}
__device__ __forceinline__ void norm_mod_row2(const float* xrow0, const float* xrow1, const float* g, const float* shift0, const float* scale0, const float* shift1, const float* scale1, u16* orow0, u16* orow1, int lane) {
    const f32x4* xr0 = (const f32x4*)xrow0 + lane; const f32x4* xr1 = (const f32x4*)xrow1 + lane;
    f32x4 v0[4], v1[4]; float s0 = 0.f, s1 = 0.f;
#pragma unroll
    for (int j = 0; j < 4; ++j) { v0[j] = __builtin_nontemporal_load(xr0 + 64 * j); v1[j] = __builtin_nontemporal_load(xr1 + 64 * j); }
#pragma unroll
    for (int j = 0; j < 4; ++j) { s0 += (v0[j].x * v0[j].x + v0[j].y * v0[j].y) + (v0[j].z * v0[j].z + v0[j].w * v0[j].w); s1 += (v1[j].x * v1[j].x + v1[j].y * v1[j].y) + (v1[j].z * v1[j].z + v1[j].w * v1[j].w); }
#pragma unroll
    for (int o = 1; o < 64; o <<= 1) { s0 += __shfl_xor(s0, o); s1 += __shfl_xor(s1, o); }
    const float r0 = rsqrtf(s0 * (1.f / DM) + EPS), r1 = rsqrtf(s1 * (1.f / DM) + EPS);
    unsigned long long* o80 = (unsigned long long*)orow0 + lane; unsigned long long* o81 = (unsigned long long*)orow1 + lane;
#pragma unroll
    for (int j = 0; j < 4; ++j) { const f32x4 gg = ((const f32x4*)g)[lane + 64 * j];
        const f32x4 sh0 = ((const f32x4*)shift0)[lane + 64 * j], sc0 = ((const f32x4*)scale0)[lane + 64 * j], sh1 = ((const f32x4*)shift1)[lane + 64 * j], sc1 = ((const f32x4*)scale1)[lane + 64 * j];
        const f32x4 y0 = (v0[j] * r0 * gg) * (sc0 + 1.f) + sh0, y1 = (v1[j] * r1 * gg) * (sc1 + 1.f) + sh1;
        o80[64 * j] = (unsigned long long)pk2(y0.x, y0.y) | ((unsigned long long)pk2(y0.z, y0.w) << 32);
        o81[64 * j] = (unsigned long long)pk2(y1.x, y1.y) | ((unsigned long long)pk2(y1.z, y1.w) << 32); }
}
__device__ __forceinline__ void norm_mod_row2_bf(const u16* xrow0, const u16* xrow1, const float* g, const float* shift, const float* scale, u16* orow0, u16* orow1, int lane) {
    v4u w0[2], w1[2]; float x0[2][8], x1[2][8]; float s0 = 0.f, s1 = 0.f;
#pragma unroll
    for (int j = 0; j < 2; ++j) { w0[j] = *(const v4u*)(xrow0 + 512 * j + 8 * lane); w1[j] = *(const v4u*)(xrow1 + 512 * j + 8 * lane); }
#pragma unroll
    for (int j = 0; j < 2; ++j) { const unsigned a_[4] = {w0[j].x, w0[j].y, w0[j].z, w0[j].w}, b_[4] = {w1[j].x, w1[j].y, w1[j].z, w1[j].w};
#pragma unroll
        for (int e = 0; e < 4; ++e) { x0[j][2 * e] = bf2f((u16)(a_[e] & 0xffffu)); x0[j][2 * e + 1] = bf2f((u16)(a_[e] >> 16)); x1[j][2 * e] = bf2f((u16)(b_[e] & 0xffffu)); x1[j][2 * e + 1] = bf2f((u16)(b_[e] >> 16)); }
#pragma unroll
        for (int e = 0; e < 8; ++e) { s0 += x0[j][e] * x0[j][e]; s1 += x1[j][e] * x1[j][e]; } }
#pragma unroll
    for (int o = 1; o < 64; o <<= 1) { s0 += __shfl_xor(s0, o); s1 += __shfl_xor(s1, o); }
    const float r0 = rsqrtf(s0 * (1.f / DM) + EPS), r1 = rsqrtf(s1 * (1.f / DM) + EPS);
#pragma unroll
    for (int j = 0; j < 2; ++j) { const int c0 = 512 * j + 8 * lane; float y0[8], y1[8];
#pragma unroll
        for (int h4 = 0; h4 < 2; ++h4) { const f32x4 gg = *(const f32x4*)(g + c0 + 4 * h4), sh = *(const f32x4*)(shift + c0 + 4 * h4), sc = *(const f32x4*)(scale + c0 + 4 * h4);
#pragma unroll
            for (int e = 0; e < 4; ++e) { y0[4 * h4 + e] = (x0[j][4 * h4 + e] * r0 * gg[e]) * (sc[e] + 1.f) + sh[e]; y1[4 * h4 + e] = (x1[j][4 * h4 + e] * r1 * gg[e]) * (sc[e] + 1.f) + sh[e]; } }
        v4u o0 = {pk2(y0[0], y0[1]), pk2(y0[2], y0[3]), pk2(y0[4], y0[5]), pk2(y0[6], y0[7])}, o1 = {pk2(y1[0], y1[1]), pk2(y1[2], y1[3]), pk2(y1[4], y1[5]), pk2(y1[6], y1[7])};
        *(v4u*)(orow0 + c0) = o0; *(v4u*)(orow1 + c0) = o1; }
}
__device__ __forceinline__ void p_weights(const Args& a, unsigned char* lds, const int mk_wid, const int item_lo, const int item_hi, const int blk_lo, const bool do_rope) {
    const int tid = MK_TID, lane = tid & 63, wave = mk_wid;
    float* scr = (float*)(lds + wave * 16384);
    if ((int)blockIdx.x < blk_lo) return;
    const int gw = ((int)blockIdx.x - blk_lo) * 8 + wave, NGW = ((int)gridDim.x - blk_lo) * 8;
    unsigned char* ws = a.ws;
    constexpr int I_IN = 16 * 216, I_SQ = 16 * 32, I_FI = 16 * 176, I_FO = 44 * 32;
    constexpr int NITEMS = I_IN + 3 * I_SQ + I_FI + I_FO;
    for (int it = item_lo + gw; it < (item_hi < NITEMS ? item_hi : NITEMS); it += NGW) {
        int r = it;
        if (r < I_IN) { const int kb = r / 216, nb = r % 216, n0 = 32 * nb; const bool zero = n0 >= 6688;
            const int src = n0 < 4608 ? n0 : (n0 < 6656 ? n0 + 32 : n0 - 2048);
            transpose_item(a.in[7], 6688, zero ? 0 : src, 64 * kb, (u16*)(ws + WS_WIN), 1024, n0, zero, scr, lane); continue; }
        r -= I_IN;
        if (r < 3 * I_SQ) { const int which = r / I_SQ, q = r % I_SQ, kb = q / 32, nb = q % 32;
            const float* W = which == 0 ? a.in[15] : (which == 1 ? a.in[16] : a.in[17]);
            u16* WT = (u16*)(ws + (which == 0 ? WS_WAP : (which == 1 ? WS_WGP : WS_WOUT)));
            transpose_item(W, 1024, 32 * nb, 64 * kb, WT, 1024, 32 * nb, false, scr, lane); continue; }
        r -= 3 * I_SQ;
        if (r < I_FI) { const int kb = r / 176, nb = r % 176, n0 = 32 * nb, pn = n0 >> 8, j = n0 & 255;
            const int src = j < 128 ? pn * 128 + j : DFF + pn * 128 + (j - 128);
            transpose_item(a.in[19], 2 * DFF, src, 64 * kb, (u16*)(ws + WS_WFI), 1024, n0, false, scr, lane); continue; }
        r -= I_FI;
        { const int kb = r / 32, nb = r % 32; transpose_item(a.in[20], 1024, 32 * nb, 64 * kb, (u16*)(ws + WS_WFO), DFF, 32 * nb, false, scr, lane); }
    }
    float* rope = (float*)(ws + WS_ROPE);
    if (do_rope) for (int idx = blockIdx.x * 512 + tid; idx < T * 64; idx += gridDim.x * 512) { const int t = idx >> 6, i = idx & 63, j = i & 31;
        const float pos = (float)(i < 32 ? (t >> 6) : (t & 63));
        const float inv = 1.0f / powf(10000.f, (float)(2 * j) / 64.f);
        const float ang = pos * inv;
        rope[2 * idx] = cosf(ang); rope[2 * idx + 1] = sinf(ang); }
}

__device__ __forceinline__ void p_h1rows(const Args& a, const int mk_wid) {
    const int tid = MK_TID, lane = tid & 63, wave = mk_wid;
    const int gw = blockIdx.x * 8 + wave, NGW = gridDim.x * 8;
    unsigned char* ws = a.ws;
    const float* MOD = (const float*)(ws + WS_MOD);
    for (int m0 = gw * 2; m0 < MALL; m0 += NGW * 2) {
        const float* src[2]; const float* mod[2];
#pragma unroll
        for (int e = 0; e < 2; ++e) { const int m = m0 + e, b = m / TA, r = m % TA; const bool isc = r < TC;
            src[e] = isc ? a.in[2] + ((size_t)b * TC + r) * DM : a.in[0] + ((size_t)b * T + (r - TC)) * DM; mod[e] = MOD + (size_t)(isc ? 16 : b) * 6144; }
        norm_mod_row2(src[0], src[1], a.in[6], mod[0], mod[0] + 1024, mod[1], mod[1] + 1024, (u16*)(ws + WS_H1) + (size_t)m0 * DM, (u16*)(ws + WS_H1) + (size_t)(m0 + 1) * DM, lane); }
}

__device__ __forceinline__ void p_lowrank(const Args& a, unsigned char* lds, const int mk_wid) {
    const int tid = MK_TID, lane = tid & 63, r32 = lane & 31, hi = lane >> 5;
    constexpr int WP = 1032, APT = 136;
    u16* wl = (u16*)lds; u16* al = (u16*)(lds + 32 * WP * 2);
    const u16* H1 = (const u16*)(a.ws + WS_H1); const u16* WL = (const u16*)(a.ws + WS_WIN) + (size_t)6656 * 1024; u16* LR = (u16*)(a.ws + WS_LR);
    const int rb0 = (int)gridDim.x >= 256 ? (int)blockIdx.x - ((int)gridDim.x - MALL / 256) : (int)blockIdx.x;
    if (rb0 < 0 || rb0 >= MALL / 256) return;
#pragma unroll
    for (int p = 0; p < 8; ++p) { const int piece = p * 512 + tid, row = piece >> 7, c8 = piece & 127; *(v4u*)(wl + row * WP + c8 * 8) = *(const v4u*)(WL + (size_t)row * 1024 + c8 * 8); }
    for (int rb = rb0; rb < MALL / 256; rb += gridDim.x) {
        const u16* Ab = H1 + (size_t)rb * 256 * 1024;
        v4u st[8];
#pragma unroll
        for (int p = 0; p < 8; ++p) { const int piece = p * 512 + tid, row = piece >> 4, c8 = piece & 15; st[p] = *(const v4u*)(Ab + (size_t)row * 1024 + c8 * 8); }
        att::f32x16 acc = att::f32x16{};
        for (int kc = 0; kc < 8; ++kc) {
            __syncthreads();
#pragma unroll
            for (int p = 0; p < 8; ++p) { const int piece = p * 512 + tid, row = piece >> 4, c8 = piece & 15; *(v4u*)(al + row * APT + c8 * 8) = st[p]; }
            if (kc + 1 < 8) {
#pragma unroll
                for (int p = 0; p < 8; ++p) { const int piece = p * 512 + tid, row = piece >> 4, c8 = piece & 15; st[p] = *(const v4u*)(Ab + (size_t)row * 1024 + (kc + 1) * 128 + c8 * 8); } }
            __syncthreads();
            const u16* ap = al + (mk_wid * 32 + r32) * APT + 8 * hi; const u16* bp = wl + r32 * WP + kc * 128 + 8 * hi;
#pragma unroll
            for (int kb = 0; kb < 8; ++kb) acc = __builtin_amdgcn_mfma_f32_32x32x16_bf16(*(const att::bf16x8*)(ap + kb * 16), *(const att::bf16x8*)(bp + kb * 16), acc, 0, 0, 0);
        }
#pragma unroll
        for (int r = 0; r < 16; ++r) LR[(size_t)(rb * 256 + mk_wid * 32 + att::crow(r, hi)) * 32 + r32] = f2bf(acc[r]);
    }
    __syncthreads();
}
__device__ __forceinline__ void p_kprep(const Args& a, const int mk_wid) {
    const int tid = MK_TID, lane = tid & 63, wave = mk_wid;
    const int gw = blockIdx.x * 8 + wave, NGW = gridDim.x * 8;
    u16* Kb = (u16*)(a.ws + WS_K); const float* rope = (const float*)(a.ws + WS_ROPE); const float* kg = a.in[9];
    const int head = lane >> 5, l = lane & 31;
    const f32x4 g = *(const f32x4*)(kg + 4 * l);
    for (int m0 = gw * 6; m0 < MALL; m0 += NGW * 6) {
        v2u w[6]; f32x4 cs[6]; float f[6][4], s[6];
#pragma unroll
        for (int e = 0; e < 6; ++e) { const int m = m0 + e, r = m % TA; w[e] = *(const v2u*)(Kb + (size_t)m * 256 + head * 128 + 4 * l);
            cs[e] = (r >= TC) ? *(const f32x4*)(rope + ((size_t)(r - TC) * 64 + 2 * l) * 2) : (f32x4){1.f, 0.f, 1.f, 0.f}; }
#pragma unroll
        for (int e = 0; e < 6; ++e) { f[e][0] = bf2f((u16)(w[e].x & 0xffffu)); f[e][1] = bf2f((u16)(w[e].x >> 16)); f[e][2] = bf2f((u16)(w[e].y & 0xffffu)); f[e][3] = bf2f((u16)(w[e].y >> 16));
            s[e] = (f[e][0] * f[e][0] + f[e][1] * f[e][1]) + (f[e][2] * f[e][2] + f[e][3] * f[e][3]); }
#pragma unroll
        for (int o = 1; o < 32; o <<= 1) {
#pragma unroll
            for (int e = 0; e < 6; ++e) s[e] += __shfl_xor(s[e], o); }
#pragma unroll
        for (int e = 0; e < 6; ++e) { const float rinv = rsqrtf(s[e] * (1.f / 128.f) + EPS);
            const float f0 = f[e][0] * rinv * g.x, f1 = f[e][1] * rinv * g.y, f2 = f[e][2] * rinv * g.z, f3 = f[e][3] * rinv * g.w;
            v2u o; o.x = pk2(f0 * cs[e].x - f1 * cs[e].y, f0 * cs[e].y + f1 * cs[e].x); o.y = pk2(f2 * cs[e].z - f3 * cs[e].w, f2 * cs[e].w + f3 * cs[e].z);
            *(v2u*)(Kb + (size_t)(m0 + e) * 256 + head * 128 + 4 * l) = o; } }
}
__device__ __forceinline__ void p_glapost(const Args& a, const int mk_wid) {
    const int tid = MK_TID, lane = tid & 63, wave = mk_wid;
    const int gw = blockIdx.x * 8 + wave, NGW = gridDim.x * 8;
    const u16* OF = (const u16*)(a.ws + WS_OF); const u16* OB = (const u16*)(a.ws + WS_OB); u16* GG = (u16*)(a.ws + WS_GG);
    const f32x4 g = *(const f32x4*)(a.in[14] + 4 * lane);
    for (int it0 = gw * 4; it0 < MLAT * 4; it0 += NGW * 4) {
        v2u wf[4], wb[4], wg[4]; float o_[4][4], ss[4];
#pragma unroll
        for (int e = 0; e < 4; ++e) { const size_t off = (size_t)(it0 + e) * 256 + 4 * lane; wf[e] = __builtin_nontemporal_load((const v2u*)(OF + off)); wb[e] = __builtin_nontemporal_load((const v2u*)(OB + off)); wg[e] = __builtin_nontemporal_load((const v2u*)(GG + off)); }
#pragma unroll
        for (int e = 0; e < 4; ++e) {
            o_[e][0] = bf2f((u16)(wf[e].x & 0xffffu)) + bf2f((u16)(wb[e].x & 0xffffu)); o_[e][1] = bf2f((u16)(wf[e].x >> 16)) + bf2f((u16)(wb[e].x >> 16));
            o_[e][2] = bf2f((u16)(wf[e].y & 0xffffu)) + bf2f((u16)(wb[e].y & 0xffffu)); o_[e][3] = bf2f((u16)(wf[e].y >> 16)) + bf2f((u16)(wb[e].y >> 16));
            ss[e] = (o_[e][0] * o_[e][0] + o_[e][1] * o_[e][1]) + (o_[e][2] * o_[e][2] + o_[e][3] * o_[e][3]); }
#pragma unroll
        for (int o = 1; o < 64; o <<= 1) {
#pragma unroll
            for (int e = 0; e < 4; ++e) ss[e] += __shfl_xor(ss[e], o); }
#pragma unroll
        for (int e = 0; e < 4; ++e) { const float rinv = rsqrtf(ss[e] * (1.f / 256.f) + EPS);
            const float g0 = bf2f((u16)(wg[e].x & 0xffffu)), g1 = bf2f((u16)(wg[e].x >> 16)), g2 = bf2f((u16)(wg[e].y & 0xffffu)), g3 = bf2f((u16)(wg[e].y >> 16));
            v2u o; o.x = pk2(o_[e][0] * rinv * g.x * (g0 * sigmoidf_(g0)), o_[e][1] * rinv * g.y * (g1 * sigmoidf_(g1)));
            o.y = pk2(o_[e][2] * rinv * g.z * (g2 * sigmoidf_(g2)), o_[e][3] * rinv * g.w * (g3 * sigmoidf_(g3)));
            *(v2u*)(GG + (size_t)(it0 + e) * 256 + 4 * lane) = o; } }
}
__device__ __forceinline__ void p_h2(const Args& a, const int mk_wid) {
    const int tid = MK_TID, lane = tid & 63, wave = mk_wid;
    const int gw = blockIdx.x * 8 + wave, NGW = gridDim.x * 8;
    const float* MOD = (const float*)(a.ws + WS_MOD);
    const u16* X1 = (const u16*)(a.ws + WS_X1);
    for (int m0 = gw * 2; m0 < MLAT; m0 += NGW * 2) { const float* mod = MOD + (size_t)(m0 / T) * 6144;
        norm_mod_row2_bf(X1 + (size_t)m0 * DM, X1 + (size_t)(m0 + 1) * DM, a.in[18], mod + 3 * 1024, mod + 4 * 1024,
                         (u16*)(a.ws + WS_H2) + (size_t)m0 * DM, (u16*)(a.ws + WS_H2) + (size_t)(m0 + 1) * DM, lane); }
}
namespace gla {
using att::bf16x8; using att::s16x4; using att::f32x16; using att::crow; using att::v_st; using att::v_rd_base; using att::v_rd_off; using att::tr_read;
constexpr int QP = 136, AP = 72;
constexpr int L_QE = 0, L_KE = 17408, L_KD = 34816, L_V = 51200, L_AM = 83968, L_LAS = 93184, L_LR = 125952, L_GS = 128000, L_DL = 130048, L_END = 130560;
static_assert(L_END <= LDS_BYTES - 64, "GLA LDS map");
#define GLA_PK(L, H) (bf16x8){L[0], L[1], L[2], L[3], H[0], H[1], H[2], H[3]}
#define GLA_SBAR() __builtin_amdgcn_sched_barrier(0)
#define OPAQUE_TID(name) int name = MK_TID; asm volatile("" : "+v"(name))

__device__ __forceinline__ void scan_unit(const int unit, const Args& a, unsigned char* lds, const int mk_wid) {
    const int wid = mk_wid;
    const int dir = unit & 1, h = (unit >> 1) & 3, b = unit >> 3;
    const int vt = wid;
    const u16* GQ = (const u16*)(a.ws + WS_GQ); const u16* GK = (const u16*)(a.ws + WS_GK); const u16* GV = (const u16*)(a.ws + WS_GV); const u16* LR = (const u16*)(a.ws + WS_LR);
    u16* OUT = (u16*)(a.ws + (dir ? WS_OB : WS_OF));
    bf16x8 upf; float biasc;
    { const int l_ = MK_TID & 63, r32 = l_ & 31, hi = l_ >> 5; const float* up = a.in[dir ? 12 : 10] + (size_t)(8 * hi) * 512 + h * 128 + (wid & 3) * 32 + r32;
      v4u w; w.x = pk2(up[0], up[512]); w.y = pk2(up[2 * 512], up[3 * 512]); w.z = pk2(up[4 * 512], up[5 * 512]); w.w = pk2(up[6 * 512], up[7 * 512]);
      upf = __builtin_bit_cast(bf16x8, w); biasc = a.in[dir ? 13 : 11][h * 128 + (wid & 3) * 32 + r32]; }
    u16* qe = (u16*)(lds + L_QE); u16* ke = (u16*)(lds + L_KE); u16* am = (u16*)(lds + L_AM);
    float* las = (float*)(lds + L_LAS); float* gs = (float*)(lds + L_GS); float* dl = (float*)(lds + L_DL);
    const int ldsb = (int)(uintptr_t)lds;
    u16* ot = (u16*)(lds + L_LAS);
    int pend_cc = -1;
#define GLA_FLUSH() do { if (pend_cc >= 0) { OPAQUE_TID(tf_); const size_t rl0_ = (size_t)b * T + (size_t)(pend_cc - 4) * 64; \
      _Pragma("unroll") for (int p = 0; p < 4; ++p) { const int idx_ = p * 512 + tf_, i_ = idx_ >> 5, c16_ = idx_ & 31; \
          *(v4u*)(OUT + (rl0_ + (dir ? 63 - i_ : i_)) * 1024 + h * 256 + c16_ * 8) = *(const v4u*)(ot + i_ * 256 + c16_ * 8); } } } while (0)
    f32x16 S[4]; S[0] = f32x16{}; S[1] = f32x16{}; S[2] = f32x16{}; S[3] = f32x16{};
    bf16x8 qraw[2], kraw[2], vraw[4]; bf16x8 lraw = bf16x8{};
#define GLA_CHUNK(s) (dir ? ((s) < 4 ? 3 - (s) : 39 - (s)) : (s))
#define GLA_LOAD(s) do { OPAQUE_TID(t_); const int cc_ = GLA_CHUNK(s); const size_t rowb_ = (size_t)b * TA + (size_t)cc_ * 64; \
      _Pragma("unroll") for (int p = 0; p < 2; ++p) { const int i_ = p * 32 + (t_ >> 4); const size_t row_ = rowb_ + (dir ? 63 - i_ : i_); \
          kraw[p] = *(const bf16x8*)(GK + row_ * 512 + h * 128 + (t_ & 15) * 8); \
          qraw[p] = (cc_ >= 4) ? *(const bf16x8*)(GQ + row_ * 512 + h * 128 + (t_ & 15) * 8) : bf16x8{}; } \
      _Pragma("unroll") for (int p = 0; p < 4; ++p) { const int i_ = p * 16 + (t_ >> 5); const size_t row_ = rowb_ + (dir ? 63 - i_ : i_); \
          vraw[p] = *(const bf16x8*)(GV + row_ * 1024 + h * 256 + (t_ & 31) * 8); } \
      if (t_ < 128) { const int i_ = t_ >> 1; const size_t row_ = rowb_ + (dir ? 63 - i_ : i_); lraw = *(const bf16x8*)(LR + row_ * 32 + dir * 16 + (t_ & 1) * 8); } } while (0)
    GLA_LOAD(0);
    for (int step = 0; step < 36; ++step) {
        const int cc = GLA_CHUNK(step); const bool lat = cc >= 4;
        GLA_FLUSH();
        { OPAQUE_TID(t_);
#pragma unroll
          for (int p = 0; p < 2; ++p) { const int i_ = p * 32 + (t_ >> 4), c_ = (t_ & 15) * 8; *(bf16x8*)(qe + i_ * QP + c_) = qraw[p]; *(bf16x8*)(ke + i_ * QP + c_) = kraw[p]; }
#pragma unroll
          for (int p = 0; p < 4; ++p) { const int i_ = p * 16 + (t_ >> 5), c8 = t_ & 31; *(bf16x8*)(lds + L_V + (c8 >> 4) * 16384 + v_st(i_, (c8 & 15) * 8)) = vraw[p]; }
          if (t_ < 128) *(bf16x8*)(lds + L_LR + (t_ >> 1) * 32 + (t_ & 1) * 16) = lraw; }
        __syncthreads();
        { OPAQUE_TID(t_); const int lane = t_ & 63, r32 = lane & 31, hi = lane >> 5; const int tt = wid >> 2, ct = wid & 3;
          const bf16x8 af = *(const bf16x8*)(lds + L_LR + (tt * 32 + r32) * 32 + hi * 16);
          const f32x16 z = __builtin_amdgcn_mfma_f32_32x32x16_bf16(af, upf, f32x16{}, 0, 0, 0);
          float* lw = las + (tt * 32 + 4 * hi) * 128 + ct * 32 + r32;
#pragma unroll
          for (int r = 0; r < 16; ++r) { const float zz = z[r] + biasc;
              lw[crow(r, 0) * 128] = (fminf(zz, 0.f) - __builtin_amdgcn_logf(1.f + __builtin_amdgcn_exp2f(-1.4426950408889634f * fabsf(zz))) * 0.6931471805599453f) * (1.f / 16.f); } }
        __syncthreads();
        { OPAQUE_TID(t_); const int c = t_ & 127, g = t_ >> 7;
          float bl[16]; float run = 0.f;
          { const float* lp = las + (g * 16) * 128 + c;
#pragma unroll
            for (int ii = 0; ii < 16; ++ii) { run += lp[ii * 128]; bl[ii] = run; } }
          gs[g * 128 + c] = run;
          __syncthreads();
          const float g0 = gs[c], g1 = gs[128 + c], g2 = gs[256 + c], g3 = gs[384 + c];
          const float off = (g > 0 ? g0 : 0.f) + (g > 1 ? g1 : 0.f) + (g > 2 ? g2 : 0.f);
          const float btot = (g0 + g1) + (g2 + g3);
          const float dlc = __builtin_amdgcn_exp2f(btot * 1.4426950408889634f);
          if (g == 0) dl[c] = dlc;
          u16* qcol = qe + (g * 16) * QP + c; u16* kcol = ke + (g * 16) * QP + c; unsigned char* kdb = lds + L_KD + v_st(g * 16, c);
#pragma unroll
          for (int ii = 0; ii < 16; ++ii) { const float bb = bl[ii] + off;
              const float qf = bf2f(qcol[ii * QP]), kf = bf2f(kcol[ii * QP]);
              const float e = __builtin_amdgcn_exp2f(bb * 1.4426950408889634f), ker = kf * __builtin_amdgcn_rcpf(e);
              qcol[ii * QP] = f2bf(qf * (0.088388347648318440f * e));
              kcol[ii * QP] = f2bf(ker);
              *(u16*)(kdb + v_st(ii, 0)) = f2bf(ker * dlc); } }
        if (step + 1 < 36) GLA_LOAD(step + 1);
        __syncthreads();
        if (lat) {
            if (wid < 4) { OPAQUE_TID(t_); const int r32 = t_ & 31, hi = (t_ >> 5) & 1;
                const int jt = wid >> 1, it = wid & 1; f32x16 ct = f32x16{};
                const u16* kp = ke + (jt * 32 + r32) * QP + hi * 8; const u16* qp = qe + (it * 32 + r32) * QP + hi * 8;
#pragma unroll
                for (int kb = 0; kb < 8; ++kb) ct = __builtin_amdgcn_mfma_f32_32x32x16_bf16(*(const bf16x8*)(kp + kb * 16), *(const bf16x8*)(qp + kb * 16), ct, 0, 0, 0);
                const int i = it * 32 + r32;
#pragma unroll
                for (int rg = 0; rg < 4; ++rg) { const int j0 = jt * 32 + 8 * rg + 4 * hi;
                    const float x0 = (j0 + 0 <= i) ? ct[4 * rg + 0] : 0.f, x1 = (j0 + 1 <= i) ? ct[4 * rg + 1] : 0.f, x2 = (j0 + 2 <= i) ? ct[4 * rg + 2] : 0.f, x3 = (j0 + 3 <= i) ? ct[4 * rg + 3] : 0.f;
                    v2u w; w.x = pk2(x0, x1); w.y = pk2(x2, x3); *(v2u*)(am + i * AP + j0) = w; } }
            __syncthreads();
        }
        { OPAQUE_TID(t_); const int lane = t_ & 63, r32 = lane & 31, hi = lane >> 5;
          const int vb = ldsb + L_V + (vt >> 2) * 16384 + v_rd_base(lane) + (vt & 3) * 512;
          s16x4 vl0, vh0, vl1, vh1, vl2, vh2, vl3, vh3;
#define GLA_LOADV() do { vl0 = tr_read<v_rd_off(0, 0, 0)>(vb); vh0 = tr_read<v_rd_off(0, 0, 1)>(vb); vl1 = tr_read<v_rd_off(0, 1, 0)>(vb); vh1 = tr_read<v_rd_off(0, 1, 1)>(vb); \
              vl2 = tr_read<v_rd_off(0, 2, 0)>(vb); vh2 = tr_read<v_rd_off(0, 2, 1)>(vb); vl3 = tr_read<v_rd_off(0, 3, 0)>(vb); vh3 = tr_read<v_rd_off(0, 3, 1)>(vb); } while (0)
          if (!lat) GLA_LOADV();
          if (lat) {
              f32x16 o0 = f32x16{}, o1 = f32x16{};
#pragma unroll
              for (int ct = 0; ct < 4; ++ct)
#pragma unroll
                for (int kb = 0; kb < 2; ++kb) { const int cb = ct * 32 + kb * 16;
                    v4u sw; sw.x = pk2(S[ct][8 * kb + 0], S[ct][8 * kb + 1]); sw.y = pk2(S[ct][8 * kb + 2], S[ct][8 * kb + 3]); sw.z = pk2(S[ct][8 * kb + 4], S[ct][8 * kb + 5]); sw.w = pk2(S[ct][8 * kb + 6], S[ct][8 * kb + 7]);
                    const bf16x8 sb = __builtin_bit_cast(bf16x8, sw);
                    { const u16* p0 = qe + r32 * QP + cb + 4 * hi; const v2u lo = *(const v2u*)p0, hh = *(const v2u*)(p0 + 8); v4u aw = {lo.x, lo.y, hh.x, hh.y};
                      o0 = __builtin_amdgcn_mfma_f32_32x32x16_bf16(__builtin_bit_cast(bf16x8, aw), sb, o0, 0, 0, 0); }
                    { const u16* p1 = qe + (32 + r32) * QP + cb + 4 * hi; const v2u lo = *(const v2u*)p1, hh = *(const v2u*)(p1 + 8); v4u aw = {lo.x, lo.y, hh.x, hh.y};
                      o1 = __builtin_amdgcn_mfma_f32_32x32x16_bf16(__builtin_bit_cast(bf16x8, aw), sb, o1, 0, 0, 0); } }
              GLA_LOADV();
              asm volatile("s_waitcnt lgkmcnt(0)" ::: "memory"); GLA_SBAR();
              { const u16* a0 = am + r32 * AP + hi * 8; const u16* a1 = am + (32 + r32) * AP + hi * 8;
                o0 = __builtin_amdgcn_mfma_f32_32x32x16_bf16(*(const bf16x8*)(a0), GLA_PK(vl0, vh0), o0, 0, 0, 0);
                o0 = __builtin_amdgcn_mfma_f32_32x32x16_bf16(*(const bf16x8*)(a0 + 16), GLA_PK(vl1, vh1), o0, 0, 0, 0);
                o1 = __builtin_amdgcn_mfma_f32_32x32x16_bf16(*(const bf16x8*)(a1), GLA_PK(vl0, vh0), o1, 0, 0, 0);
                o1 = __builtin_amdgcn_mfma_f32_32x32x16_bf16(*(const bf16x8*)(a1 + 16), GLA_PK(vl1, vh1), o1, 0, 0, 0);
                o1 = __builtin_amdgcn_mfma_f32_32x32x16_bf16(*(const bf16x8*)(a1 + 32), GLA_PK(vl2, vh2), o1, 0, 0, 0);
                o1 = __builtin_amdgcn_mfma_f32_32x32x16_bf16(*(const bf16x8*)(a1 + 48), GLA_PK(vl3, vh3), o1, 0, 0, 0); }
              { u16* ow = ot + (4 * hi) * 256 + vt * 32 + r32;
#pragma unroll
                for (int r = 0; r < 16; ++r) { const int i0 = crow(r, 0); ow[i0 * 256] = f2bf(o0[r]); ow[(i0 + 32) * 256] = f2bf(o1[r]); } }
          }
#pragma unroll
          for (int ct = 0; ct < 4; ++ct) { const int kb_ = ldsb + L_KD + v_rd_base(lane) + ct * 512;
              const s16x4 al0 = tr_read<v_rd_off(0, 0, 0)>(kb_), ah0 = tr_read<v_rd_off(0, 0, 1)>(kb_), al1 = tr_read<v_rd_off(0, 1, 0)>(kb_), ah1 = tr_read<v_rd_off(0, 1, 1)>(kb_);
              const s16x4 al2 = tr_read<v_rd_off(0, 2, 0)>(kb_), ah2 = tr_read<v_rd_off(0, 2, 1)>(kb_), al3 = tr_read<v_rd_off(0, 3, 0)>(kb_), ah3 = tr_read<v_rd_off(0, 3, 1)>(kb_);
              const float* dp = dl + ct * 32 + 4 * hi;
#pragma unroll
              for (int rg = 0; rg < 4; ++rg) { const f32x4 d4 = *(const f32x4*)(dp + 8 * rg);
                  S[ct][4 * rg + 0] *= d4.x; S[ct][4 * rg + 1] *= d4.y; S[ct][4 * rg + 2] *= d4.z; S[ct][4 * rg + 3] *= d4.w; }
              asm volatile("s_waitcnt lgkmcnt(0)" ::: "memory"); GLA_SBAR();
              S[ct] = __builtin_amdgcn_mfma_f32_32x32x16_bf16(GLA_PK(al0, ah0), GLA_PK(vl0, vh0), S[ct], 0, 0, 0);
              S[ct] = __builtin_amdgcn_mfma_f32_32x32x16_bf16(GLA_PK(al1, ah1), GLA_PK(vl1, vh1), S[ct], 0, 0, 0);
              S[ct] = __builtin_amdgcn_mfma_f32_32x32x16_bf16(GLA_PK(al2, ah2), GLA_PK(vl2, vh2), S[ct], 0, 0, 0);
              S[ct] = __builtin_amdgcn_mfma_f32_32x32x16_bf16(GLA_PK(al3, ah3), GLA_PK(vl3, vh3), S[ct], 0, 0, 0); } }
        __syncthreads();
        pend_cc = lat ? cc : -1;
    }
    GLA_FLUSH();
    __syncthreads();
#undef GLA_FLUSH
#undef GLA_LOADV
#undef GLA_CHUNK
#undef GLA_LOAD
}
}
#define XB_TMO      128
#define XB_XCNT(j)  (256  + 64 * (j))
#define XB_XSUB(j)  (1280 + 64 * (j))
#define XB_XGEN(j)  (2304 + 64 * (j))
#define XB_TOP      3328
#define XB_TOPGEN   3392
#define XCD_BAR_WORDS 3456
#define XB_SPIN_CAP (1u << 18)

__device__ __forceinline__ unsigned xb_ld(unsigned* p)              { return __hip_atomic_load(p, __ATOMIC_RELAXED, __HIP_MEMORY_SCOPE_AGENT); }
__device__ __forceinline__ unsigned xb_add(unsigned* p, unsigned v) { return __hip_atomic_fetch_add(p, v, __ATOMIC_RELAXED, __HIP_MEMORY_SCOPE_AGENT); }
__device__ __forceinline__ unsigned xb_xcc_id() { return (unsigned)__builtin_amdgcn_s_getreg((3 << 11) | 20) & 0xFu; }
#define XB_SPIN(cond, bar) do { unsigned _sp = 0; while (cond) { __builtin_amdgcn_s_sleep(1); \
    if ((++_sp & 255u) == 0u) { if (xb_ld(&(bar)[XB_TMO])) break; if (_sp > XB_SPIN_CAP) { atomicAdd(&(bar)[XB_TMO], 1u); break; } } } } while (0)

struct XcdBarrier {
    unsigned* bar; unsigned x;
    volatile LAS unsigned* st;
};

__device__ __forceinline__ XcdBarrier xcd_barrier_post(unsigned* bar, volatile LAS unsigned* st, const bool tid0) {
    XcdBarrier b; b.bar = bar; b.x = xb_xcc_id(); b.st = st;
    if (tid0) (void)xb_add(&bar[XB_XCNT(b.x)], 1u);
    return b;
}
__device__ __forceinline__ void xcd_barrier_complete(unsigned* bar, unsigned x, unsigned& nloc, unsigned& nx) {
    const unsigned G = gridDim.x * gridDim.y * gridDim.z;
    unsigned sum, cnt, mine, sp = 0u;
    for (;;) {
        sum = 0u; cnt = 0u; mine = 0u;
#pragma unroll
        for (unsigned j = 0; j < 16; ++j) { const unsigned c = xb_ld(&bar[XB_XCNT(j)]); sum += c; cnt += (c > 0u) ? 1u : 0u; mine = (j == x) ? c : mine; }
        if (sum == G) break;
        __builtin_amdgcn_s_sleep(1);
        if ((++sp & 255u) == 0u) { if (xb_ld(&bar[XB_TMO])) break; if (sp > XB_SPIN_CAP) { atomicAdd(&bar[XB_TMO], 1u); break; } }
    }
    nloc = mine > 0u ? mine : 1u; nx = cnt > 0u ? cnt : 1u;
}

__device__ __forceinline__ void xcd_barrier(const XcdBarrier& b, const bool tid0) {
    asm volatile("s_waitcnt vmcnt(0)" ::: "memory");
    __syncthreads();
    if (tid0) {
        unsigned* bar = b.bar; const unsigned bx_ = (unsigned)__builtin_amdgcn_readfirstlane((int)xb_xcc_id());
        __builtin_amdgcn_s_waitcnt(0);
        unsigned nloc = b.st[0], nx = b.st[1];
        if (nloc == 0u) { xcd_barrier_complete(bar, bx_, nloc, nx); b.st[0] = nloc; b.st[1] = nx; }
        const unsigned old = xb_add(&bar[XB_XSUB(bx_)], 1u);
        const unsigned gen = old / nloc;
        if (old + 1u == (gen + 1u) * nloc) {
            __builtin_amdgcn_fence(__ATOMIC_RELEASE, "agent");
            asm volatile("s_waitcnt vmcnt(0)" ::: "memory");
            const unsigned og = xb_add(&bar[XB_TOP], 1u);
            const unsigned tg = og / nx;
            if (og + 1u == (tg + 1u) * nx) xb_add(&bar[XB_TOPGEN], 1u);
            else XB_SPIN(xb_ld(&bar[XB_TOPGEN]) == tg, bar);
            __builtin_amdgcn_fence(__ATOMIC_ACQUIRE, "agent");
            xb_add(&bar[XB_XGEN(bx_)], 1u);
            asm volatile("s_waitcnt vmcnt(0)" ::: "memory");
        } else {
            XB_SPIN(xb_ld(&bar[XB_XGEN(bx_)]) == gen, bar);
            __builtin_amdgcn_fence(__ATOMIC_ACQUIRE, "agent");
            asm volatile("s_waitcnt vmcnt(0)" ::: "memory");
        }
    }
    __syncthreads();
}
#ifndef MK_PER_PHASE
#define MK_PER_PHASE 0
#endif
__global__ void __launch_bounds__(512) mk_fwd(Args a) {
    extern __shared__ __attribute__((aligned(16))) unsigned char lds[];
    cg::grid_group grid = cg::this_grid();
    unsigned char* ws = a.ws;
    LAS unsigned char* lds3 = (LAS unsigned char*)lds;
    const int G = gridDim.x, bx = blockIdx.x;
    const int mk_wid = __builtin_amdgcn_readfirstlane(threadIdx.x >> 6);
#ifndef PHMASK
#define PHMASK 0x7ff
#endif
#define IN(k) (((PHMASK >> (k)) & 1) && a.ph_lo <= (k) && (k) < a.ph_hi)
    unsigned* bar_words = (unsigned*)(ws + 4096);
    volatile LAS unsigned* bar_st = (volatile LAS unsigned*)(lds3 + (LDS_BYTES - 64));
    { const int t0_ = MK_TID; if (t0_ < 2) bar_st[t0_] = 0u; }
    if (IN(0) && bx == 0) { for (int i = MK_TID; i < XCD_BAR_WORDS; i += 512) __hip_atomic_store(bar_words + i, 0u, __ATOMIC_RELAXED, __HIP_MEMORY_SCOPE_AGENT); }
#define SEAM(k) do { if (IN(k) && IN((k) + 1)) { if ((k) == 0) { grid.sync(); (void)xcd_barrier_post(bar_words, bar_st, MK_TID == 0); } else { unsigned long long bp_ = (unsigned long long)(a.ws + 4096); asm volatile("" : "+s"(bp_)); XcdBarrier xb_; xb_.bar = (unsigned*)bp_; xb_.x = 0; xb_.st = bar_st; xcd_barrier(xb_, MK_TID == 0); } } } while (0)
    if (IN(0)) p_adaln(a, lds, mk_wid);
    SEAM(0);
    if (IN(1)) { p_weights(a, lds, mk_wid, 0, (G == 256) ? WI_IN : WI_ALL, 0, true); p_h1rows(a, mk_wid); }
    SEAM(1);
    if (IN(2)) {
        pg8::Gemm g{(const pg8::bf16_t*)(ws + WS_H1), (const pg8::bf16_t*)(ws + WS_WIN), MALL, NIN, DM}; InProjOrder S; S.init(G, bx);
        EpiInProj E{ws, (u16*)a.out};
        p_lowrank(a, lds, mk_wid);
        __syncthreads();
        pg8::gemm_phase<EpiInProj, InProjOrder, true, true>(lds3, g, S, E, mk_wid);
        if (G == 256) p_weights(a, lds, mk_wid, WI_IN, WI_PROJ, 128, false);
    }
    SEAM(2);
    if (IN(3)) p_kprep(a, mk_wid);
    SEAM(3);
    if (IN(4)) {
        const att::bf16* Qp = (const att::bf16*)(ws + WS_Q); const att::bf16* Kp = (const att::bf16*)(ws + WS_K); const att::bf16* Vp = (const att::bf16*)(ws + WS_V);
        const float* rope = (const float*)(ws + WS_ROPE);
        const bool full = (G == 256);
        if (full) { if (bx < 128) gla::scan_unit(bx, a, lds, mk_wid); }
        else { for (int u = bx; u < 128; u += G) gla::scan_unit(u, a, lds, mk_wid); }
        __syncthreads();
        const int xj = bx >> 3, xx = bx & 7;
        const int nun = full ? (xj < 16 ? 3 : 5) : 0;
        for (int i = 0; ; ++i) {
            int bk, w;
            if (full) { if (i >= nun) break; const int idx = (xj < 16) ? 80 + i * 16 + xj : i * 16 + (xj - 16); bk = (idx >> 5) * 8 + xx; w = idx & 31; }
            else { const int u = i * G + bx; if (u >= 1024) break; bk = u >> 5; w = u & 31; }
            const int b = bk >> 1, kvh = bk & 1, hq = kvh * 4 + (w >> 3), qb = w & 7;
            const size_t qoff = ((size_t)b * T + (size_t)qb * 256) * 1024 + hq * 128;
            const size_t koff = (size_t)b * TA * 256 + kvh * 128;
            att::attn_unit(Qp + qoff, Kp + koff, Vp + koff, (att::bf16*)(ws + WS_Q) + qoff, TA, (char*)lds, rope + (size_t)qb * 256 * 128, a.in[8], mk_wid);
        }
        if (full) p_weights(a, lds, mk_wid, WI_PROJ, WI_ALL, 128, false);
    }
    SEAM(4);
    if (IN(5)) {
        pg8::StaticOrder S; S.init(MLAT, DM, G, bx, 2);
        { pg8::Gemm g{(const pg8::bf16_t*)(ws + WS_Q), (const pg8::bf16_t*)(ws + WS_WAP), MLAT, DM, DM};
          EpiMerge<0> E{(const u16*)a.out, (u16*)(ws + WS_T1), (u16*)(ws + WS_MRG)};
          pg8::gemm_phase<EpiMerge<0>, pg8::StaticOrder, true, true>(lds3, g, S, E, mk_wid); }
        p_glapost(a, mk_wid);
    }
    SEAM(5);
    if (IN(6)) {
        pg8::StaticOrder S; S.init(MLAT, DM, G, bx, 2);
        pg8::Gemm g{(const pg8::bf16_t*)(ws + WS_GG), (const pg8::bf16_t*)(ws + WS_WGP), MLAT, DM, DM};
        EpiMerge<1> E{(const u16*)a.out, (u16*)(ws + WS_T1), (u16*)(ws + WS_MRG)};
        pg8::gemm_phase<EpiMerge<1>, pg8::StaticOrder, true, true>(lds3, g, S, E, mk_wid);
    }
    SEAM(6);
    if (IN(7)) {
        pg8::Gemm g{(const pg8::bf16_t*)(ws + WS_MRG), (const pg8::bf16_t*)(ws + WS_WOUT), MLAT, DM, DM}; pg8::StaticOrder S; S.init(MLAT, DM, G, bx, 2);
        EpiGateResB<false> E{(const void*)a.in[0], (void*)(ws + WS_X1), (const float*)(ws + WS_MOD) + 2 * 1024};
        pg8::gemm_phase<EpiGateResB<false>, pg8::StaticOrder, true, true>(lds3, g, S, E, mk_wid);
    }
    SEAM(7);
    if (IN(8)) p_h2(a, mk_wid);
    SEAM(8);
    if (IN(9)) {
        pg8::Gemm g{(const pg8::bf16_t*)(ws + WS_H2), (const pg8::bf16_t*)(ws + WS_WFI), MLAT, 2 * DFF, DM}; pg8::StaticOrder S; S.init(MLAT, 2 * DFF, G, bx);
        EpiSwiglu E{(u16*)(ws + WS_ACT)};
        pg8::gemm_phase<EpiSwiglu, pg8::StaticOrder, true, true>(lds3, g, S, E, mk_wid);
    }
    SEAM(9);
    if (IN(10)) {
        pg8::Gemm g{(const pg8::bf16_t*)(ws + WS_ACT), (const pg8::bf16_t*)(ws + WS_WFO), MLAT, DM, DFF}; pg8::StaticOrder S; S.init(MLAT, DM, G, bx, 2);
        EpiGateResB<true> E{(const void*)(ws + WS_X1), (void*)a.out, (const float*)(ws + WS_MOD) + 5 * 1024};
        pg8::gemm_phase<EpiGateResB<true>, pg8::StaticOrder, true, true>(lds3, g, S, E, mk_wid);
    }
#undef IN
#undef SEAM
}

extern "C" void kernel_launch(void* const* d_in, const int* in_sizes, int n_in, void* d_out, int out_size, void* d_ws, size_t ws_size, hipStream_t stream) {
    static int grid = 0;
    if (grid == 0) {
        if (n_in != 21 || in_sizes[0] != MLAT * DM || out_size != MLAT * DM || ws_size < WS_END) {
            fprintf(stderr, "kernel_launch: unexpected shapes: n_in %d in0 %d out %d ws %zu (need >= %zu)\n", n_in, n_in > 0 ? in_sizes[0] : -1, out_size, ws_size, (size_t)WS_END); grid = -1; return; }
        int dev = 0, cus = 0, per_cu = 0;
        if (hipGetDevice(&dev) != hipSuccess || hipDeviceGetAttribute(&cus, hipDeviceAttributeMultiprocessorCount, dev) != hipSuccess) { grid = -1; return; }
        if (hipFuncSetAttribute((const void*)mk_fwd, hipFuncAttributeMaxDynamicSharedMemorySize, LDS_BYTES) != hipSuccess) { fprintf(stderr, "kernel_launch: hipFuncSetAttribute failed\n"); grid = -1; return; }
        if (hipOccupancyMaxActiveBlocksPerMultiprocessor(&per_cu, (const void*)mk_fwd, 512, LDS_BYTES) != hipSuccess || per_cu < 1) { fprintf(stderr, "kernel_launch: occupancy query says %d blocks per CU\n", per_cu); grid = -1; return; }
        grid = cus;
    }
    if (grid < 0) return;
    Args a{};
    for (int i = 0; i < 21; ++i) a.in[i] = (const float*)d_in[i];
    a.out = (float*)d_out; a.ws = (unsigned char*)d_ws;
#if MK_PER_PHASE
    for (int ph = 0; ph < NPH; ++ph) { a.ph_lo = ph; a.ph_hi = ph + 1; hipLaunchKernelGGL(mk_fwd, dim3(grid), dim3(512), LDS_BYTES, stream, a); }
#else
    a.ph_lo = 0; a.ph_hi = NPH;
    void* args[] = {&a};
    const hipError_t e = hipLaunchCooperativeKernel((const void*)mk_fwd, dim3(grid), dim3(512), args, LDS_BYTES, stream);
    if (e != hipSuccess) fprintf(stderr, "kernel_launch: cooperative launch failed: %s (grid %d)\n", hipGetErrorString(e), grid);
#endif
}
```

```cpp
#include <hip/hip_runtime.h>
#include <hip/hip_bf16.h>
#include <hip/hip_cooperative_groups.h>
#include <cstdio>
#include <cstdint>
namespace cg = cooperative_groups;
__device__ __forceinline__ int mk_lane_() { int l; asm volatile("v_mbcnt_lo_u32_b32 %0, -1, 0\n\tv_mbcnt_hi_u32_b32 %0, -1, %0" : "=v"(l)); return l; }
#define MK_LANE() mk_lane_()
#define MK_TID (mk_wid * 64 + MK_LANE())
namespace pg8 {
#define PG8_LAS __attribute__((address_space(3)))
typedef unsigned short bf16_t;
typedef short bf16x8 __attribute__((ext_vector_type(8)));
typedef float f32x4 __attribute__((ext_vector_type(4)));
typedef unsigned u32x4 __attribute__((ext_vector_type(4)));
constexpr int BM = 256, BK = 64, HALF = 128, HTB = HALF * BK * 2  , STAGE_BYTES = 8 * HTB, NXCD = 8, WGM = 4  ;

__host__ __device__ __forceinline__ int lds_byte(int r, int c) { const int st = (r >> 4) * 2 + (c >> 5), rr = r & 15, cc = c & 31, ob = rr * 64 + cc * 2; return st * 1024 + (ob ^ (((ob >> 9) & 1) << 5)); }
__host__ __device__ __forceinline__ void stage_rc(int b, int& R, int& C) { const int st = b / 1024, sb = b % 1024, swz = sb ^ (((sb >> 9) & 1) << 5); R = (st >> 1) * 16 + swz / 64; C = (st & 1) * 32 + (swz % 64) / 2; }
__host__ __device__ __forceinline__ int perm32(int rho) { const int n = rho >> 4, i = rho & 15; return 8 * (i >> 2) + 4 * n + (i & 3); }

struct Unit { int pm, pn; };
struct Gemm { const bf16_t* A; const bf16_t* Bt; int M, N, K; };

struct StaticOrder {
    int nM, nN, nwg, G, c, wgm;
    __host__ __device__ void init(int M, int N, int G_, int c_, int wgm_ = WGM) { nM = M / BM; nN = N / BM; nwg = nM * nN; G = G_; c = c_; wgm = wgm_; }
    __host__ __device__ bool next(int i, Unit& u) const {
        const long L = (long)i * G + c; if (L >= nwg) return false;
        int wgid = (int)L; { const int q = nwg / NXCD, r = nwg % NXCD, xcd = wgid % NXCD, off = wgid / NXCD; wgid = (xcd < r ? xcd * (q + 1) : r * (q + 1) + (xcd - r) * q) + off; }
        const int nig = wgm * nN, gid = wgid / nig, fm = gid * wgm, gsz = (nM - fm) < wgm ? (nM - fm) : wgm;
        u.pm = fm + ((wgid % nig) % gsz); u.pn = (wgid % nig) / gsz; return true;
    }
    __device__ __forceinline__ void a_ready(const Unit&) const {}
    __device__ __forceinline__ void done(const Unit&) const {}
};

__device__ __forceinline__ unsigned cvt_pk_bf16(float lo, float hi) { unsigned r; asm volatile("v_cvt_pk_bf16_f32 %0, %1, %2" : "=v"(r) : "v"(lo), "v"(hi)); return r; }
typedef float f32x2 __attribute__((ext_vector_type(2)));
template <class Epi, class Sched, bool ALIGN_EPI = false, bool SP2 = false>
__device__ __forceinline__ void gemm_phase(PG8_LAS unsigned char* lds, const Gemm g, const Sched& S, const Epi& E, const int mk_wid) {
    const int tid = MK_TID, wid = mk_wid, lane = tid & 63, wr = wid >> 2, wc = wid & 3, fr = lane & 15, fq = lane >> 4;
    const int K = g.K, nt = K / BK;
    unsigned voffA[2], voffB[2];
#pragma unroll
    for (int i = 0; i < 2; ++i) { int R, C; stage_rc(tid * 16 + i * 8192, R, C); const int Rb = Epi::PERM ? ((R & ~31) + perm32(R & 31)) : R;
        voffA[i] = (unsigned)(R * K + C) * 2u; voffB[i] = (unsigned)(Rb * K + C) * 2u; }
    const size_t kstep = (size_t)(BK * 2);
    const size_t hstep = (size_t)HALF * K * 2;
    const size_t tstep = 2 * hstep;
    const unsigned ldsw = (unsigned)wid * 1024u;
    const int aoff = lds_byte(wr * 64 + fr, fq * 8), boff = lds_byte(wc * 32 + fr, fq * 8);
#define PG8_SA(b, h) (((b) * 2 + (h)) * HTB)
#define PG8_SB(b, h) ((4 + (b) * 2 + (h)) * HTB)
#define PG8_STAGE(bufoff, gbase, voff) do { _Pragma("unroll") for (int _i = 0; _i < 2; ++_i) \
        __builtin_amdgcn_global_load_lds((const unsigned*)((const char*)(gbase) + (voff)[_i]), (PG8_LAS unsigned*)(lds + (bufoff) + ldsw + _i * 8192), 16, 0, 0); } while (0)
#define PG8_LDA(dst, b, h) do { _Pragma("unroll") for (int m = 0; m < 4; ++m) _Pragma("unroll") for (int k = 0; k < 2; ++k) dst[m][k] = *(const PG8_LAS bf16x8*)(lds + PG8_SA(b, h) + aoff + m * 2048 + k * 1024); } while (0)
#define PG8_LDB(dst, b, h) do { _Pragma("unroll") for (int n = 0; n < 2; ++n) _Pragma("unroll") for (int k = 0; k < 2; ++k) dst[n][k] = *(const PG8_LAS bf16x8*)(lds + PG8_SB(b, h) + boff + n * 2048 + k * 1024); } while (0)
#define PG8_MMA(ai, bj, At, Bt) do { __builtin_amdgcn_s_setprio(1); _Pragma("unroll") for (int m = 0; m < 4; ++m) _Pragma("unroll") for (int n = 0; n < 2; ++n) _Pragma("unroll") for (int k = 0; k < 2; ++k) \
        acc[ai][bj][m][n] = __builtin_amdgcn_mfma_f32_16x16x32_bf16(Bt[n][k], At[m][k], acc[ai][bj][m][n], 0, 0, 0); __builtin_amdgcn_s_setprio(0); } while (0)
#define PG8_WAIT_V(n) asm volatile("s_waitcnt vmcnt(" #n ")" ::: "memory")
#define PG8_WAIT_L(n) asm volatile("s_waitcnt lgkmcnt(" #n ")" ::: "memory")
#define PG8_BAR __builtin_amdgcn_s_barrier()
#define PG8_SCHED __builtin_amdgcn_sched_barrier(0)
    Unit cur, nxt; int ui = 0;
    if (!S.next(0, cur)) return;
    f32x4 acc[2][2][4][2];
#pragma unroll
    for (int a = 0; a < 2; ++a)
#pragma unroll
        for (int b = 0; b < 2; ++b)
#pragma unroll
            for (int m = 0; m < 4; ++m)
#pragma unroll
                for (int n = 0; n < 2; ++n) acc[a][b][m][n] = (f32x4){0.f, 0.f, 0.f, 0.f};
    bf16x8 At[4][2], B0[2][2], B1[2][2];
    const char* cA = (const char*)g.A + (size_t)cur.pm * tstep; const char* cB = (const char*)g.Bt + (size_t)cur.pn * tstep;
    S.a_ready(cur);
    if constexpr (SP2) {
        PG8_STAGE(PG8_SB(0, 0), cB, voffB); PG8_STAGE(PG8_SB(0, 1), cB + hstep, voffB); PG8_STAGE(PG8_SA(0, 0), cA, voffA); PG8_STAGE(PG8_SA(0, 1), cA + hstep, voffA);
        if (wr == 1) PG8_BAR;
        PG8_WAIT_V(2); PG8_BAR;
        PG8_STAGE(PG8_SB(1, 0), cB + kstep, voffB); PG8_STAGE(PG8_SA(1, 0), cA + kstep, voffA); PG8_STAGE(PG8_SB(1, 1), cB + hstep + kstep, voffB);
        PG8_WAIT_V(6); PG8_BAR;
    } else {
        PG8_STAGE(PG8_SB(0, 0), cB, voffB); PG8_STAGE(PG8_SA(0, 0), cA, voffA); PG8_STAGE(PG8_SB(0, 1), cB + hstep, voffB); PG8_STAGE(PG8_SA(0, 1), cA + hstep, voffA);
        if (wr == 1) PG8_BAR;
        PG8_WAIT_V(4); PG8_BAR;
        PG8_STAGE(PG8_SB(1, 0), cB + kstep, voffB); PG8_STAGE(PG8_SA(1, 0), cA + kstep, voffA); PG8_STAGE(PG8_SB(1, 1), cB + hstep + kstep, voffB);
        PG8_WAIT_V(6); PG8_BAR;
    }
    for (;;) {
        const bool has_next = S.next(ui + 1, nxt);
        const char* nA = has_next ? (const char*)g.A + (size_t)nxt.pm * tstep : cA; const char* nB = has_next ? (const char*)g.Bt + (size_t)nxt.pn * tstep : cB;
        for (int t = 0; t < nt; t += 2) {
            const bool last = (t == nt - 2);
            const char* a1 = cA + (size_t)(t + 1) * kstep;
            const char* a2 = last ? nA : cA + (size_t)(t + 2) * kstep; const char* b2 = last ? nB : cB + (size_t)(t + 2) * kstep;
            const char* a3 = a2 + kstep; const char* b3 = b2 + kstep;
            if (last && has_next) S.a_ready(nxt);
            if constexpr (SP2) {
            PG8_LDB(B0, 0, 0); PG8_LDB(B1, 0, 1); PG8_SCHED; PG8_LDA(At, 0, 0); PG8_STAGE(PG8_SA(1, 1), a1 + hstep, voffA);
            PG8_WAIT_V(8); PG8_WAIT_L(0); PG8_BAR; PG8_MMA(0, 0, At, B0); PG8_MMA(0, 1, At, B1); PG8_BAR; PG8_SCHED;
            PG8_LDA(At, 0, 1); PG8_STAGE(PG8_SB(0, 0), b2, voffB); PG8_STAGE(PG8_SB(0, 1), b2 + hstep, voffB); PG8_STAGE(PG8_SA(0, 0), a2, voffA);
            PG8_WAIT_V(8); PG8_WAIT_L(0); PG8_BAR; PG8_MMA(1, 0, At, B0); PG8_MMA(1, 1, At, B1); PG8_BAR; PG8_SCHED;
            PG8_LDB(B0, 1, 0); PG8_LDB(B1, 1, 1); PG8_SCHED; PG8_LDA(At, 1, 0); PG8_STAGE(PG8_SA(0, 1), a2 + hstep, voffA);
            PG8_WAIT_V(8); PG8_WAIT_L(0); PG8_BAR; PG8_MMA(0, 0, At, B0); PG8_MMA(0, 1, At, B1); PG8_BAR; PG8_SCHED;
            PG8_LDA(At, 1, 1); PG8_STAGE(PG8_SB(1, 0), b3, voffB); PG8_STAGE(PG8_SB(1, 1), b3 + hstep, voffB); PG8_STAGE(PG8_SA(1, 0), a3, voffA);
            PG8_WAIT_V(8); PG8_WAIT_L(0); PG8_BAR; PG8_MMA(1, 0, At, B0); PG8_MMA(1, 1, At, B1); PG8_BAR; PG8_SCHED;
            } else {
            PG8_LDB(B0, 0, 0); PG8_SCHED; PG8_LDA(At, 0, 0); PG8_STAGE(PG8_SA(1, 1), a1 + hstep, voffA);
            PG8_WAIT_L(8); PG8_BAR; PG8_WAIT_L(0); PG8_MMA(0, 0, At, B0); PG8_BAR; PG8_SCHED;
            PG8_LDB(B1, 0, 1); PG8_STAGE(PG8_SB(0, 0), b2, voffB);
            PG8_BAR; PG8_WAIT_L(0); PG8_MMA(0, 1, At, B1); PG8_BAR;
            PG8_LDA(At, 0, 1); PG8_STAGE(PG8_SA(0, 0), a2, voffA);
            PG8_BAR; PG8_WAIT_L(0); PG8_MMA(1, 0, At, B0); PG8_BAR; PG8_SCHED;
            PG8_STAGE(PG8_SB(0, 1), b2 + hstep, voffB);
            PG8_WAIT_V(6); PG8_BAR; PG8_MMA(1, 1, At, B1); PG8_BAR;
            PG8_LDB(B0, 1, 0); PG8_SCHED; PG8_LDA(At, 1, 0); PG8_STAGE(PG8_SA(0, 1), a2 + hstep, voffA);
            PG8_WAIT_L(8); PG8_BAR; PG8_WAIT_L(0); PG8_MMA(0, 0, At, B0); PG8_BAR; PG8_SCHED;
            PG8_LDB(B1, 1, 1); PG8_STAGE(PG8_SB(1, 0), b3, voffB);
            PG8_BAR; PG8_WAIT_L(0); PG8_MMA(0, 1, At, B1); PG8_BAR;
            PG8_LDA(At, 1, 1); PG8_STAGE(PG8_SA(1, 0), a3, voffA);
            PG8_BAR; PG8_WAIT_L(0); PG8_MMA(1, 0, At, B0); PG8_BAR; PG8_SCHED;
            PG8_STAGE(PG8_SB(1, 1), b3 + hstep, voffB);
            PG8_WAIT_V(6); PG8_BAR; PG8_MMA(1, 1, At, B1); PG8_BAR;
            }
        }
        if constexpr (ALIGN_EPI) { if (wr == 0) PG8_BAR; }
        if constexpr (!Epi::AFTER_DRAIN) { E(acc, cur, wr, wc, fr, fq); S.done(cur); }
        if (!has_next) break;
#pragma unroll
        for (int a = 0; a < 2; ++a)
#pragma unroll
            for (int b = 0; b < 2; ++b)
#pragma unroll
                for (int m = 0; m < 4; ++m)
#pragma unroll
                    for (int n = 0; n < 2; ++n) acc[a][b][m][n] = (f32x4){0.f, 0.f, 0.f, 0.f};
        cur = nxt; cA = nA; cB = nB; ++ui;
        if constexpr (ALIGN_EPI) { if (wr == 1) PG8_BAR; }
    }
    PG8_WAIT_V(0);
    if constexpr (!ALIGN_EPI) { if (wr == 0) PG8_BAR; }
    PG8_BAR;
    if constexpr (Epi::AFTER_DRAIN) { E.fused(acc, cur, wr, wc, fr, fq, lds, wid, lane); S.done(cur); }
#undef PG8_SA
#undef PG8_SB
#undef PG8_STAGE
#undef PG8_LDA
#undef PG8_LDB
#undef PG8_MMA
#undef PG8_WAIT_V
#undef PG8_WAIT_L
#undef PG8_BAR
#undef PG8_SCHED
}
}
namespace att {
using bf16 = __hip_bfloat16;
constexpr int   D = 128, NW = 8, QBLK = 32, KVBLK = 64;
constexpr float SCALE = 0.088388347648318440f;
constexpr float THR = 8.f;
constexpr int LDQ = 1024, LDK = 256, LDO = 1024;
constexpr size_t SHM_V = KVBLK * D * 2, SHM_K = KVBLK * D * 2, SHM_ATTN = 2 * SHM_V + 2 * SHM_K + NW * 64 * 4;
using bf16x8 = __attribute__((ext_vector_type(8))) short;
using s16x4  = __attribute__((ext_vector_type(4))) short;
using f32x16 = __attribute__((ext_vector_type(16))) float;
using f32x8  = __attribute__((ext_vector_type(8))) float;
using u32x4  = __attribute__((ext_vector_type(4))) unsigned;
#define KSWZ(row, colB) ((row) * 256 + ((colB) ^ (((row) & 7) << 4)))
#define SBAR() __builtin_amdgcn_sched_barrier(0)
__device__ __forceinline__ int crow(int r, int hi) { return (r & 3) + 8 * (r >> 2) + 4 * hi; }
__device__ __forceinline__ unsigned cvtpk(float lo, float hi) {
  unsigned r; asm volatile("v_cvt_pk_bf16_f32 %0, %1, %2" : "=v"(r) : "v"(lo), "v"(hi)); return r;
}
template <typename TIn> struct Stage;
template <> struct Stage<bf16>  { using T = bf16x8;
  __device__ static __forceinline__ T ld8(const bf16* p) { return *reinterpret_cast<const bf16x8*>(p); }
  __device__ static __forceinline__ bf16x8 tobf(T x) { return x; } };
template <> struct Stage<float> { using T = f32x8;
  __device__ static __forceinline__ T ld8(const float* p) { return *reinterpret_cast<const f32x8*>(p); }
  __device__ static __forceinline__ bf16x8 tobf(T x) {
    u32x4 w = {cvtpk(x[0], x[1]), cvtpk(x[2], x[3]), cvtpk(x[4], x[5]), cvtpk(x[6], x[7])}; return *reinterpret_cast<bf16x8*>(&w); } };

__device__ __forceinline__ void partialSM(f32x16& p0, f32x16& p1, float& m_reg, float& mn, float& alpha) {
  constexpr float C = SCALE * 1.4426950408889634f;
  float pmax = p0[0]; for (int r = 1; r < 16; ++r) pmax = fmaxf(pmax, p0[r]); for (int r = 0; r < 16; ++r) pmax = fmaxf(pmax, p1[r]);
  { auto rr = __builtin_amdgcn_permlane32_swap(__float_as_uint(pmax), __float_as_uint(pmax), false, false);
    pmax = fmaxf(__uint_as_float(rr[0]), __uint_as_float(rr[1])); }
  if (__builtin_expect(__all(pmax - m_reg <= THR / SCALE), 1)) { mn = m_reg; alpha = 1.f; }
  else { mn = fmaxf(m_reg, pmax); alpha = __builtin_amdgcn_exp2f((m_reg - mn) * C); m_reg = mn; }
  float mnC = -mn * C;
  for (int r = 0; r < 16; ++r) p0[r] = fmaf(p0[r], C, mnC); for (int r = 0; r < 16; ++r) p1[r] = fmaf(p1[r], C, mnC);
  for (int r = 0; r < 16; ++r) p0[r] = __builtin_amdgcn_exp2f(p0[r]);
}
__device__ __forceinline__ void finishSM(f32x16& p0, f32x16& p1, float alpha, float& l_reg, bf16x8& pa0, bf16x8& pa1, bf16x8& pa2, bf16x8& pa3) {
  for (int r = 0; r < 16; ++r) p1[r] = __builtin_amdgcn_exp2f(p1[r]);
  float ps = 0; for (int r = 0; r < 16; ++r) ps += p0[r]; for (int r = 0; r < 16; ++r) ps += p1[r];
  { auto rr = __builtin_amdgcn_permlane32_swap(__float_as_uint(ps), __float_as_uint(ps), false, false);
    ps = __uint_as_float(rr[0]) + __uint_as_float(rr[1]); }
  l_reg = l_reg * alpha + ps;
#define PK4(P, BASE, OUT) do { unsigned a0 = cvtpk(P[BASE + 0], P[BASE + 1]), a1 = cvtpk(P[BASE + 2], P[BASE + 3]);   \
    unsigned b0 = cvtpk(P[BASE + 4], P[BASE + 5]), b1 = cvtpk(P[BASE + 6], P[BASE + 7]);                              \
    auto r0 = __builtin_amdgcn_permlane32_swap(a0, b0, false, false); auto r1 = __builtin_amdgcn_permlane32_swap(a1, b1, false, false); \
    u32x4 w = {r0[0], r1[0], r0[1], r1[1]}; OUT = *reinterpret_cast<bf16x8*>(&w); } while (0)
  PK4(p0, 0, pa0); PK4(p0, 8, pa1); PK4(p1, 0, pa2); PK4(p1, 8, pa3);
#undef PK4
}
__device__ __forceinline__ void qkt(f32x16& p0, f32x16& p1, const bf16* Ks, const bf16x8* qr, int r32, int hi) {
  p0 = f32x16{}; p1 = f32x16{};
  for (int d0 = 0; d0 < 8; ++d0) { int cb = (d0 * 16 + hi * 8) * 2;
    bf16x8 b0 = *reinterpret_cast<const bf16x8*>((const char*)Ks + KSWZ(r32, cb));
    bf16x8 b1 = *reinterpret_cast<const bf16x8*>((const char*)Ks + KSWZ(32 + r32, cb));
    p0 = __builtin_amdgcn_mfma_f32_32x32x16_bf16(b0, qr[d0], p0, 0, 0, 0);
    p1 = __builtin_amdgcn_mfma_f32_32x32x16_bf16(b1, qr[d0], p1, 0, 0, 0); }
}
__device__ __forceinline__ int v_st(int k, int c) { const int kk = (k & ~0xC) | ((k & 4) << 1) | ((k & 8) >> 1); return ((kk >> 3) * 4 + (c >> 5)) * 512 + ((kk & 7) * 32 + (c & 31)) * 2; }
__device__ __forceinline__ int v_rd_base(int lane) { return ((lane & 3) << 3) | (((lane >> 2) & 3) << 6) | (((lane >> 4) & 1) << 5) | (((lane >> 5) & 1) << 8); }
constexpr int v_rd_off(int d0, int ks, int half) { return d0 * 512 + ks * 4096 + half * 2048; }
template <int OFF> __device__ __forceinline__ s16x4 tr_read(int vb) {
  s16x4 r; asm volatile("ds_read_b64_tr_b16 %0, %1 offset:%2" : "=&v"(r) : "v"(vb), "i"(OFF) : "memory"); return r;
}
template <int D0> __device__ __forceinline__ void pv_one(f32x16& od, int vb, bf16x8 pa0, bf16x8 pa1, bf16x8 pa2, bf16x8 pa3) {
  const s16x4 l0 = tr_read<v_rd_off(D0, 0, 0)>(vb), h0 = tr_read<v_rd_off(D0, 0, 1)>(vb), l1 = tr_read<v_rd_off(D0, 1, 0)>(vb), h1 = tr_read<v_rd_off(D0, 1, 1)>(vb);
  const s16x4 l2 = tr_read<v_rd_off(D0, 2, 0)>(vb), h2 = tr_read<v_rd_off(D0, 2, 1)>(vb), l3 = tr_read<v_rd_off(D0, 3, 0)>(vb), h3 = tr_read<v_rd_off(D0, 3, 1)>(vb);
  asm volatile("s_waitcnt lgkmcnt(0)" ::: "memory"); SBAR();
#define PK(L, H) (bf16x8){L[0], L[1], L[2], L[3], H[0], H[1], H[2], H[3]}
  od = __builtin_amdgcn_mfma_f32_32x32x16_bf16(pa0, PK(l0, h0), od, 0, 0, 0);
  od = __builtin_amdgcn_mfma_f32_32x32x16_bf16(pa1, PK(l1, h1), od, 0, 0, 0);
  od = __builtin_amdgcn_mfma_f32_32x32x16_bf16(pa2, PK(l2, h2), od, 0, 0, 0);
  od = __builtin_amdgcn_mfma_f32_32x32x16_bf16(pa3, PK(l3, h3), od, 0, 0, 0);
#undef PK
}
__device__ __forceinline__ void pv_d0(f32x16* o, int vb, bf16x8 pa0, bf16x8 pa1, bf16x8 pa2, bf16x8 pa3) {
  pv_one<0>(o[0], vb, pa0, pa1, pa2, pa3); pv_one<1>(o[1], vb, pa0, pa1, pa2, pa3); pv_one<2>(o[2], vb, pa0, pa1, pa2, pa3); pv_one<3>(o[3], vb, pa0, pa1, pa2, pa3);
}
__device__ __forceinline__ float bf2f(short s) { return __uint_as_float(((unsigned)(unsigned short)s) << 16); }
__device__ __forceinline__ void attn_unit(const bf16* Qb, const bf16* __restrict__ Kh, const bf16* __restrict__ Vh, bf16* Ob, int seq, char* lds,
                                          const float* __restrict__ rope, const float* __restrict__ qg, const int mk_wid) {
  using St = Stage<bf16>;
  int tid = MK_TID; asm volatile("" : "+v"(tid));
  const int wid = mk_wid, lane = tid & 63, r32 = lane & 31, hi = lane >> 5;
  bf16* V_lds = (bf16*)lds; bf16* K_lds = (bf16*)(lds + 2 * SHM_V);
  float* ws = (float*)(lds + 2 * SHM_V + 2 * SHM_K) + wid * 64; float* li_l = ws; float* al_l = ws + 32;
  float m_reg = -1e30f, l_reg = 0; f32x16 o[4] = {}; bf16x8 qr[8];
  const int sr = tid >> 4, sc = (tid & 15) * 8, vst0 = v_st(sr, sc), vst1 = v_st(32 + sr, sc);
  const int vb0 = (int)(uintptr_t)V_lds + v_rd_base(lane);
  struct { typename St::T vs0, vs1, ks0, ks1; } sr_[2];
#define SLOAD(i, k0) do { sr_[i].vs0 = St::ld8(&Vh[(long)((k0) + sr) * LDK + sc]); sr_[i].vs1 = St::ld8(&Vh[(long)((k0) + 32 + sr) * LDK + sc]); \
    sr_[i].ks0 = St::ld8(&Kh[(long)((k0) + sr) * LDK + sc]); sr_[i].ks1 = St::ld8(&Kh[(long)((k0) + 32 + sr) * LDK + sc]); } while (0)
#define SWRITE(b, i) do { *(bf16x8*)((char*)V_lds + (b) * SHM_V + vst0) = St::tobf(sr_[i].vs0);          \
    *(bf16x8*)((char*)V_lds + (b) * SHM_V + vst1) = St::tobf(sr_[i].vs1); int kc = sc * 2;               \
    *(bf16x8*)((char*)K_lds + (b) * SHM_K + KSWZ(sr, kc)) = St::tobf(sr_[i].ks0);                       \
    *(bf16x8*)((char*)K_lds + (b) * SHM_K + KSWZ(32 + sr, kc)) = St::tobf(sr_[i].ks1); } while (0)
#define SWAIT() do { asm volatile("s_waitcnt vmcnt(4)" ::: "memory"); } while (0)
#define RESC(a) do { if (__any((a) < 1.f)) { if (hi == 0) al_l[r32] = (a); asm volatile("s_waitcnt lgkmcnt(0)" ::: "memory"); \
    for (int d = 0; d < 4; ++d) for (int r = 0; r < 16; ++r) o[d][r] *= al_l[crow(r, hi)]; } } while (0)
  constexpr int SE = 0, SO = 1;
  {
    int tp = MK_TID; asm volatile("" : "+v"(tp)); const int r32 = tp & 31, hi = (tp >> 5) & 1;
    const bf16* Qw = Qb + (long)(wid * QBLK + r32) * LDQ + hi * 8;
    const float* rp = rope + ((long)(wid * QBLK + r32) * 64 + hi * 4) * 2;
    bf16x8 rw[8]; float4 gA[8], gB[8], cA[8], cB[8];
#pragma unroll
    for (int d0 = 0; d0 < 8; ++d0) { rw[d0] = *reinterpret_cast<const bf16x8*>(Qw + d0 * 16);
      gA[d0] = *reinterpret_cast<const float4*>(qg + d0 * 16 + hi * 8); gB[d0] = *reinterpret_cast<const float4*>(qg + d0 * 16 + hi * 8 + 4);
      cA[d0] = *reinterpret_cast<const float4*>(rp + d0 * 16); cB[d0] = *reinterpret_cast<const float4*>(rp + d0 * 16 + 4); }
    float ss = 0.f;
#pragma unroll
    for (int d0 = 0; d0 < 8; ++d0)
#pragma unroll
      for (int e = 0; e < 8; ++e) { const float f = bf2f(rw[d0][e]); ss += f * f; }
    { auto rr = __builtin_amdgcn_permlane32_swap(__float_as_uint(ss), __float_as_uint(ss), false, false); ss = __uint_as_float(rr[0]) + __uint_as_float(rr[1]); }
    const float rinv = rsqrtf(ss * (1.f / 128.f) + 1e-6f);
#pragma unroll
    for (int d0 = 0; d0 < 8; ++d0) {
      const float4 g0 = gA[d0], g1 = gB[d0], cs0 = cA[d0], cs1 = cB[d0];
      const float x0 = bf2f(rw[d0][0]) * rinv * g0.x, x1 = bf2f(rw[d0][1]) * rinv * g0.y, x2 = bf2f(rw[d0][2]) * rinv * g0.z, x3 = bf2f(rw[d0][3]) * rinv * g0.w;
      const float x4 = bf2f(rw[d0][4]) * rinv * g1.x, x5 = bf2f(rw[d0][5]) * rinv * g1.y, x6 = bf2f(rw[d0][6]) * rinv * g1.z, x7 = bf2f(rw[d0][7]) * rinv * g1.w;
      u32x4 w = {cvtpk(x0 * cs0.x - x1 * cs0.y, x0 * cs0.y + x1 * cs0.x), cvtpk(x2 * cs0.z - x3 * cs0.w, x2 * cs0.w + x3 * cs0.z),
                 cvtpk(x4 * cs1.x - x5 * cs1.y, x4 * cs1.y + x5 * cs1.x), cvtpk(x6 * cs1.z - x7 * cs1.w, x6 * cs1.w + x7 * cs1.z)};
      qr[d0] = *reinterpret_cast<bf16x8*>(&w);
    }
  }
  f32x16 pA0, pA1, pB0, pB1; float mnA, mnB, alA, alB; bf16x8 pa0, pa1, pa2, pa3; const int NT = seq / KVBLK;
  SLOAD(SE, 0); asm volatile("s_waitcnt vmcnt(0)" ::: "memory"); SWRITE(0, SE); __syncthreads();
  qkt(pA0, pA1, K_lds, qr, r32, hi); partialSM(pA0, pA1, m_reg, mnA, alA);
  SLOAD(SO, KVBLK); if (2 < NT) SLOAD(SE, 2 * KVBLK);
  SWAIT(); SWRITE(1, SO); __syncthreads();
  for (int j = 1; j + 1 < NT; j += 2) {
    SBAR(); qkt(pB0, pB1, (bf16*)((char*)K_lds + SHM_K), qr, r32, hi);
    finishSM(pA0, pA1, alA, l_reg, pa0, pa1, pa2, pa3); SBAR();
    SLOAD(SO, (j + 2) * KVBLK); SBAR();
    pv_d0(o, vb0, pa0, pa1, pa2, pa3); partialSM(pB0, pB1, m_reg, mnB, alB);
    __syncthreads(); SWAIT(); SWRITE(0, SE);
    RESC(alB); __syncthreads();
    SBAR(); qkt(pA0, pA1, K_lds, qr, r32, hi);
    finishSM(pB0, pB1, alB, l_reg, pa0, pa1, pa2, pa3); SBAR();
    if (j + 3 < NT) SLOAD(SE, (j + 3) * KVBLK); SBAR();
    pv_d0(o, vb0 + (int)SHM_V, pa0, pa1, pa2, pa3); partialSM(pA0, pA1, m_reg, mnA, alA);
    __syncthreads(); SWAIT(); SWRITE(1, SO);
    RESC(alA); __syncthreads();
  }
  SBAR(); qkt(pB0, pB1, (bf16*)((char*)K_lds + SHM_K), qr, r32, hi);
  finishSM(pA0, pA1, alA, l_reg, pa0, pa1, pa2, pa3); SBAR();
  pv_d0(o, vb0, pa0, pa1, pa2, pa3); partialSM(pB0, pB1, m_reg, mnB, alB);
  __syncthreads(); RESC(alB);
  finishSM(pB0, pB1, alB, l_reg, pa0, pa1, pa2, pa3); SBAR();
  pv_d0(o, vb0 + (int)SHM_V, pa0, pa1, pa2, pa3);
  if (hi == 0) li_l[r32] = l_reg; asm volatile("s_waitcnt lgkmcnt(0)" ::: "memory");
  float rli[16];
#pragma unroll
  for (int r = 0; r < 16; ++r) rli[r] = __builtin_amdgcn_rcpf(li_l[crow(r, hi)]);
  __syncthreads();
  { int te = MK_TID; asm volatile("" : "+v"(te)); const int lane = te & 63, r32 = lane & 31, hi = lane >> 5;
    unsigned short* stg = (unsigned short*)(lds + wid * 8192);
#pragma unroll
    for (int r = 0; r < 16; ++r) { const int orow = crow(r, hi);
#pragma unroll
      for (int d0 = 0; d0 < 4; ++d0) stg[orow * 128 + d0 * 32 + r32] = (unsigned short)(cvtpk(o[d0][r] * rli[r], 0.f) & 0xffffu); }
    asm volatile("s_waitcnt lgkmcnt(0)" ::: "memory");
    bf16* Ow = Ob + (long)(wid * QBLK) * LDO;
#pragma unroll
    for (int i = 0; i < 8; ++i) { const int row = i * 4 + (lane >> 4), ch = lane & 15; const u32x4 v = *(const u32x4*)(stg + row * 128 + ch * 8); *(u32x4*)(Ow + (long)row * LDO + ch * 8) = v; } }
  __syncthreads();
#undef SLOAD
#undef SWRITE
#undef SWAIT
#undef RESC
}
}
constexpr int NB = 16, T = 2048, TC = 256, TA = T + TC, DM = 1024;
constexpr int MLAT = NB * T, MALL = NB * TA;
constexpr int NIN = 6912;
constexpr int DFF = 2816;
constexpr float EPS = 1e-6f;
constexpr size_t MiB = 1u << 20;
constexpr size_t WS_MOD = 1 * MiB, WS_ROPE = 2 * MiB, WS_WIN = 4 * MiB, WS_WAP = 18 * MiB, WS_WGP = 20 * MiB, WS_WOUT = 22 * MiB, WS_WFI = 24 * MiB, WS_WFO = 36 * MiB,
                 WS_H1 = 42 * MiB, WS_Q = 114 * MiB, WS_K = 178 * MiB, WS_V = 196 * MiB, WS_GQ = 214 * MiB, WS_GK = 250 * MiB, WS_GV = 286 * MiB, WS_GG = 358 * MiB,
                 WS_LR = 422 * MiB, WS_OB = 426 * MiB, WS_END = 490 * MiB;
constexpr size_t WS_OF = WS_H1, WS_T1 = WS_GQ  , WS_H2 = WS_H1, WS_MRG = WS_GV, WS_ACT = WS_Q, WS_X1 = WS_OB  ;
constexpr int LDS_BYTES = 147456;
constexpr int NPH = 11;
constexpr int WI_IN = 16 * 216, WI_PROJ = WI_IN + 3 * 16 * 32, WI_ALL = WI_PROJ + 16 * 176 + 44 * 32;

typedef unsigned short u16;
typedef unsigned v4u __attribute__((ext_vector_type(4)));
typedef unsigned v2u __attribute__((ext_vector_type(2)));
typedef float f32x4 __attribute__((ext_vector_type(4)));
#define LAS __attribute__((address_space(3)))

struct Args { const float* in[21]; float* out; unsigned char* ws; int ph_lo, ph_hi; };

__device__ __forceinline__ float bf2f(u16 u) { return __uint_as_float((unsigned)u << 16); }
typedef float f32x2_t __attribute__((ext_vector_type(2))); typedef __bf16 bf16x2_t __attribute__((ext_vector_type(2)));
__device__ __forceinline__ unsigned pk2(float lo, float hi) { f32x2_t v = {lo, hi}; bf16x2_t b = __builtin_convertvector(v, bf16x2_t); return __builtin_bit_cast(unsigned, b); }
__device__ __forceinline__ u16 f2bf(float f) { return (u16)(pk2(f, 0.f) & 0xffffu); }
__device__ __forceinline__ float wave_sum(float v) {
#pragma unroll
    for (int o = 1; o < 64; o <<= 1) v += __shfl_xor(v, o);
    return v;
}
__device__ __forceinline__ float sigmoidf_(float x) { return __builtin_amdgcn_rcpf(1.f + __expf(-x)); }

struct EpiInProj {
    static constexpr bool PERM = true, AFTER_DRAIN = false;
    unsigned char* ws; u16* MG;
    __device__ __forceinline__ void operator()(const pg8::f32x4 (&acc)[2][2][4][2], const pg8::Unit& u, int wr, int wc, int fr, int fq) const {
        const int b = u.pm / 9, j = u.pm % 9, pn = u.pn; const bool isctx = (j == 0);
        const long rall = (long)u.pm * 256, rlat = (long)b * T + (j - 1) * 256;
        u16* base; int ld, colt; long row0;
        if (pn < 4)       { if (isctx) return; base = (u16*)(ws + WS_Q);  ld = 1024; colt = pn * 256;        row0 = rlat; }
        else if (pn == 4) {                    base = (u16*)(ws + WS_K);  ld = 256;  colt = 0;               row0 = rall; }
        else if (pn == 5) {                    base = (u16*)(ws + WS_V);  ld = 256;  colt = 0;               row0 = rall; }
        else if (pn < 8)  { if (isctx) return; base = (u16*)(ws + WS_GQ); ld = 512;  colt = (pn - 6) * 256;  row0 = rall; }
        else if (pn < 10) {                    base = (u16*)(ws + WS_GK); ld = 512;  colt = (pn - 8) * 256;  row0 = rall; }
        else if (pn < 14) {                    base = (u16*)(ws + WS_GV); ld = 1024; colt = (pn - 10) * 256; row0 = rall; }
        else if (pn < 18) { if (isctx) return; base = (u16*)(ws + WS_GG); ld = 1024; colt = (pn - 14) * 256; row0 = rlat; }
        else if (pn < 26) { if (isctx) return; base = MG;                 ld = 2048; colt = (pn - 18) * 256; row0 = rlat; }
        else              {                    base = (u16*)(ws + WS_LR); ld = 32;   colt = 0;               row0 = rall; }
        const bool lr = (pn == 26);
        if (lr && wc != 0) return;
        const int col0 = colt + wc * 32 + 8 * fq;
#pragma unroll
        for (int ai = 0; ai < 2; ++ai)
#pragma unroll
            for (int m = 0; m < 4; ++m) { u16* rowp = base + (size_t)(row0 + ai * 128 + wr * 64 + m * 16 + fr) * ld + col0;
#pragma unroll
                for (int bj = 0; bj < 2; ++bj) { if (lr && bj) continue;
                    const pg8::f32x4 v0 = acc[ai][bj][m][0], v1 = acc[ai][bj][m][1];
                    v4u w; w.x = pk2(v0[0], v0[1]); w.y = pk2(v0[2], v0[3]); w.z = pk2(v1[0], v1[1]); w.w = pk2(v1[2], v1[3]);
                    *(v4u*)(rowp + bj * 128) = w; } }
    }
};
struct InProjOrder {
    pg8::StaticOrder so; int G, c;
    __device__ void init(int G_, int c_) { so.init(128 * 256, 26 * 256, G_, c_); G = G_; c = c_; }
    __device__ bool next(int i, pg8::Unit& u) const {
        if (so.next(i, u)) { u.pm = (u.pm >> 3) * 9 + 1 + (u.pm & 7); return true; }
        const long q = (long)i * G + c - 3328; if (q < 0 || q >= 128) return false;
        const int b = (int)(q >> 3), t = (int)(q & 7);
        u.pm = b * 9; u.pn = t == 0 ? 4 : (t == 1 ? 5 : (t < 4 ? 6 + t : 6 + t)); return true;
    }
    __device__ __forceinline__ void a_ready(const pg8::Unit&) const {}
    __device__ __forceinline__ void done(const pg8::Unit&) const {}
};
template <int MODE> struct EpiMerge {
    static constexpr bool PERM = true, AFTER_DRAIN = false;
    const u16* MG; u16* T1; u16* MRG;
    __device__ __forceinline__ void operator()(const pg8::f32x4 (&acc)[2][2][4][2], const pg8::Unit& u, int wr, int wc, int fr, int fq) const {
        const int col0 = u.pn * 256 + wc * 32 + 8 * fq;
#pragma unroll
        for (int ai = 0; ai < 2; ++ai) {
            v4u gwv[4][2], twv[4][2];
#pragma unroll
            for (int m = 0; m < 4; ++m) { const size_t row = (size_t)u.pm * 256 + ai * 128 + wr * 64 + m * 16 + fr;
#pragma unroll
                for (int bj = 0; bj < 2; ++bj) { const int col = col0 + bj * 128;
                    gwv[m][bj] = __builtin_nontemporal_load((const v4u*)(MG + row * 2048 + MODE * 1024 + col));
                    twv[m][bj] = (MODE == 1) ? __builtin_nontemporal_load((const v4u*)(T1 + row * 1024 + col)) : (v4u){0u, 0u, 0u, 0u}; } }
#pragma unroll
            for (int m = 0; m < 4; ++m) { const size_t row = (size_t)u.pm * 256 + ai * 128 + wr * 64 + m * 16 + fr;
#pragma unroll
                for (int bj = 0; bj < 2; ++bj) { const int col = col0 + bj * 128;
                    const pg8::f32x4 v0 = acc[ai][bj][m][0], v1 = acc[ai][bj][m][1];
                    const float r[8] = {v0[0], v0[1], v0[2], v0[3], v1[0], v1[1], v1[2], v1[3]};
                    const unsigned gws[4] = {gwv[m][bj].x, gwv[m][bj].y, gwv[m][bj].z, gwv[m][bj].w};
                    const unsigned tws[4] = {twv[m][bj].x, twv[m][bj].y, twv[m][bj].z, twv[m][bj].w};
                    unsigned ow[4];
#pragma unroll
                    for (int e = 0; e < 4; ++e) {
                        float a0 = sigmoidf_(bf2f((u16)(gws[e] & 0xffffu))) * r[2 * e], a1 = sigmoidf_(bf2f((u16)(gws[e] >> 16))) * r[2 * e + 1];
                        if (MODE == 1) { a0 += bf2f((u16)(tws[e] & 0xffffu)); a1 += bf2f((u16)(tws[e] >> 16)); }
                        ow[e] = pk2(a0, a1); }
                    v4u w = {ow[0], ow[1], ow[2], ow[3]};
                    *(v4u*)((MODE == 0 ? T1 : MRG) + row * 1024 + col) = w; } }
        }
    }
};
struct EpiGateRes {
    static constexpr bool PERM = true, AFTER_DRAIN = false;
    const float* base; float* out; const float* gate;
    __device__ __forceinline__ void operator()(const pg8::f32x4 (&acc)[2][2][4][2], const pg8::Unit& u, int wr, int wc, int fr, int fq) const {
        const int col0 = u.pn * 256 + wc * 32 + 8 * fq; const int b = (u.pm * 256) / T;
        pg8::f32x4 gv[2][2];
#pragma unroll
        for (int bj = 0; bj < 2; ++bj)
#pragma unroll
            for (int n = 0; n < 2; ++n) gv[bj][n] = *(const pg8::f32x4*)(gate + (size_t)b * 6144 + col0 + bj * 128 + n * 4);
#pragma unroll
        for (int ai = 0; ai < 2; ++ai)
#pragma unroll
            for (int m = 0; m < 4; ++m) { const size_t off = ((size_t)u.pm * 256 + ai * 128 + wr * 64 + m * 16 + fr) * DM + col0;
#pragma unroll
                for (int bj = 0; bj < 2; ++bj)
#pragma unroll
                    for (int n = 0; n < 2; ++n) { const pg8::f32x4 bs = *(const pg8::f32x4*)(base + off + bj * 128 + n * 4);
                        *(pg8::f32x4*)(out + off + bj * 128 + n * 4) = bs + gv[bj][n] * acc[ai][bj][m][n]; } }
    }
};
template <bool IN_BF16> struct EpiGateResB {
    static constexpr bool PERM = true, AFTER_DRAIN = false;
    const void* base; void* out; const float* gate;
    __device__ __forceinline__ void operator()(const pg8::f32x4 (&acc)[2][2][4][2], const pg8::Unit& u, int wr, int wc, int fr, int fq) const {
        const int col0 = u.pn * 256 + wc * 32 + 8 * fq; const int b = (u.pm * 256) / T;
        pg8::f32x4 gv[2][2];
#pragma unroll
        for (int bj = 0; bj < 2; ++bj)
#pragma unroll
            for (int n = 0; n < 2; ++n) gv[bj][n] = *(const pg8::f32x4*)(gate + (size_t)b * 6144 + col0 + bj * 128 + n * 4);
#pragma unroll
        for (int ai = 0; ai < 2; ++ai) {
            pg8::f32x4 bs[4][2][2]; v4u bw[4][2];
#pragma unroll
            for (int m = 0; m < 4; ++m) { const size_t off = ((size_t)u.pm * 256 + ai * 128 + wr * 64 + m * 16 + fr) * DM + col0;
#pragma unroll
                for (int bj = 0; bj < 2; ++bj) {
                    if (IN_BF16) bw[m][bj] = __builtin_nontemporal_load((const v4u*)((const u16*)base + off + bj * 128));
                    else { bs[m][bj][0] = __builtin_nontemporal_load((const pg8::f32x4*)((const float*)base + off + bj * 128)); bs[m][bj][1] = __builtin_nontemporal_load((const pg8::f32x4*)((const float*)base + off + bj * 128 + 4)); } } }
#pragma unroll
            for (int m = 0; m < 4; ++m) { const size_t off = ((size_t)u.pm * 256 + ai * 128 + wr * 64 + m * 16 + fr) * DM + col0;
#pragma unroll
                for (int bj = 0; bj < 2; ++bj) {
                    pg8::f32x4 b0, b1;
                    if (IN_BF16) { const v4u w = bw[m][bj];
                        b0 = (pg8::f32x4){bf2f((u16)(w.x & 0xffffu)), bf2f((u16)(w.x >> 16)), bf2f((u16)(w.y & 0xffffu)), bf2f((u16)(w.y >> 16))};
                        b1 = (pg8::f32x4){bf2f((u16)(w.z & 0xffffu)), bf2f((u16)(w.z >> 16)), bf2f((u16)(w.w & 0xffffu)), bf2f((u16)(w.w >> 16))}; }
                    else { b0 = bs[m][bj][0]; b1 = bs[m][bj][1]; }
                    const pg8::f32x4 o0 = b0 + gv[bj][0] * acc[ai][bj][m][0], o1 = b1 + gv[bj][1] * acc[ai][bj][m][1];
                    if (IN_BF16) { *(pg8::f32x4*)((float*)out + off + bj * 128) = o0; *(pg8::f32x4*)((float*)out + off + bj * 128 + 4) = o1; }
                    else { v4u w; w.x = pk2(o0[0], o0[1]); w.y = pk2(o0[2], o0[3]); w.z = pk2(o1[0], o1[1]); w.w = pk2(o1[2], o1[3]); *(v4u*)((u16*)out + off + bj * 128) = w; } } }
        }
    }
};
struct EpiSwiglu {
    static constexpr bool PERM = true, AFTER_DRAIN = false;
    u16* ACT;
    __device__ __forceinline__ void operator()(const pg8::f32x4 (&acc)[2][2][4][2], const pg8::Unit& u, int wr, int wc, int fr, int fq) const {
        const int col0 = u.pn * 128 + wc * 32 + 8 * fq;
#pragma unroll
        for (int ai = 0; ai < 2; ++ai)
#pragma unroll
            for (int m = 0; m < 4; ++m) { const size_t row = (size_t)u.pm * 256 + ai * 128 + wr * 64 + m * 16 + fr;
                unsigned ow[4];
#pragma unroll
                for (int n = 0; n < 2; ++n) { const pg8::f32x4 av = acc[ai][0][m][n], bv = acc[ai][1][m][n];
                    float s[4];
#pragma unroll
                    for (int e = 0; e < 4; ++e) s[e] = av[e] * sigmoidf_(av[e]) * bv[e];
                    ow[2 * n] = pk2(s[0], s[1]); ow[2 * n + 1] = pk2(s[2], s[3]); }
                v4u w = {ow[0], ow[1], ow[2], ow[3]};
                *(v4u*)(ACT + row * DFF + col0) = w; }
    }
};
__device__ __forceinline__ void p_adaln(const Args& a, unsigned char* lds, const int mk_wid) {
    float* sl = (float*)lds;
    float* part = (float*)(lds + 17 * 1024 * 4);
    const int tid = MK_TID;
    const float* c = a.in[1]; const float* cctx = a.in[3]; const float* W = a.in[4]; const float* bada = a.in[5];
    float* MOD = (float*)(a.ws + WS_MOD);
    for (int i = tid; i < 17 * 1024; i += 512) { const float v = (i < 16 * 1024) ? c[i] : cctx[i - 16 * 1024]; sl[i] = v * __builtin_amdgcn_rcpf(1.f + __expf(-v)); }
    __syncthreads();
    for (int w = blockIdx.x; w < 192; w += gridDim.x) {
        const int col = w * 32 + (tid & 31), kg = tid >> 5;
        float acc[17];
#pragma unroll
        for (int v = 0; v < 17; ++v) acc[v] = 0.f;
        for (int kk = 0; kk < 64; kk += 16) { const int k = kg * 64 + kk; float wv[16];
#pragma unroll
            for (int j = 0; j < 16; ++j) wv[j] = __builtin_nontemporal_load(W + (size_t)(k + j) * 6144 + col);
#pragma unroll
            for (int v = 0; v < 17; ++v)
#pragma unroll
                for (int j4 = 0; j4 < 4; ++j4) { const f32x4 s4 = *(const f32x4*)(sl + v * 1024 + k + 4 * j4);
                    acc[v] += (s4.x * wv[4 * j4] + s4.y * wv[4 * j4 + 1]) + (s4.z * wv[4 * j4 + 2] + s4.w * wv[4 * j4 + 3]); } }
#pragma unroll
        for (int v = 0; v < 17; ++v) part[(kg * 17 + v) * 32 + (tid & 31)] = acc[v];
        __syncthreads();
        for (int i = tid; i < 17 * 32; i += 512) { const int v = i >> 5, cl = i & 31; float s = bada[w * 32 + cl];
            for (int g = 0; g < 16; ++g) s += part[(g * 17 + v) * 32 + cl];
            MOD[v * 6144 + w * 32 + cl] = s; }
        __syncthreads();
    }
}

__device__ __forceinline__ void transpose_item(const float* W, int ldw, int src_n0, int k0, u16* WT, int K, int dst_n0, bool zero, float* scr, int lane) {
    { const int kr = lane >> 3, n4 = (lane & 7) * 4; f32x4 v[8];
#pragma unroll
      for (int i = 0; i < 8; ++i) v[i] = zero ? (f32x4){0.f, 0.f, 0.f, 0.f} : __builtin_nontemporal_load((const f32x4*)(W + (size_t)(k0 + 8 * i + kr) * ldw + src_n0 + n4));
#pragma unroll
      for (int i = 0; i < 8; ++i) { float* d = scr + (8 * i + kr) * 33 + n4; d[0] = v[i].x; d[1] = v[i].y; d[2] = v[i].z; d[3] = v[i].w; } }
    asm volatile("s_waitcnt lgkmcnt(0)" ::: "memory");
    const int c = lane & 7;
#pragma unroll
    for (int j = 0; j < 4; ++j) { const int n = (lane >> 3) + 8 * j; const float* s = scr + (8 * c) * 33 + n;
        v4u o; o.x = pk2(s[0 * 33], s[1 * 33]); o.y = pk2(s[2 * 33], s[3 * 33]); o.z = pk2(s[4 * 33], s[5 * 33]); o.w = pk2(s[6 * 33], s[7 * 33]);
        *(v4u*)(WT + (size_t)(dst_n0 + n) * K + k0 + 8 * c) = o; }
    asm volatile("s_waitcnt lgkmcnt(0)" ::: "memory");
}
__device__ __forceinline__ void norm_mod_row2(const float* xrow0, const float* xrow1, const float* g, const float* shift0, const float* scale0, const float* shift1, const float* scale1, u16* orow0, u16* orow1, int lane) {
    const f32x4* xr0 = (const f32x4*)xrow0 + lane; const f32x4* xr1 = (const f32x4*)xrow1 + lane;
    f32x4 v0[4], v1[4]; float s0 = 0.f, s1 = 0.f;
#pragma unroll
    for (int j = 0; j < 4; ++j) { v0[j] = __builtin_nontemporal_load(xr0 + 64 * j); v1[j] = __builtin_nontemporal_load(xr1 + 64 * j); }
#pragma unroll
    for (int j = 0; j < 4; ++j) { s0 += (v0[j].x * v0[j].x + v0[j].y * v0[j].y) + (v0[j].z * v0[j].z + v0[j].w * v0[j].w); s1 += (v1[j].x * v1[j].x + v1[j].y * v1[j].y) + (v1[j].z * v1[j].z + v1[j].w * v1[j].w); }
#pragma unroll
    for (int o = 1; o < 64; o <<= 1) { s0 += __shfl_xor(s0, o); s1 += __shfl_xor(s1, o); }
    const float r0 = rsqrtf(s0 * (1.f / DM) + EPS), r1 = rsqrtf(s1 * (1.f / DM) + EPS);
    unsigned long long* o80 = (unsigned long long*)orow0 + lane; unsigned long long* o81 = (unsigned long long*)orow1 + lane;
#pragma unroll
    for (int j = 0; j < 4; ++j) { const f32x4 gg = ((const f32x4*)g)[lane + 64 * j];
        const f32x4 sh0 = ((const f32x4*)shift0)[lane + 64 * j], sc0 = ((const f32x4*)scale0)[lane + 64 * j], sh1 = ((const f32x4*)shift1)[lane + 64 * j], sc1 = ((const f32x4*)scale1)[lane + 64 * j];
        const f32x4 y0 = (v0[j] * r0 * gg) * (sc0 + 1.f) + sh0, y1 = (v1[j] * r1 * gg) * (sc1 + 1.f) + sh1;
        o80[64 * j] = (unsigned long long)pk2(y0.x, y0.y) | ((unsigned long long)pk2(y0.z, y0.w) << 32);
        o81[64 * j] = (unsigned long long)pk2(y1.x, y1.y) | ((unsigned long long)pk2(y1.z, y1.w) << 32); }
}
__device__ __forceinline__ void norm_mod_row2_bf(const u16* xrow0, const u16* xrow1, const float* g, const float* shift, const float* scale, u16* orow0, u16* orow1, int lane) {
    v4u w0[2], w1[2]; float x0[2][8], x1[2][8]; float s0 = 0.f, s1 = 0.f;
#pragma unroll
    for (int j = 0; j < 2; ++j) { w0[j] = *(const v4u*)(xrow0 + 512 * j + 8 * lane); w1[j] = *(const v4u*)(xrow1 + 512 * j + 8 * lane); }
#pragma unroll
    for (int j = 0; j < 2; ++j) { const unsigned a_[4] = {w0[j].x, w0[j].y, w0[j].z, w0[j].w}, b_[4] = {w1[j].x, w1[j].y, w1[j].z, w1[j].w};
#pragma unroll
        for (int e = 0; e < 4; ++e) { x0[j][2 * e] = bf2f((u16)(a_[e] & 0xffffu)); x0[j][2 * e + 1] = bf2f((u16)(a_[e] >> 16)); x1[j][2 * e] = bf2f((u16)(b_[e] & 0xffffu)); x1[j][2 * e + 1] = bf2f((u16)(b_[e] >> 16)); }
#pragma unroll
        for (int e = 0; e < 8; ++e) { s0 += x0[j][e] * x0[j][e]; s1 += x1[j][e] * x1[j][e]; } }
#pragma unroll
    for (int o = 1; o < 64; o <<= 1) { s0 += __shfl_xor(s0, o); s1 += __shfl_xor(s1, o); }
    const float r0 = rsqrtf(s0 * (1.f / DM) + EPS), r1 = rsqrtf(s1 * (1.f / DM) + EPS);
#pragma unroll
    for (int j = 0; j < 2; ++j) { const int c0 = 512 * j + 8 * lane; float y0[8], y1[8];
#pragma unroll
        for (int h4 = 0; h4 < 2; ++h4) { const f32x4 gg = *(const f32x4*)(g + c0 + 4 * h4), sh = *(const f32x4*)(shift + c0 + 4 * h4), sc = *(const f32x4*)(scale + c0 + 4 * h4);
#pragma unroll
            for (int e = 0; e < 4; ++e) { y0[4 * h4 + e] = (x0[j][4 * h4 + e] * r0 * gg[e]) * (sc[e] + 1.f) + sh[e]; y1[4 * h4 + e] = (x1[j][4 * h4 + e] * r1 * gg[e]) * (sc[e] + 1.f) + sh[e]; } }
        v4u o0 = {pk2(y0[0], y0[1]), pk2(y0[2], y0[3]), pk2(y0[4], y0[5]), pk2(y0[6], y0[7])}, o1 = {pk2(y1[0], y1[1]), pk2(y1[2], y1[3]), pk2(y1[4], y1[5]), pk2(y1[6], y1[7])};
        *(v4u*)(orow0 + c0) = o0; *(v4u*)(orow1 + c0) = o1; }
}
__device__ __forceinline__ void p_weights(const Args& a, unsigned char* lds, const int mk_wid, const int item_lo, const int item_hi, const int blk_lo, const bool do_rope) {
    const int tid = MK_TID, lane = tid & 63, wave = mk_wid;
    float* scr = (float*)(lds + wave * 16384);
    if ((int)blockIdx.x < blk_lo) return;
    const int gw = ((int)blockIdx.x - blk_lo) * 8 + wave, NGW = ((int)gridDim.x - blk_lo) * 8;
    unsigned char* ws = a.ws;
    constexpr int I_IN = 16 * 216, I_SQ = 16 * 32, I_FI = 16 * 176, I_FO = 44 * 32;
    constexpr int NITEMS = I_IN + 3 * I_SQ + I_FI + I_FO;
    for (int it = item_lo + gw; it < (item_hi < NITEMS ? item_hi : NITEMS); it += NGW) {
        int r = it;
        if (r < I_IN) { const int kb = r / 216, nb = r % 216, n0 = 32 * nb; const bool zero = n0 >= 6688;
            const int src = n0 < 4608 ? n0 : (n0 < 6656 ? n0 + 32 : n0 - 2048);
            transpose_item(a.in[7], 6688, zero ? 0 : src, 64 * kb, (u16*)(ws + WS_WIN), 1024, n0, zero, scr, lane); continue; }
        r -= I_IN;
        if (r < 3 * I_SQ) { const int which = r / I_SQ, q = r % I_SQ, kb = q / 32, nb = q % 32;
            const float* W = which == 0 ? a.in[15] : (which == 1 ? a.in[16] : a.in[17]);
            u16* WT = (u16*)(ws + (which == 0 ? WS_WAP : (which == 1 ? WS_WGP : WS_WOUT)));
            transpose_item(W, 1024, 32 * nb, 64 * kb, WT, 1024, 32 * nb, false, scr, lane); continue; }
        r -= 3 * I_SQ;
        if (r < I_FI) { const int kb = r / 176, nb = r % 176, n0 = 32 * nb, pn = n0 >> 8, j = n0 & 255;
            const int src = j < 128 ? pn * 128 + j : DFF + pn * 128 + (j - 128);
            transpose_item(a.in[19], 2 * DFF, src, 64 * kb, (u16*)(ws + WS_WFI), 1024, n0, false, scr, lane); continue; }
        r -= I_FI;
        { const int kb = r / 32, nb = r % 32; transpose_item(a.in[20], 1024, 32 * nb, 64 * kb, (u16*)(ws + WS_WFO), DFF, 32 * nb, false, scr, lane); }
    }
    float* rope = (float*)(ws + WS_ROPE);
    if (do_rope) for (int idx = blockIdx.x * 512 + tid; idx < T * 64; idx += gridDim.x * 512) { const int t = idx >> 6, i = idx & 63, j = i & 31;
        const float pos = (float)(i < 32 ? (t >> 6) : (t & 63));
        const float inv = 1.0f / powf(10000.f, (float)(2 * j) / 64.f);
        const float ang = pos * inv;
        rope[2 * idx] = cosf(ang); rope[2 * idx + 1] = sinf(ang); }
}

__device__ __forceinline__ void p_h1rows(const Args& a, const int mk_wid) {
    const int tid = MK_TID, lane = tid & 63, wave = mk_wid;
    const int gw = blockIdx.x * 8 + wave, NGW = gridDim.x * 8;
    unsigned char* ws = a.ws;
    const float* MOD = (const float*)(ws + WS_MOD);
    for (int m0 = gw * 2; m0 < MALL; m0 += NGW * 2) {
        const float* src[2]; const float* mod[2];
#pragma unroll
        for (int e = 0; e < 2; ++e) { const int m = m0 + e, b = m / TA, r = m % TA; const bool isc = r < TC;
            src[e] = isc ? a.in[2] + ((size_t)b * TC + r) * DM : a.in[0] + ((size_t)b * T + (r - TC)) * DM; mod[e] = MOD + (size_t)(isc ? 16 : b) * 6144; }
        norm_mod_row2(src[0], src[1], a.in[6], mod[0], mod[0] + 1024, mod[1], mod[1] + 1024, (u16*)(ws + WS_H1) + (size_t)m0 * DM, (u16*)(ws + WS_H1) + (size_t)(m0 + 1) * DM, lane); }
}

__device__ __forceinline__ void p_lowrank(const Args& a, unsigned char* lds, const int mk_wid) {
    const int tid = MK_TID, lane = tid & 63, r32 = lane & 31, hi = lane >> 5;
    constexpr int WP = 1032, APT = 136;
    u16* wl = (u16*)lds; u16* al = (u16*)(lds + 32 * WP * 2);
    const u16* H1 = (const u16*)(a.ws + WS_H1); const u16* WL = (const u16*)(a.ws + WS_WIN) + (size_t)6656 * 1024; u16* LR = (u16*)(a.ws + WS_LR);
    const bool full = (int)gridDim.x == 256;
    const int rb0 = full ? (int)blockIdx.x - 128 : (int)blockIdx.x, rbs = full ? 128 : (int)gridDim.x;
    if (rb0 < 0 || rb0 >= MALL / 256) return;
#pragma unroll
    for (int p = 0; p < 8; ++p) { const int piece = p * 512 + tid, row = piece >> 7, c8 = piece & 127; *(v4u*)(wl + row * WP + c8 * 8) = *(const v4u*)(WL + (size_t)row * 1024 + c8 * 8); }
    for (int rb = rb0; rb < MALL / 256; rb += rbs) {
        const u16* Ab = H1 + (size_t)rb * 256 * 1024;
        v4u st[8];
#pragma unroll
        for (int p = 0; p < 8; ++p) { const int piece = p * 512 + tid, row = piece >> 4, c8 = piece & 15; st[p] = *(const v4u*)(Ab + (size_t)row * 1024 + c8 * 8); }
        att::f32x16 acc = att::f32x16{};
        for (int kc = 0; kc < 8; ++kc) {
            __syncthreads();
#pragma unroll
            for (int p = 0; p < 8; ++p) { const int piece = p * 512 + tid, row = piece >> 4, c8 = piece & 15; *(v4u*)(al + row * APT + c8 * 8) = st[p]; }
            if (kc + 1 < 8) {
#pragma unroll
                for (int p = 0; p < 8; ++p) { const int piece = p * 512 + tid, row = piece >> 4, c8 = piece & 15; st[p] = *(const v4u*)(Ab + (size_t)row * 1024 + (kc + 1) * 128 + c8 * 8); } }
            __syncthreads();
            const u16* ap = al + (mk_wid * 32 + r32) * APT + 8 * hi; const u16* bp = wl + r32 * WP + kc * 128 + 8 * hi;
#pragma unroll
            for (int kb = 0; kb < 8; ++kb) acc = __builtin_amdgcn_mfma_f32_32x32x16_bf16(*(const att::bf16x8*)(ap + kb * 16), *(const att::bf16x8*)(bp + kb * 16), acc, 0, 0, 0);
        }
#pragma unroll
        for (int r = 0; r < 16; ++r) LR[(size_t)(rb * 256 + mk_wid * 32 + att::crow(r, hi)) * 32 + r32] = f2bf(acc[r]);
    }
    __syncthreads();
}
__device__ __forceinline__ void p_kprep(const Args& a, const int mk_wid) {
    const int tid = MK_TID, lane = tid & 63, wave = mk_wid;
    const int gw = blockIdx.x * 8 + wave, NGW = gridDim.x * 8;
    u16* Kb = (u16*)(a.ws + WS_K); const float* rope = (const float*)(a.ws + WS_ROPE); const float* kg = a.in[9];
    const int head = lane >> 5, l = lane & 31;
    const f32x4 g = *(const f32x4*)(kg + 4 * l);
    for (int m0 = gw * 6; m0 < MALL; m0 += NGW * 6) {
        v2u w[6]; f32x4 cs[6]; float f[6][4], s[6];
#pragma unroll
        for (int e = 0; e < 6; ++e) { const int m = m0 + e, r = m % TA; w[e] = *(const v2u*)(Kb + (size_t)m * 256 + head * 128 + 4 * l);
            cs[e] = (r >= TC) ? *(const f32x4*)(rope + ((size_t)(r - TC) * 64 + 2 * l) * 2) : (f32x4){1.f, 0.f, 1.f, 0.f}; }
#pragma unroll
        for (int e = 0; e < 6; ++e) { f[e][0] = bf2f((u16)(w[e].x & 0xffffu)); f[e][1] = bf2f((u16)(w[e].x >> 16)); f[e][2] = bf2f((u16)(w[e].y & 0xffffu)); f[e][3] = bf2f((u16)(w[e].y >> 16));
            s[e] = (f[e][0] * f[e][0] + f[e][1] * f[e][1]) + (f[e][2] * f[e][2] + f[e][3] * f[e][3]); }
#pragma unroll
        for (int o = 1; o < 32; o <<= 1) {
#pragma unroll
            for (int e = 0; e < 6; ++e) s[e] += __shfl_xor(s[e], o); }
#pragma unroll
        for (int e = 0; e < 6; ++e) { const float rinv = rsqrtf(s[e] * (1.f / 128.f) + EPS);
            const float f0 = f[e][0] * rinv * g.x, f1 = f[e][1] * rinv * g.y, f2 = f[e][2] * rinv * g.z, f3 = f[e][3] * rinv * g.w;
            v2u o; o.x = pk2(f0 * cs[e].x - f1 * cs[e].y, f0 * cs[e].y + f1 * cs[e].x); o.y = pk2(f2 * cs[e].z - f3 * cs[e].w, f2 * cs[e].w + f3 * cs[e].z);
            *(v2u*)(Kb + (size_t)(m0 + e) * 256 + head * 128 + 4 * l) = o; } }
}
__device__ __forceinline__ void p_glapost(const Args& a, const int mk_wid) {
    const int tid = MK_TID, lane = tid & 63, wave = mk_wid;
    const int gw = blockIdx.x * 8 + wave, NGW = gridDim.x * 8;
    const u16* OF = (const u16*)(a.ws + WS_OF); const u16* OB = (const u16*)(a.ws + WS_OB); u16* GG = (u16*)(a.ws + WS_GG);
    const f32x4 g = *(const f32x4*)(a.in[14] + 4 * lane);
    for (int it0 = gw * 4; it0 < MLAT * 4; it0 += NGW * 4) {
        v2u wf[4], wb[4], wg[4]; float o_[4][4], ss[4];
#pragma unroll
        for (int e = 0; e < 4; ++e) { const size_t off = (size_t)(it0 + e) * 256 + 4 * lane; wf[e] = __builtin_nontemporal_load((const v2u*)(OF + off)); wb[e] = __builtin_nontemporal_load((const v2u*)(OB + off)); wg[e] = __builtin_nontemporal_load((const v2u*)(GG + off)); }
#pragma unroll
        for (int e = 0; e < 4; ++e) {
            o_[e][0] = bf2f((u16)(wf[e].x & 0xffffu)) + bf2f((u16)(wb[e].x & 0xffffu)); o_[e][1] = bf2f((u16)(wf[e].x >> 16)) + bf2f((u16)(wb[e].x >> 16));
            o_[e][2] = bf2f((u16)(wf[e].y & 0xffffu)) + bf2f((u16)(wb[e].y & 0xffffu)); o_[e][3] = bf2f((u16)(wf[e].y >> 16)) + bf2f((u16)(wb[e].y >> 16));
            ss[e] = (o_[e][0] * o_[e][0] + o_[e][1] * o_[e][1]) + (o_[e][2] * o_[e][2] + o_[e][3] * o_[e][3]); }
#pragma unroll
        for (int o = 1; o < 64; o <<= 1) {
#pragma unroll
            for (int e = 0; e < 4; ++e) ss[e] += __shfl_xor(ss[e], o); }
#pragma unroll
        for (int e = 0; e < 4; ++e) { const float rinv = rsqrtf(ss[e] * (1.f / 256.f) + EPS);
            const float g0 = bf2f((u16)(wg[e].x & 0xffffu)), g1 = bf2f((u16)(wg[e].x >> 16)), g2 = bf2f((u16)(wg[e].y & 0xffffu)), g3 = bf2f((u16)(wg[e].y >> 16));
            v2u o; o.x = pk2(o_[e][0] * rinv * g.x * (g0 * sigmoidf_(g0)), o_[e][1] * rinv * g.y * (g1 * sigmoidf_(g1)));
            o.y = pk2(o_[e][2] * rinv * g.z * (g2 * sigmoidf_(g2)), o_[e][3] * rinv * g.w * (g3 * sigmoidf_(g3)));
            *(v2u*)(GG + (size_t)(it0 + e) * 256 + 4 * lane) = o; } }
}
__device__ __forceinline__ void p_h2(const Args& a, const int mk_wid) {
    const int tid = MK_TID, lane = tid & 63, wave = mk_wid;
    const int gw = blockIdx.x * 8 + wave, NGW = gridDim.x * 8;
    const float* MOD = (const float*)(a.ws + WS_MOD);
    const u16* X1 = (const u16*)(a.ws + WS_X1);
    for (int m0 = gw * 2; m0 < MLAT; m0 += NGW * 2) { const float* mod = MOD + (size_t)(m0 / T) * 6144;
        norm_mod_row2_bf(X1 + (size_t)m0 * DM, X1 + (size_t)(m0 + 1) * DM, a.in[18], mod + 3 * 1024, mod + 4 * 1024,
                         (u16*)(a.ws + WS_H2) + (size_t)m0 * DM, (u16*)(a.ws + WS_H2) + (size_t)(m0 + 1) * DM, lane); }
}
namespace gla {
using att::bf16x8; using att::s16x4; using att::f32x16; using att::crow; using att::v_st; using att::v_rd_base; using att::v_rd_off; using att::tr_read;
constexpr int QP = 136, AP = 72;
constexpr int L_QE = 0, L_KE = 17408, L_KD = 34816, L_V = 51200, L_AM = 83968, L_LAS = 93184, L_LR = 125952, L_GS = 128000, L_DL = 130048, L_END = 130560;
static_assert(L_END <= LDS_BYTES - 64, "GLA LDS map");
#define GLA_PK(L, H) (bf16x8){L[0], L[1], L[2], L[3], H[0], H[1], H[2], H[3]}
#define GLA_SBAR() __builtin_amdgcn_sched_barrier(0)
#define OPAQUE_TID(name) int name = MK_TID; asm volatile("" : "+v"(name))

__device__ __forceinline__ void scan_unit(const int unit, const Args& a, unsigned char* lds, const int mk_wid) {
    const int wid = mk_wid;
    const int dir = unit & 1, h = (unit >> 1) & 3, b = unit >> 3;
    const int vt = wid;
    const u16* GQ = (const u16*)(a.ws + WS_GQ); const u16* GK = (const u16*)(a.ws + WS_GK); const u16* GV = (const u16*)(a.ws + WS_GV); const u16* LR = (const u16*)(a.ws + WS_LR);
    u16* OUT = (u16*)(a.ws + (dir ? WS_OB : WS_OF));
    bf16x8 upf; float biasc;
    { const int l_ = MK_TID & 63, r32 = l_ & 31, hi = l_ >> 5; const float* up = a.in[dir ? 12 : 10] + (size_t)(8 * hi) * 512 + h * 128 + (wid & 3) * 32 + r32;
      v4u w; w.x = pk2(up[0], up[512]); w.y = pk2(up[2 * 512], up[3 * 512]); w.z = pk2(up[4 * 512], up[5 * 512]); w.w = pk2(up[6 * 512], up[7 * 512]);
      upf = __builtin_bit_cast(bf16x8, w); biasc = a.in[dir ? 13 : 11][h * 128 + (wid & 3) * 32 + r32]; }
    u16* qe = (u16*)(lds + L_QE); u16* ke = (u16*)(lds + L_KE); u16* am = (u16*)(lds + L_AM);
    float* las = (float*)(lds + L_LAS); float* gs = (float*)(lds + L_GS); float* dl = (float*)(lds + L_DL);
    const int ldsb = (int)(uintptr_t)lds;
    u16* ot = (u16*)(lds + L_LAS);
    int pend_cc = -1;
#define GLA_FLUSH() do { if (pend_cc >= 0) { OPAQUE_TID(tf_); const size_t rl0_ = (size_t)b * T + (size_t)(pend_cc - 4) * 64; \
      _Pragma("unroll") for (int p = 0; p < 4; ++p) { const int idx_ = p * 512 + tf_, i_ = idx_ >> 5, c16_ = idx_ & 31; \
          *(v4u*)(OUT + (rl0_ + (dir ? 63 - i_ : i_)) * 1024 + h * 256 + c16_ * 8) = *(const v4u*)(ot + i_ * 256 + c16_ * 8); } } } while (0)
    f32x16 S[4]; S[0] = f32x16{}; S[1] = f32x16{}; S[2] = f32x16{}; S[3] = f32x16{};
    bf16x8 qraw[2], kraw[2], vraw[4]; bf16x8 lraw = bf16x8{};
#define GLA_CHUNK(s) (dir ? ((s) < 4 ? 3 - (s) : 39 - (s)) : (s))
#define GLA_LOAD(s) do { OPAQUE_TID(t_); const int cc_ = GLA_CHUNK(s); const size_t rowb_ = (size_t)b * TA + (size_t)cc_ * 64; \
      _Pragma("unroll") for (int p = 0; p < 2; ++p) { const int i_ = p * 32 + (t_ >> 4); const size_t row_ = rowb_ + (dir ? 63 - i_ : i_); \
          kraw[p] = *(const bf16x8*)(GK + row_ * 512 + h * 128 + (t_ & 15) * 8); \
          qraw[p] = (cc_ >= 4) ? *(const bf16x8*)(GQ + row_ * 512 + h * 128 + (t_ & 15) * 8) : bf16x8{}; } \
      _Pragma("unroll") for (int p = 0; p < 4; ++p) { const int i_ = p * 16 + (t_ >> 5); const size_t row_ = rowb_ + (dir ? 63 - i_ : i_); \
          vraw[p] = *(const bf16x8*)(GV + row_ * 1024 + h * 256 + (t_ & 31) * 8); } \
      if (t_ < 128) { const int i_ = t_ >> 1; const size_t row_ = rowb_ + (dir ? 63 - i_ : i_); lraw = *(const bf16x8*)(LR + row_ * 32 + dir * 16 + (t_ & 1) * 8); } } while (0)
    GLA_LOAD(0);
    for (int step = 0; step < 36; ++step) {
        const int cc = GLA_CHUNK(step); const bool lat = cc >= 4;
        GLA_FLUSH();
        { OPAQUE_TID(t_);
#pragma unroll
          for (int p = 0; p < 2; ++p) { const int i_ = p * 32 + (t_ >> 4), c_ = (t_ & 15) * 8; *(bf16x8*)(qe + i_ * QP + c_) = qraw[p]; *(bf16x8*)(ke + i_ * QP + c_) = kraw[p]; }
#pragma unroll
          for (int p = 0; p < 4; ++p) { const int i_ = p * 16 + (t_ >> 5), c8 = t_ & 31; *(bf16x8*)(lds + L_V + (c8 >> 4) * 16384 + v_st(i_, (c8 & 15) * 8)) = vraw[p]; }
          if (t_ < 128) *(bf16x8*)(lds + L_LR + (t_ >> 1) * 32 + (t_ & 1) * 16) = lraw; }
        __syncthreads();
        { OPAQUE_TID(t_); const int lane = t_ & 63, r32 = lane & 31, hi = lane >> 5; const int tt = wid >> 2, ct = wid & 3;
          const bf16x8 af = *(const bf16x8*)(lds + L_LR + (tt * 32 + r32) * 32 + hi * 16);
          const f32x16 z = __builtin_amdgcn_mfma_f32_32x32x16_bf16(af, upf, f32x16{}, 0, 0, 0);
          float* lw = las + (tt * 32 + 4 * hi) * 128 + ct * 32 + r32;
#pragma unroll
          for (int r = 0; r < 16; ++r) { const float zz = z[r] + biasc;
              lw[crow(r, 0) * 128] = (fminf(zz, 0.f) - __builtin_amdgcn_logf(1.f + __builtin_amdgcn_exp2f(-1.4426950408889634f * fabsf(zz))) * 0.6931471805599453f) * (1.f / 16.f); } }
        __syncthreads();
        { OPAQUE_TID(t_); const int c = t_ & 127, g = t_ >> 7;
          float bl[16]; float run = 0.f;
          { const float* lp = las + (g * 16) * 128 + c;
#pragma unroll
            for (int ii = 0; ii < 16; ++ii) { run += lp[ii * 128]; bl[ii] = run; } }
          gs[g * 128 + c] = run;
          __syncthreads();
          const float g0 = gs[c], g1 = gs[128 + c], g2 = gs[256 + c], g3 = gs[384 + c];
          const float off = (g > 0 ? g0 : 0.f) + (g > 1 ? g1 : 0.f) + (g > 2 ? g2 : 0.f);
          const float btot = (g0 + g1) + (g2 + g3);
          const float dlc = __builtin_amdgcn_exp2f(btot * 1.4426950408889634f);
          if (g == 0) dl[c] = dlc;
          u16* qcol = qe + (g * 16) * QP + c; u16* kcol = ke + (g * 16) * QP + c; unsigned char* kdb = lds + L_KD + v_st(g * 16, c);
#pragma unroll
          for (int ii = 0; ii < 16; ++ii) { const float bb = bl[ii] + off;
              const float qf = bf2f(qcol[ii * QP]), kf = bf2f(kcol[ii * QP]);
              const float e = __builtin_amdgcn_exp2f(bb * 1.4426950408889634f), ker = kf * __builtin_amdgcn_rcpf(e);
              qcol[ii * QP] = f2bf(qf * (0.088388347648318440f * e));
              kcol[ii * QP] = f2bf(ker);
              *(u16*)(kdb + v_st(ii, 0)) = f2bf(ker * dlc); } }
        if (step + 1 < 36) GLA_LOAD(step + 1);
        __syncthreads();
        if (lat) {
            if (wid < 4) { OPAQUE_TID(t_); const int r32 = t_ & 31, hi = (t_ >> 5) & 1;
                const int jt = wid >> 1, it = wid & 1; f32x16 ct = f32x16{};
                const u16* kp = ke + (jt * 32 + r32) * QP + hi * 8; const u16* qp = qe + (it * 32 + r32) * QP + hi * 8;
#pragma unroll
                for (int kb = 0; kb < 8; ++kb) ct = __builtin_amdgcn_mfma_f32_32x32x16_bf16(*(const bf16x8*)(kp + kb * 16), *(const bf16x8*)(qp + kb * 16), ct, 0, 0, 0);
                const int i = it * 32 + r32;
#pragma unroll
                for (int rg = 0; rg < 4; ++rg) { const int j0 = jt * 32 + 8 * rg + 4 * hi;
                    const float x0 = (j0 + 0 <= i) ? ct[4 * rg + 0] : 0.f, x1 = (j0 + 1 <= i) ? ct[4 * rg + 1] : 0.f, x2 = (j0 + 2 <= i) ? ct[4 * rg + 2] : 0.f, x3 = (j0 + 3 <= i) ? ct[4 * rg + 3] : 0.f;
                    v2u w; w.x = pk2(x0, x1); w.y = pk2(x2, x3); *(v2u*)(am + i * AP + j0) = w; } }
            __syncthreads();
        }
        { OPAQUE_TID(t_); const int lane = t_ & 63, r32 = lane & 31, hi = lane >> 5;
          const int vb = ldsb + L_V + (vt >> 2) * 16384 + v_rd_base(lane) + (vt & 3) * 512;
          s16x4 vl0, vh0, vl1, vh1, vl2, vh2, vl3, vh3;
#define GLA_LOADV() do { vl0 = tr_read<v_rd_off(0, 0, 0)>(vb); vh0 = tr_read<v_rd_off(0, 0, 1)>(vb); vl1 = tr_read<v_rd_off(0, 1, 0)>(vb); vh1 = tr_read<v_rd_off(0, 1, 1)>(vb); \
              vl2 = tr_read<v_rd_off(0, 2, 0)>(vb); vh2 = tr_read<v_rd_off(0, 2, 1)>(vb); vl3 = tr_read<v_rd_off(0, 3, 0)>(vb); vh3 = tr_read<v_rd_off(0, 3, 1)>(vb); } while (0)
          if (!lat) GLA_LOADV();
          if (lat) {
              f32x16 o0 = f32x16{}, o1 = f32x16{};
#pragma unroll
              for (int ct = 0; ct < 4; ++ct)
#pragma unroll
                for (int kb = 0; kb < 2; ++kb) { const int cb = ct * 32 + kb * 16;
                    v4u sw; sw.x = pk2(S[ct][8 * kb + 0], S[ct][8 * kb + 1]); sw.y = pk2(S[ct][8 * kb + 2], S[ct][8 * kb + 3]); sw.z = pk2(S[ct][8 * kb + 4], S[ct][8 * kb + 5]); sw.w = pk2(S[ct][8 * kb + 6], S[ct][8 * kb + 7]);
                    const bf16x8 sb = __builtin_bit_cast(bf16x8, sw);
                    { const u16* p0 = qe + r32 * QP + cb + 4 * hi; const v2u lo = *(const v2u*)p0, hh = *(const v2u*)(p0 + 8); v4u aw = {lo.x, lo.y, hh.x, hh.y};
                      o0 = __builtin_amdgcn_mfma_f32_32x32x16_bf16(__builtin_bit_cast(bf16x8, aw), sb, o0, 0, 0, 0); }
                    { const u16* p1 = qe + (32 + r32) * QP + cb + 4 * hi; const v2u lo = *(const v2u*)p1, hh = *(const v2u*)(p1 + 8); v4u aw = {lo.x, lo.y, hh.x, hh.y};
                      o1 = __builtin_amdgcn_mfma_f32_32x32x16_bf16(__builtin_bit_cast(bf16x8, aw), sb, o1, 0, 0, 0); } }
              GLA_LOADV();
              asm volatile("s_waitcnt lgkmcnt(0)" ::: "memory"); GLA_SBAR();
              { const u16* a0 = am + r32 * AP + hi * 8; const u16* a1 = am + (32 + r32) * AP + hi * 8;
                o0 = __builtin_amdgcn_mfma_f32_32x32x16_bf16(*(const bf16x8*)(a0), GLA_PK(vl0, vh0), o0, 0, 0, 0);
                o0 = __builtin_amdgcn_mfma_f32_32x32x16_bf16(*(const bf16x8*)(a0 + 16), GLA_PK(vl1, vh1), o0, 0, 0, 0);
                o1 = __builtin_amdgcn_mfma_f32_32x32x16_bf16(*(const bf16x8*)(a1), GLA_PK(vl0, vh0), o1, 0, 0, 0);
                o1 = __builtin_amdgcn_mfma_f32_32x32x16_bf16(*(const bf16x8*)(a1 + 16), GLA_PK(vl1, vh1), o1, 0, 0, 0);
                o1 = __builtin_amdgcn_mfma_f32_32x32x16_bf16(*(const bf16x8*)(a1 + 32), GLA_PK(vl2, vh2), o1, 0, 0, 0);
                o1 = __builtin_amdgcn_mfma_f32_32x32x16_bf16(*(const bf16x8*)(a1 + 48), GLA_PK(vl3, vh3), o1, 0, 0, 0); }
              { u16* ow = ot + (4 * hi) * 256 + vt * 32 + r32;
#pragma unroll
                for (int r = 0; r < 16; ++r) { const int i0 = crow(r, 0); ow[i0 * 256] = f2bf(o0[r]); ow[(i0 + 32) * 256] = f2bf(o1[r]); } }
          }
#pragma unroll
          for (int ct = 0; ct < 4; ++ct) { const int kb_ = ldsb + L_KD + v_rd_base(lane) + ct * 512;
              const s16x4 al0 = tr_read<v_rd_off(0, 0, 0)>(kb_), ah0 = tr_read<v_rd_off(0, 0, 1)>(kb_), al1 = tr_read<v_rd_off(0, 1, 0)>(kb_), ah1 = tr_read<v_rd_off(0, 1, 1)>(kb_);
              const s16x4 al2 = tr_read<v_rd_off(0, 2, 0)>(kb_), ah2 = tr_read<v_rd_off(0, 2, 1)>(kb_), al3 = tr_read<v_rd_off(0, 3, 0)>(kb_), ah3 = tr_read<v_rd_off(0, 3, 1)>(kb_);
              const float* dp = dl + ct * 32 + 4 * hi;
#pragma unroll
              for (int rg = 0; rg < 4; ++rg) { const f32x4 d4 = *(const f32x4*)(dp + 8 * rg);
                  S[ct][4 * rg + 0] *= d4.x; S[ct][4 * rg + 1] *= d4.y; S[ct][4 * rg + 2] *= d4.z; S[ct][4 * rg + 3] *= d4.w; }
              asm volatile("s_waitcnt lgkmcnt(0)" ::: "memory"); GLA_SBAR();
              S[ct] = __builtin_amdgcn_mfma_f32_32x32x16_bf16(GLA_PK(al0, ah0), GLA_PK(vl0, vh0), S[ct], 0, 0, 0);
              S[ct] = __builtin_amdgcn_mfma_f32_32x32x16_bf16(GLA_PK(al1, ah1), GLA_PK(vl1, vh1), S[ct], 0, 0, 0);
              S[ct] = __builtin_amdgcn_mfma_f32_32x32x16_bf16(GLA_PK(al2, ah2), GLA_PK(vl2, vh2), S[ct], 0, 0, 0);
              S[ct] = __builtin_amdgcn_mfma_f32_32x32x16_bf16(GLA_PK(al3, ah3), GLA_PK(vl3, vh3), S[ct], 0, 0, 0); } }
        __syncthreads();
        pend_cc = lat ? cc : -1;
    }
    GLA_FLUSH();
    __syncthreads();
#undef GLA_FLUSH
#undef GLA_LOADV
#undef GLA_CHUNK
#undef GLA_LOAD
}
}
#define XB_TMO      128
#define XB_XCNT(j)  (256  + 64 * (j))
#define XB_XSUB(j)  (1280 + 64 * (j))
#define XB_XGEN(j)  (2304 + 64 * (j))
#define XB_TOP      3328
#define XB_TOPGEN   3392
#define XCD_BAR_WORDS 3456
#define XB_SPIN_CAP (1u << 18)

__device__ __forceinline__ unsigned xb_ld(unsigned* p)              { return __hip_atomic_load(p, __ATOMIC_RELAXED, __HIP_MEMORY_SCOPE_AGENT); }
__device__ __forceinline__ unsigned xb_add(unsigned* p, unsigned v) { return __hip_atomic_fetch_add(p, v, __ATOMIC_RELAXED, __HIP_MEMORY_SCOPE_AGENT); }
__device__ __forceinline__ unsigned xb_xcc_id() { return (unsigned)__builtin_amdgcn_s_getreg((3 << 11) | 20) & 0xFu; }
#define XB_SPIN(cond, bar) do { unsigned _sp = 0; while (cond) { __builtin_amdgcn_s_sleep(1); \
    if ((++_sp & 255u) == 0u) { if (xb_ld(&(bar)[XB_TMO])) break; if (_sp > XB_SPIN_CAP) { atomicAdd(&(bar)[XB_TMO], 1u); break; } } } } while (0)

struct XcdBarrier {
    unsigned* bar; unsigned x;
    volatile LAS unsigned* st;
};

__device__ __forceinline__ XcdBarrier xcd_barrier_post(unsigned* bar, volatile LAS unsigned* st, const bool tid0) {
    XcdBarrier b; b.bar = bar; b.x = xb_xcc_id(); b.st = st;
    if (tid0) (void)xb_add(&bar[XB_XCNT(b.x)], 1u);
    return b;
}
__device__ __forceinline__ void xcd_barrier_complete(unsigned* bar, unsigned x, unsigned& nloc, unsigned& nx) {
    const unsigned G = gridDim.x * gridDim.y * gridDim.z;
    unsigned sum, cnt, mine, sp = 0u;
    for (;;) {
        sum = 0u; cnt = 0u; mine = 0u;
#pragma unroll
        for (unsigned j = 0; j < 16; ++j) { const unsigned c = xb_ld(&bar[XB_XCNT(j)]); sum += c; cnt += (c > 0u) ? 1u : 0u; mine = (j == x) ? c : mine; }
        if (sum == G) break;
        __builtin_amdgcn_s_sleep(1);
        if ((++sp & 255u) == 0u) { if (xb_ld(&bar[XB_TMO])) break; if (sp > XB_SPIN_CAP) { atomicAdd(&bar[XB_TMO], 1u); break; } }
    }
    nloc = mine > 0u ? mine : 1u; nx = cnt > 0u ? cnt : 1u;
}

__device__ __forceinline__ void xcd_barrier(const XcdBarrier& b, const bool tid0) {
    asm volatile("s_waitcnt vmcnt(0)" ::: "memory");
    __syncthreads();
    if (tid0) {
        unsigned* bar = b.bar; const unsigned bx_ = (unsigned)__builtin_amdgcn_readfirstlane((int)xb_xcc_id());
        __builtin_amdgcn_s_waitcnt(0);
        unsigned nloc = b.st[0], nx = b.st[1];
        if (nloc == 0u) { xcd_barrier_complete(bar, bx_, nloc, nx); b.st[0] = nloc; b.st[1] = nx; }
        const unsigned old = xb_add(&bar[XB_XSUB(bx_)], 1u);
        const unsigned gen = old / nloc;
        if (old + 1u == (gen + 1u) * nloc) {
            __builtin_amdgcn_fence(__ATOMIC_RELEASE, "agent");
            asm volatile("s_waitcnt vmcnt(0)" ::: "memory");
            const unsigned og = xb_add(&bar[XB_TOP], 1u);
            const unsigned tg = og / nx;
            if (og + 1u == (tg + 1u) * nx) xb_add(&bar[XB_TOPGEN], 1u);
            else XB_SPIN(xb_ld(&bar[XB_TOPGEN]) == tg, bar);
            __builtin_amdgcn_fence(__ATOMIC_ACQUIRE, "agent");
            xb_add(&bar[XB_XGEN(bx_)], 1u);
            asm volatile("s_waitcnt vmcnt(0)" ::: "memory");
        } else {
            XB_SPIN(xb_ld(&bar[XB_XGEN(bx_)]) == gen, bar);
            __builtin_amdgcn_fence(__ATOMIC_ACQUIRE, "agent");
            asm volatile("s_waitcnt vmcnt(0)" ::: "memory");
        }
    }
    __syncthreads();
}
#ifndef MK_PER_PHASE
#define MK_PER_PHASE 0
#endif
__global__ void __launch_bounds__(512) mk_fwd(Args a) {
    extern __shared__ __attribute__((aligned(16))) unsigned char lds[];
    cg::grid_group grid = cg::this_grid();
    unsigned char* ws = a.ws;
    LAS unsigned char* lds3 = (LAS unsigned char*)lds;
    const int G = gridDim.x, bx = blockIdx.x;
    const int mk_wid = __builtin_amdgcn_readfirstlane(threadIdx.x >> 6);
#ifndef PHMASK
#define PHMASK 0x7ff
#endif
#define IN(k) (((PHMASK >> (k)) & 1) && a.ph_lo <= (k) && (k) < a.ph_hi)
    unsigned* bar_words = (unsigned*)(ws + 4096);
    volatile LAS unsigned* bar_st = (volatile LAS unsigned*)(lds3 + (LDS_BYTES - 64));
    { const int t0_ = MK_TID; if (t0_ < 2) bar_st[t0_] = 0u; }
    if (IN(0) && bx == 0) { for (int i = MK_TID; i < XCD_BAR_WORDS; i += 512) __hip_atomic_store(bar_words + i, 0u, __ATOMIC_RELAXED, __HIP_MEMORY_SCOPE_AGENT); }
#define SEAM(k) do { if (IN(k) && IN((k) + 1)) { if ((k) == 0) { grid.sync(); (void)xcd_barrier_post(bar_words, bar_st, MK_TID == 0); } else { unsigned long long bp_ = (unsigned long long)(a.ws + 4096); asm volatile("" : "+s"(bp_)); XcdBarrier xb_; xb_.bar = (unsigned*)bp_; xb_.x = 0; xb_.st = bar_st; xcd_barrier(xb_, MK_TID == 0); } } } while (0)
    if (IN(0)) p_adaln(a, lds, mk_wid);
    SEAM(0);
    if (IN(1)) { p_weights(a, lds, mk_wid, 0, (G == 256) ? WI_IN : WI_ALL, 0, true); p_h1rows(a, mk_wid); }
    SEAM(1);
    if (IN(2)) {
        pg8::Gemm g{(const pg8::bf16_t*)(ws + WS_H1), (const pg8::bf16_t*)(ws + WS_WIN), MALL, NIN, DM}; InProjOrder S; S.init(G, bx);
        EpiInProj E{ws, (u16*)a.out};
        p_lowrank(a, lds, mk_wid);
        __syncthreads();
        pg8::gemm_phase<EpiInProj, InProjOrder, true, true>(lds3, g, S, E, mk_wid);
        if (G == 256) p_weights(a, lds, mk_wid, WI_IN, WI_PROJ, 128, false);
    }
    SEAM(2);
    if (IN(3)) p_kprep(a, mk_wid);
    SEAM(3);
    if (IN(4)) {
        const att::bf16* Qp = (const att::bf16*)(ws + WS_Q); const att::bf16* Kp = (const att::bf16*)(ws + WS_K); const att::bf16* Vp = (const att::bf16*)(ws + WS_V);
        const float* rope = (const float*)(ws + WS_ROPE);
        const bool full = (G == 256);
        if (full) { if (bx < 128) gla::scan_unit(bx, a, lds, mk_wid); }
        else { for (int u = bx; u < 128; u += G) gla::scan_unit(u, a, lds, mk_wid); }
        __syncthreads();
        const int xj = bx >> 3, xx = bx & 7;
        const int nun = full ? (xj < 16 ? 3 : 5) : 0;
        for (int i = 0; ; ++i) {
            int bk, w;
            if (full) { if (i >= nun) break; const int idx = (xj < 16) ? 80 + i * 16 + xj : i * 16 + (xj - 16); bk = (idx >> 5) * 8 + xx; w = idx & 31; }
            else { const int u = i * G + bx; if (u >= 1024) break; bk = u >> 5; w = u & 31; }
            const int b = bk >> 1, kvh = bk & 1, hq = kvh * 4 + (w >> 3), qb = w & 7;
            const size_t qoff = ((size_t)b * T + (size_t)qb * 256) * 1024 + hq * 128;
            const size_t koff = (size_t)b * TA * 256 + kvh * 128;
            att::attn_unit(Qp + qoff, Kp + koff, Vp + koff, (att::bf16*)(ws + WS_Q) + qoff, TA, (char*)lds, rope + (size_t)qb * 256 * 128, a.in[8], mk_wid);
        }
        if (full) p_weights(a, lds, mk_wid, WI_PROJ, WI_ALL, 128, false);
    }
    SEAM(4);
    if (IN(5)) {
        pg8::StaticOrder S; S.init(MLAT, DM, G, bx, 2);
        { pg8::Gemm g{(const pg8::bf16_t*)(ws + WS_Q), (const pg8::bf16_t*)(ws + WS_WAP), MLAT, DM, DM};
          EpiMerge<0> E{(const u16*)a.out, (u16*)(ws + WS_T1), (u16*)(ws + WS_MRG)};
          pg8::gemm_phase<EpiMerge<0>, pg8::StaticOrder, true, true>(lds3, g, S, E, mk_wid); }
        p_glapost(a, mk_wid);
    }
    SEAM(5);
    if (IN(6)) {
        pg8::StaticOrder S; S.init(MLAT, DM, G, bx, 2);
        pg8::Gemm g{(const pg8::bf16_t*)(ws + WS_GG), (const pg8::bf16_t*)(ws + WS_WGP), MLAT, DM, DM};
        EpiMerge<1> E{(const u16*)a.out, (u16*)(ws + WS_T1), (u16*)(ws + WS_MRG)};
        pg8::gemm_phase<EpiMerge<1>, pg8::StaticOrder, true, true>(lds3, g, S, E, mk_wid);
    }
    SEAM(6);
    if (IN(7)) {
        pg8::Gemm g{(const pg8::bf16_t*)(ws + WS_MRG), (const pg8::bf16_t*)(ws + WS_WOUT), MLAT, DM, DM}; pg8::StaticOrder S; S.init(MLAT, DM, G, bx, 2);
        EpiGateResB<false> E{(const void*)a.in[0], (void*)(ws + WS_X1), (const float*)(ws + WS_MOD) + 2 * 1024};
        pg8::gemm_phase<EpiGateResB<false>, pg8::StaticOrder, true, true>(lds3, g, S, E, mk_wid);
    }
    SEAM(7);
    if (IN(8)) p_h2(a, mk_wid);
    SEAM(8);
    if (IN(9)) {
        pg8::Gemm g{(const pg8::bf16_t*)(ws + WS_H2), (const pg8::bf16_t*)(ws + WS_WFI), MLAT, 2 * DFF, DM}; pg8::StaticOrder S; S.init(MLAT, 2 * DFF, G, bx);
        EpiSwiglu E{(u16*)(ws + WS_ACT)};
        pg8::gemm_phase<EpiSwiglu, pg8::StaticOrder, true, true>(lds3, g, S, E, mk_wid);
    }
    SEAM(9);
    if (IN(10)) {
        pg8::Gemm g{(const pg8::bf16_t*)(ws + WS_ACT), (const pg8::bf16_t*)(ws + WS_WFO), MLAT, DM, DFF}; pg8::StaticOrder S; S.init(MLAT, DM, G, bx, 2);
        EpiGateResB<true> E{(const void*)(ws + WS_X1), (void*)a.out, (const float*)(ws + WS_MOD) + 5 * 1024};
        pg8::gemm_phase<EpiGateResB<true>, pg8::StaticOrder, true, true>(lds3, g, S, E, mk_wid);
    }
#undef IN
#undef SEAM
}

extern "C" void kernel_launch(void* const* d_in, const int* in_sizes, int n_in, void* d_out, int out_size, void* d_ws, size_t ws_size, hipStream_t stream) {
    static int grid = 0;
    if (grid == 0) {
        if (n_in != 21 || in_sizes[0] != MLAT * DM || out_size != MLAT * DM || ws_size < WS_END) {
            fprintf(stderr, "kernel_launch: unexpected shapes: n_in %d in0 %d out %d ws %zu (need >= %zu)\n", n_in, n_in > 0 ? in_sizes[0] : -1, out_size, ws_size, (size_t)WS_END); grid = -1; return; }
        int dev = 0, cus = 0, per_cu = 0;
        if (hipGetDevice(&dev) != hipSuccess || hipDeviceGetAttribute(&cus, hipDeviceAttributeMultiprocessorCount, dev) != hipSuccess) { grid = -1; return; }
        if (hipFuncSetAttribute((const void*)mk_fwd, hipFuncAttributeMaxDynamicSharedMemorySize, LDS_BYTES) != hipSuccess) { fprintf(stderr, "kernel_launch: hipFuncSetAttribute failed\n"); grid = -1; return; }
        if (hipOccupancyMaxActiveBlocksPerMultiprocessor(&per_cu, (const void*)mk_fwd, 512, LDS_BYTES) != hipSuccess || per_cu < 1) { fprintf(stderr, "kernel_launch: occupancy query says %d blocks per CU\n", per_cu); grid = -1; return; }
        grid = cus;
    }
    if (grid < 0) return;
    Args a{};
    for (int i = 0; i < 21; ++i) a.in[i] = (const float*)d_in[i];
    a.out = (float*)d_out; a.ws = (unsigned char*)d_ws;
#if MK_PER_PHASE
    for (int ph = 0; ph < NPH; ++ph) { a.ph_lo = ph; a.ph_hi = ph + 1; hipLaunchKernelGGL(mk_fwd, dim3(grid), dim3(512), LDS_BYTES, stream, a); }
#else
    a.ph_lo = 0; a.ph_hi = NPH;
    void* args[] = {&a};
    const hipError_t e = hipLaunchCooperativeKernel((const void*)mk_fwd, dim3(grid), dim3(512), args, LDS_BYTES, stream);
    if (e != hipSuccess) fprintf(stderr, "kernel_launch: cooperative launch failed: %s (grid %d)\n", hipGetErrorString(e), grid);
#endif
}
```
